# Optimizing an MI355X kernel written in HIP

```python
import math
import jax, jax.numpy as jnp
from jax import lax
import numpy as np

D_MODEL = 2048
BATCH = 2
SEQ = 4096
DEPTH = 2

D_MIX = D_MODEL
HEAD_DIM = 128
GROUP_W = D_MIX // 4
FOX_HEADS = GROUP_W // HEAD_DIM
GDN_HEADS = GROUP_W // HEAD_DIM
GDN_CHUNK = 64
CONV_W = 4
LRU_W = GROUP_W
LRU_BLOCKS = 8
LRU_C = 8.0
NSA_HEADS = GROUP_W // HEAD_DIM
CMP_LEN = 32
CMP_STRIDE = 16
SLC_LEN = 64
N_SELECT = 16
WINDOW = 512
FORCED_SCORE = 1.0e6
N_BUCKETS = 32
MAX_EXACT = 16
MAX_DIST = 1024
D_FF = 5632
Q_BLOCK = 128
EPS = 1e-6

IN_SPLITS = (
    ("fox_q", GROUP_W), ("fox_k", GROUP_W), ("fox_v", GROUP_W), ("fox_f", FOX_HEADS),
    ("gdn_q", GROUP_W), ("gdn_k", GROUP_W), ("gdn_v", GROUP_W), ("gdn_a", GDN_HEADS), ("gdn_b", GDN_HEADS), ("gdn_z", GROUP_W),
    ("lru_x", LRU_W), ("lru_gate", LRU_W),
    ("nsa_q", GROUP_W), ("nsa_kc", HEAD_DIM), ("nsa_vc", HEAD_DIM), ("nsa_ks", HEAD_DIM), ("nsa_vs", HEAD_DIM),
    ("nsa_kw", HEAD_DIM), ("nsa_vw", HEAD_DIM), ("nsa_g", 3 * NSA_HEADS),
)
D_IN = sum(w for _, w in IN_SPLITS)

kernel_name = "hymba_fox_gdn_rglru_nsa_macaron"


def rmsnorm(x, g):
    xf = x.astype(jnp.float32)
    y = xf * lax.rsqrt(jnp.mean(xf * xf, axis=-1, keepdims=True) + EPS)
    return (y * g.astype(jnp.float32)).astype(x.dtype)


def l2norm(x):
    return x * lax.rsqrt(jnp.sum(x * x, axis=-1, keepdims=True) + EPS)


def swiglu(h, w_g, w_u, w_d):
    return (jax.nn.silu(h @ w_g) * (h @ w_u)) @ w_d


def split_cols(z):
    out = []
    off = 0
    for _, w in IN_SPLITS:
        out.append(z[..., off:off + w])
        off += w
    return out


def causal_dwconv(x, w):
    K, C = w.shape
    xp = jnp.pad(x, ((0, 0), (K - 1, 0), (0, 0)))
    return lax.conv_general_dilated(xp, w[:, None, :].astype(x.dtype), window_strides=(1,), padding="VALID",
                                    dimension_numbers=("NWC", "WIO", "NWC"), feature_group_count=C)


def t5_bucket(dist):
    n = jnp.maximum(dist, 0)
    nf = jnp.maximum(n, 1).astype(jnp.float32)
    large = MAX_EXACT + (jnp.log(nf / MAX_EXACT) / math.log(MAX_DIST / MAX_EXACT)
                         * (N_BUCKETS - MAX_EXACT)).astype(jnp.int32)
    large = jnp.minimum(large, N_BUCKETS - 1)
    return jnp.where(n < MAX_EXACT, n, large)


def masked_softmax(s, mask):
    s = jnp.where(mask, s, -jnp.inf)
    m = jnp.max(s, axis=-1, keepdims=True)
    m = jnp.where(jnp.isfinite(m), m, 0.0)
    e = jnp.where(mask, jnp.exp(s - m), 0.0)
    return e / jnp.maximum(jnp.sum(e, axis=-1, keepdims=True), 1e-30)


def fox_attention(q, k, v, log_f):
    B, T, H, D = q.shape
    nb = T // Q_BLOCK
    c = jnp.cumsum(log_f, axis=1)
    c_k = c.transpose(0, 2, 1)[:, :, None, :]
    kpos = jnp.arange(T)
    scale = D ** -0.5
    qb = q.reshape(B, nb, Q_BLOCK, H, D).transpose(1, 0, 2, 3, 4)
    cb = c.reshape(B, nb, Q_BLOCK, H).transpose(1, 0, 2, 3)
    starts = jnp.arange(nb) * Q_BLOCK

    def block(args):
        q_blk, c_blk, s0 = args
        s = jnp.einsum('bqhd,bkhd->bhqk', q_blk, k, preferred_element_type=jnp.float32) * scale
        s = s + c_blk.transpose(0, 2, 1)[..., None] - c_k
        qpos = s0 + jnp.arange(Q_BLOCK)
        mask = kpos[None, :] <= qpos[:, None]
        p = jax.nn.softmax(jnp.where(mask, s, -jnp.inf), axis=-1)
        return jnp.einsum('bhqk,bkhd->bqhd', p.astype(v.dtype), v)

    o = lax.map(block, (qb, cb, starts))
    return o.transpose(1, 0, 2, 3, 4).reshape(B, T, H, D)


def gated_delta_rule(q, k, v, g, beta):
    B, H, T, Dk = q.shape
    Dv = v.shape[-1]
    C = GDN_CHUNK
    N = T // C
    q = q * Dk ** -0.5
    rs = lambda t: t.reshape(B, H, N, C, *t.shape[3:])
    q, k, v, g, beta = rs(q), rs(k), rs(v), rs(g), rs(beta)
    g = jnp.cumsum(g, axis=-1)
    idx = jnp.arange(C)
    tril = idx[:, None] >= idx[None, :]
    strict = idx[:, None] > idx[None, :]
    decay = jnp.where(tril, jnp.exp(jnp.where(tril, g[..., :, None] - g[..., None, :], 0.0)), 0.0)
    kb = k * beta[..., None]
    A = jnp.where(strict, jnp.einsum('bhnid,bhnjd->bhnij', kb, k) * decay, 0.0)
    eye = jnp.eye(C, dtype=jnp.float32)
    Tm = lax.linalg.triangular_solve(eye + A, jnp.broadcast_to(eye, A.shape), left_side=True,
                                     lower=True, unit_diagonal=True)
    U = Tm @ (v * beta[..., None])
    W = Tm @ (kb * jnp.exp(g)[..., None])
    qk = jnp.einsum('bhnid,bhnjd->bhnij', q, k) * decay
    g_last = g[..., -1]

    def step(S, xs):
        q_c, k_c, U_c, W_c, qk_c, g_c, gl_c = xs
        v_new = U_c - W_c @ S
        o = (q_c * jnp.exp(g_c)[..., None]) @ S + qk_c @ v_new
        k_dec = k_c * jnp.exp(gl_c[..., None] - g_c)[..., None]
        S = S * jnp.exp(gl_c)[..., None, None] + jnp.swapaxes(k_dec, -1, -2) @ v_new
        return S, o

    mv = lambda t: jnp.moveaxis(t, 2, 0)
    xs = (mv(q), mv(k), mv(U), mv(W), mv(qk), mv(g), mv(g_last))
    S0 = jnp.zeros((B, H, Dk, Dv), jnp.float32)
    _, o = lax.scan(step, S0, xs)
    return jnp.moveaxis(o, 0, 2).reshape(B, H, T, Dv)


def rg_lru(x, w_a, b_a, w_x, b_x, lam):
    B, T, W = x.shape
    xr = x.reshape(B, T, LRU_BLOCKS, W // LRU_BLOCKS)
    r = jax.nn.sigmoid(jnp.einsum('btnd,nde->btne', xr, w_a).reshape(B, T, W) + b_a)
    i = jax.nn.sigmoid(jnp.einsum('btnd,nde->btne', xr, w_x).reshape(B, T, W) + b_x)
    log_a = -LRU_C * r * jax.nn.softplus(-lam)
    a = jnp.exp(log_a)
    u = jnp.sqrt(-jnp.expm1(2.0 * log_a)) * (i * x)

    def comb(left, right):
        a1, b1 = left
        a2, b2 = right
        return a1 * a2, a2 * b1 + b2

    _, h = lax.associative_scan(comb, (a, u), axis=1)
    return h


def nsa_compress(k, pe, w1, w2):
    B, T, D = k.shape
    n_cmp = (T - CMP_LEN) // CMP_STRIDE + 1
    idx = jnp.arange(n_cmp)[:, None] * CMP_STRIDE + jnp.arange(CMP_LEN)[None, :]
    blocks = k[:, idx] + pe
    hid = jax.nn.gelu(blocks.reshape(B, n_cmp, CMP_LEN * D) @ w1)
    return hid @ w2


def nsa_attention(q, kc, vc, ks, vs, kw, vw, gates, rel_bias):
    B, T, H, D = q.shape
    nb = T // Q_BLOCK
    n_cmp = kc.shape[1]
    n_slc = T // SLC_LEN
    n_sel = min(N_SELECT, n_slc)
    scale = D ** -0.5
    c_start = jnp.arange(n_cmp) * CMP_STRIDE
    c_end = c_start + CMP_LEN - 1
    s_start = jnp.arange(n_slc) * SLC_LEN
    s_end = s_start + SLC_LEN - 1
    overlap = ((c_start[:, None] <= s_end[None, :]) & (c_end[:, None] >= s_start[None, :])).astype(jnp.float32)
    ks_blk = ks.reshape(B, n_slc, SLC_LEN, D)
    vs_blk = vs.reshape(B, n_slc, SLC_LEN, D)
    kw_pad = jnp.pad(kw, ((0, 0), (WINDOW, 0), (0, 0)))
    vw_pad = jnp.pad(vw, ((0, 0), (WINDOW, 0), (0, 0)))
    bidx = jnp.arange(B)[:, None, None]
    jsl = jnp.arange(n_slc)
    qb = q.reshape(B, nb, Q_BLOCK, H, D).transpose(1, 0, 2, 3, 4)
    gb = gates.reshape(B, nb, Q_BLOCK, H, 3).transpose(1, 0, 2, 3, 4)
    starts = jnp.arange(nb) * Q_BLOCK

    def block(args):
        q_blk, g_blk, s0 = args
        qpos = s0 + jnp.arange(Q_BLOCK)
        dist_c = qpos[:, None] - c_end[None, :]
        s_c = jnp.einsum('bqhd,bnd->bhqn', q_blk, kc, preferred_element_type=jnp.float32) * scale
        s_c = s_c + rel_bias[t5_bucket(dist_c)].transpose(2, 0, 1)
        p_c = masked_softmax(s_c, dist_c >= 0)
        o_c = jnp.einsum('bhqn,bnd->bqhd', p_c.astype(vc.dtype), vc)
        imp = jnp.einsum('bhqn,nj->bqj', p_c, overlap)
        cur = qpos // SLC_LEN
        forced = (jsl[None, :] == 0) | (jsl[None, :] == cur[:, None]) | (jsl[None, :] == cur[:, None] - 1)
        imp = jnp.where(forced[None], FORCED_SCORE, imp)
        imp = jnp.where((jsl[None, :] > cur[:, None])[None], -1.0, imp)
        _, sel = lax.top_k(imp, n_sel)
        k_sel = ks_blk[bidx, sel].reshape(B, Q_BLOCK, n_sel * SLC_LEN, D)
        v_sel = vs_blk[bidx, sel].reshape(B, Q_BLOCK, n_sel * SLC_LEN, D)
        pos_s = (sel[..., None] * SLC_LEN + jnp.arange(SLC_LEN)).reshape(B, Q_BLOCK, n_sel * SLC_LEN)
        dist_s = qpos[None, :, None] - pos_s
        s_s = jnp.einsum('bqhd,bqkd->bhqk', q_blk, k_sel, preferred_element_type=jnp.float32) * scale
        s_s = s_s + rel_bias[t5_bucket(dist_s)].transpose(0, 3, 1, 2)
        p_s = masked_softmax(s_s, (dist_s >= 0)[:, None])
        o_s = jnp.einsum('bhqk,bqkd->bqhd', p_s.astype(v_sel.dtype), v_sel)
        k_win = lax.dynamic_slice_in_dim(kw_pad, s0, WINDOW + Q_BLOCK, axis=1)
        v_win = lax.dynamic_slice_in_dim(vw_pad, s0, WINDOW + Q_BLOCK, axis=1)
        pos_w = s0 - WINDOW + jnp.arange(WINDOW + Q_BLOCK)
        dist_w = qpos[:, None] - pos_w[None, :]
        mask_w = (dist_w >= 0) & (dist_w < WINDOW) & (pos_w[None, :] >= 0)
        s_w = jnp.einsum('bqhd,bkd->bhqk', q_blk, k_win, preferred_element_type=jnp.float32) * scale
        s_w = s_w + rel_bias[t5_bucket(dist_w)].transpose(2, 0, 1)
        p_w = masked_softmax(s_w, mask_w)
        o_w = jnp.einsum('bhqk,bkd->bqhd', p_w.astype(v_win.dtype), v_win)
        out = g_blk[..., 0:1] * o_c + g_blk[..., 1:2] * o_s + g_blk[..., 2:3] * o_w
        return out.astype(q.dtype)

    o = lax.map(block, (qb, gb, starts))
    return o.transpose(1, 0, 2, 3, 4).reshape(B, T, H, D)


def hybrid_mixer(h, w_in, b_in, gdn_conv_w, gdn_a_log, gdn_dt_bias, gdn_norm_g,
                 lru_conv_w, lru_conv_b, lru_w_a, lru_b_a, lru_w_x, lru_b_x, lru_lambda,
                 nsa_pe_k, nsa_w1_k, nsa_w2_k, nsa_pe_v, nsa_w1_v, nsa_w2_v, rel_bias,
                 out_norm_g, w_out):
    B, T, _ = h.shape
    f32 = jnp.float32
    z = h @ w_in + b_in
    (fq, fk, fv, ff, gq, gk, gv, ga, gbeta, gz, lx, lg,
     nq, nkc, nvc, nks, nvs, nkw, nvw, ng) = split_cols(z)
    heads = lambda t, n: t.reshape(B, T, n, HEAD_DIM)
    log_f = jax.nn.log_sigmoid(ff.astype(f32))
    o_a = fox_attention(heads(fq, FOX_HEADS), heads(fk, FOX_HEADS), heads(fv, FOX_HEADS), log_f)
    o_a = o_a.reshape(B, T, GROUP_W)
    qkv = jax.nn.silu(causal_dwconv(jnp.concatenate([gq, gk, gv], axis=-1), gdn_conv_w)).astype(f32)
    dq = l2norm(heads(qkv[..., :GROUP_W], GDN_HEADS))
    dk = l2norm(heads(qkv[..., GROUP_W:2 * GROUP_W], GDN_HEADS))
    dv = heads(qkv[..., 2 * GROUP_W:], GDN_HEADS)
    beta = jax.nn.sigmoid(gbeta.astype(f32))
    g = -jnp.exp(gdn_a_log.astype(f32)) * jax.nn.softplus(ga.astype(f32) + gdn_dt_bias.astype(f32))
    tr = lambda t: t.transpose(0, 2, 1, 3)
    o_b = gated_delta_rule(tr(dq), tr(dk), tr(dv), g.transpose(0, 2, 1), beta.transpose(0, 2, 1))
    o_b = rmsnorm(tr(o_b), gdn_norm_g) * jax.nn.silu(heads(gz, GDN_HEADS).astype(f32))
    o_b = o_b.reshape(B, T, GROUP_W)
    xc = (causal_dwconv(lx, lru_conv_w) + lru_conv_b).astype(f32)
    hc = rg_lru(xc, lru_w_a.astype(f32), lru_b_a.astype(f32), lru_w_x.astype(f32), lru_b_x.astype(f32),
                lru_lambda.astype(f32))
    o_c = hc * jax.nn.gelu(lg.astype(f32))
    kc = nsa_compress(nkc, nsa_pe_k, nsa_w1_k, nsa_w2_k)
    vc = nsa_compress(nvc, nsa_pe_v, nsa_w1_v, nsa_w2_v)
    gates = jax.nn.sigmoid(ng.astype(f32)).reshape(B, T, NSA_HEADS, 3)
    o_d = nsa_attention(heads(nq, NSA_HEADS), kc, vc, nks, nvs, nkw, nvw, gates, rel_bias)
    o_d = o_d.reshape(B, T, GROUP_W)
    y = jnp.concatenate([rmsnorm(o_a, out_norm_g[0]).astype(f32), o_b.astype(f32),
                         rmsnorm(o_c, out_norm_g[1]).astype(f32), rmsnorm(o_d, out_norm_g[2]).astype(f32)], axis=-1)
    return y.astype(h.dtype) @ w_out


def setup_inputs(seed: int = 0) -> dict:
    key = jax.random.key(seed)
    keys = iter(list(jax.random.split(key, 64)))
    nrm = lambda shape, scale: jax.random.normal(next(keys), shape, jnp.float32) * scale
    gain = lambda shape: 1.0 + nrm(shape, 0.02)
    L, D, F = DEPTH, D_MODEL, D_FF
    bw = LRU_W // LRU_BLOCKS
    x = nrm((BATCH, SEQ, D), 1.0)
    ffn1_norm_g = gain((L, D))
    ffn1_w_gate = nrm((L, D, F), D ** -0.5)
    ffn1_w_up = nrm((L, D, F), D ** -0.5)
    ffn1_w_down = nrm((L, F, D), F ** -0.5)
    mix_norm_g = gain((L, D))
    w_in = nrm((L, D, D_IN), D ** -0.5)
    b_in = nrm((L, D_IN), 0.02)
    gdn_conv_w = nrm((L, CONV_W, 3 * GROUP_W), CONV_W ** -0.5)
    gdn_a_log = jnp.log(jax.random.uniform(next(keys), (L, GDN_HEADS), jnp.float32, 1.0, 16.0))
    dt = jnp.exp(jax.random.uniform(next(keys), (L, GDN_HEADS), jnp.float32, math.log(1e-3), math.log(1e-1)))
    gdn_dt_bias = dt + jnp.log(-jnp.expm1(-dt))
    gdn_norm_g = gain((L, HEAD_DIM))
    lru_conv_w = nrm((L, CONV_W, LRU_W), CONV_W ** -0.5)
    lru_conv_b = nrm((L, LRU_W), 0.02)
    lru_w_a = nrm((L, LRU_BLOCKS, bw, bw), bw ** -0.5)
    lru_b_a = nrm((L, LRU_W), 0.02)
    lru_w_x = nrm((L, LRU_BLOCKS, bw, bw), bw ** -0.5)
    lru_b_x = nrm((L, LRU_W), 0.02)
    a_c = jax.random.uniform(next(keys), (L, LRU_W), jnp.float32, 0.9, 0.999)
    s = a_c ** (1.0 / LRU_C)
    lru_lambda = jnp.log(s) - jnp.log1p(-s)
    nsa_pe_k = nrm((L, CMP_LEN, HEAD_DIM), 0.02)
    nsa_w1_k = nrm((L, CMP_LEN * HEAD_DIM, HEAD_DIM), (CMP_LEN * HEAD_DIM) ** -0.5)
    nsa_w2_k = nrm((L, HEAD_DIM, HEAD_DIM), HEAD_DIM ** -0.5)
    nsa_pe_v = nrm((L, CMP_LEN, HEAD_DIM), 0.02)
    nsa_w1_v = nrm((L, CMP_LEN * HEAD_DIM, HEAD_DIM), (CMP_LEN * HEAD_DIM) ** -0.5)
    nsa_w2_v = nrm((L, HEAD_DIM, HEAD_DIM), HEAD_DIM ** -0.5)
    rel_bias = nrm((N_BUCKETS, NSA_HEADS), 0.2)
    out_norm_g = gain((L, 3, GROUP_W))
    w_out = nrm((L, D_MIX, D), D_MIX ** -0.5)
    ffn2_norm_g = gain((L, D))
    ffn2_w_gate = nrm((L, D, F), D ** -0.5)
    ffn2_w_up = nrm((L, D, F), D ** -0.5)
    ffn2_w_down = nrm((L, F, D), F ** -0.5)
    final_norm_g = gain((D,))
    return {"x": x, "ffn1_norm_g": ffn1_norm_g, "ffn1_w_gate": ffn1_w_gate, "ffn1_w_up": ffn1_w_up,
            "ffn1_w_down": ffn1_w_down, "mix_norm_g": mix_norm_g, "w_in": w_in, "b_in": b_in,
            "gdn_conv_w": gdn_conv_w, "gdn_a_log": gdn_a_log, "gdn_dt_bias": gdn_dt_bias, "gdn_norm_g": gdn_norm_g,
            "lru_conv_w": lru_conv_w, "lru_conv_b": lru_conv_b, "lru_w_a": lru_w_a, "lru_b_a": lru_b_a,
            "lru_w_x": lru_w_x, "lru_b_x": lru_b_x, "lru_lambda": lru_lambda,
            "nsa_pe_k": nsa_pe_k, "nsa_w1_k": nsa_w1_k, "nsa_w2_k": nsa_w2_k,
            "nsa_pe_v": nsa_pe_v, "nsa_w1_v": nsa_w1_v, "nsa_w2_v": nsa_w2_v, "rel_bias": rel_bias,
            "out_norm_g": out_norm_g, "w_out": w_out, "ffn2_norm_g": ffn2_norm_g, "ffn2_w_gate": ffn2_w_gate,
            "ffn2_w_up": ffn2_w_up, "ffn2_w_down": ffn2_w_down, "final_norm_g": final_norm_g}


def reference(x, ffn1_norm_g, ffn1_w_gate, ffn1_w_up, ffn1_w_down, mix_norm_g, w_in, b_in,
              gdn_conv_w, gdn_a_log, gdn_dt_bias, gdn_norm_g, lru_conv_w, lru_conv_b, lru_w_a, lru_b_a,
              lru_w_x, lru_b_x, lru_lambda, nsa_pe_k, nsa_w1_k, nsa_w2_k, nsa_pe_v, nsa_w1_v, nsa_w2_v,
              rel_bias, out_norm_g, w_out, ffn2_norm_g, ffn2_w_gate, ffn2_w_up, ffn2_w_down, final_norm_g):
    h = x
    for l in range(DEPTH):
        h = h + 0.5 * swiglu(rmsnorm(h, ffn1_norm_g[l]), ffn1_w_gate[l], ffn1_w_up[l], ffn1_w_down[l])
        h = h + hybrid_mixer(rmsnorm(h, mix_norm_g[l]), w_in[l], b_in[l], gdn_conv_w[l], gdn_a_log[l],
                             gdn_dt_bias[l], gdn_norm_g[l], lru_conv_w[l], lru_conv_b[l], lru_w_a[l], lru_b_a[l],
                             lru_w_x[l], lru_b_x[l], lru_lambda[l], nsa_pe_k[l], nsa_w1_k[l], nsa_w2_k[l],
                             nsa_pe_v[l], nsa_w1_v[l], nsa_w2_v[l], rel_bias, out_norm_g[l], w_out[l])
        h = h + 0.5 * swiglu(rmsnorm(h, ffn2_norm_g[l]), ffn2_w_gate[l], ffn2_w_up[l], ffn2_w_down[l])
    return rmsnorm(h, final_norm_g)
```

```cpp
#include <hip/hip_runtime.h>
#include <cstdio>
#include <cstdint>
#include <cmath>
namespace pg8 {
#define PG8_LAS __attribute__((address_space(3)))
typedef unsigned short bf16_t;
typedef short bf16x8 __attribute__((ext_vector_type(8)));
typedef float f32x4 __attribute__((ext_vector_type(4)));
typedef unsigned u32x4 __attribute__((ext_vector_type(4)));
constexpr int BM = 256, BK = 64, HALF = 128, HTB = HALF * BK * 2  , STAGE_BYTES = 8 * HTB, NXCD = 8, WGM = 8;

__host__ __device__ __forceinline__ int lds_byte(int r, int c) { const int st = (r >> 4) * 2 + (c >> 5), rr = r & 15, cc = c & 31, ob = rr * 64 + cc * 2; return st * 1024 + (ob ^ (((ob >> 9) & 1) << 5)); }
__host__ __device__ __forceinline__ void stage_rc(int b, int& R, int& C) { const int st = b / 1024, sb = b % 1024, swz = sb ^ (((sb >> 9) & 1) << 5); R = (st >> 1) * 16 + swz / 64; C = (st & 1) * 32 + (swz % 64) / 2; }
__host__ __device__ __forceinline__ int perm32(int rho) { const int n = rho >> 4, i = rho & 15; return 8 * (i >> 2) + 4 * n + (i & 3); }

struct Unit { int pm, pn; };
struct Gemm { const bf16_t* A; const bf16_t* Bt; int M, N, K; };

struct StaticOrder {
    int nM, nN, nwg, G, c;
    __host__ __device__ void init(int M, int N, int G_, int c_) { nM = M / BM; nN = N / BM; nwg = nM * nN; G = G_; c = c_; }
    __host__ __device__ bool next(int i, Unit& u) const {
        const long L = (long)i * G + c; if (L >= nwg) return false;
        int wgid = (int)L; { const int q = nwg / NXCD, r = nwg % NXCD, xcd = wgid % NXCD, off = wgid / NXCD; wgid = (xcd < r ? xcd * (q + 1) : r * (q + 1) + (xcd - r) * q) + off; }
        const int nig = WGM * nN, gid = wgid / nig, fm = gid * WGM, gsz = (nM - fm) < WGM ? (nM - fm) : WGM;
        u.pm = fm + ((wgid % nig) % gsz); u.pn = (wgid % nig) / gsz; return true;
    }
    __device__ __forceinline__ void a_ready(const Unit&) const {}
    __device__ __forceinline__ void done(const Unit&) const {}
};

__device__ __forceinline__ unsigned cvt_pk_bf16(float lo, float hi) { unsigned r; asm volatile("v_cvt_pk_bf16_f32 %0, %1, %2" : "=v"(r) : "v"(lo), "v"(hi)); return r; }
typedef unsigned u32x2v __attribute__((ext_vector_type(2)));
__device__ __forceinline__ float silu_f(float x) { return x * __builtin_amdgcn_rcpf(1.0f + __builtin_amdgcn_exp2f(-1.44269504f * x)); }

struct EpiSwiGLU {
    static constexpr bool PERM = true, AFTER_DRAIN = false;
    bf16_t* O; int ldc;
    __device__ __forceinline__ void operator()(const f32x4 (&acc)[2][2][4][2], const Unit& u, int wr, int wc, int fr, int fq) const {
        const int row0 = u.pm * BM + wr * 64 + fr, col0 = u.pn * HALF + wc * 32 + 8 * fq;
#pragma unroll
        for (int ai = 0; ai < 2; ++ai)
#pragma unroll
            for (int m = 0; m < 4; ++m) { bf16_t* rowp = O + (size_t)(row0 + ai * HALF + m * 16) * ldc + col0;
                const f32x4 g0 = acc[ai][0][m][0], g1 = acc[ai][0][m][1], u0 = acc[ai][1][m][0], u1 = acc[ai][1][m][1];
                u32x4 w;
                w.x = cvt_pk_bf16(silu_f(g0[0]) * u0[0], silu_f(g0[1]) * u0[1]); w.y = cvt_pk_bf16(silu_f(g0[2]) * u0[2], silu_f(g0[3]) * u0[3]);
                w.z = cvt_pk_bf16(silu_f(g1[0]) * u1[0], silu_f(g1[1]) * u1[1]); w.w = cvt_pk_bf16(silu_f(g1[2]) * u1[2], silu_f(g1[3]) * u1[3]);
                *(u32x4*)rowp = w; }
    }
};
struct EpiResid {
    static constexpr bool PERM = false, AFTER_DRAIN = false;
    float* C; int ldc; float scale;
    __device__ __forceinline__ void operator()(const f32x4 (&acc)[2][2][4][2], const Unit& u, int wr, int wc, int fr, int fq) const {
        const int row0 = u.pm * BM + wr * 64 + fr, col0 = u.pn * BM + wc * 32 + 4 * fq;
#pragma unroll
        for (int ai = 0; ai < 2; ++ai)
#pragma unroll
            for (int m = 0; m < 4; ++m) { float* rowp = C + (size_t)(row0 + ai * HALF + m * 16) * ldc + col0;
                f32x4 old[2][2];
#pragma unroll
                for (int bj = 0; bj < 2; ++bj)
#pragma unroll
                    for (int n = 0; n < 2; ++n) old[bj][n] = *(const f32x4*)(rowp + bj * HALF + n * 16);
#pragma unroll
                for (int bj = 0; bj < 2; ++bj)
#pragma unroll
                    for (int n = 0; n < 2; ++n) *(f32x4*)(rowp + bj * HALF + n * 16) = old[bj][n] + acc[ai][bj][m][n] * scale;
                asm volatile("" ::: "memory"); }
    }
};
struct EpiWin {
    static constexpr bool PERM = true, AFTER_DRAIN = false;
    bf16_t* ZB; int ldb; float* ZF; int ldf; const float* bias; int nb16;
    __device__ __forceinline__ void operator()(const f32x4 (&acc)[2][2][4][2], const Unit& u, int wr, int wc, int fr, int fq) const {
        const int row0 = u.pm * BM + wr * 64 + fr, col0 = u.pn * BM + wc * 32 + 8 * fq;
        if (u.pn < nb16) {
#pragma unroll
            for (int bj = 0; bj < 2; ++bj) { const f32x4 b0 = *(const f32x4*)(bias + col0 + bj * HALF), b1 = *(const f32x4*)(bias + col0 + bj * HALF + 4);
#pragma unroll
                for (int ai = 0; ai < 2; ++ai)
#pragma unroll
                    for (int m = 0; m < 4; ++m) { bf16_t* rowp = ZB + (size_t)(row0 + ai * HALF + m * 16) * ldb + col0 + bj * HALF;
                        const f32x4 v0 = acc[ai][bj][m][0] + b0, v1 = acc[ai][bj][m][1] + b1;
                        u32x4 w; w.x = cvt_pk_bf16(v0[0], v0[1]); w.y = cvt_pk_bf16(v0[2], v0[3]); w.z = cvt_pk_bf16(v1[0], v1[1]); w.w = cvt_pk_bf16(v1[2], v1[3]);
                        *(u32x4*)rowp = w; }
                asm volatile("" ::: "memory"); }
        } else {
            const int cf = col0 - nb16 * BM;
#pragma unroll
            for (int bj = 0; bj < 2; ++bj) { const f32x4 b0 = *(const f32x4*)(bias + col0 + bj * HALF), b1 = *(const f32x4*)(bias + col0 + bj * HALF + 4);
#pragma unroll
                for (int ai = 0; ai < 2; ++ai)
#pragma unroll
                    for (int m = 0; m < 4; ++m) { float* rowp = ZF + (size_t)(row0 + ai * HALF + m * 16) * ldf + cf + bj * HALF;
                        *(f32x4*)rowp = acc[ai][bj][m][0] + b0; *(f32x4*)(rowp + 4) = acc[ai][bj][m][1] + b1; }
                asm volatile("" ::: "memory"); }
        }
    }
};
template <class Epi, class Sched, bool ALIGN_EPI = false, bool SP2 = false>
__device__ __forceinline__ void gemm_phase(PG8_LAS unsigned char* lds, const Gemm g, const Sched& S, const Epi& E) {
    const int tid = threadIdx.x, wid = __builtin_amdgcn_readfirstlane(tid >> 6), lane = tid & 63, wr = wid >> 2, wc = wid & 3, fr = lane & 15, fq = lane >> 4;
    const int K = g.K, nt = K / BK;
    unsigned voffA[2], voffB[2];
#pragma unroll
    for (int i = 0; i < 2; ++i) { int R, C; stage_rc(tid * 16 + i * 8192, R, C); const int Rb = Epi::PERM ? ((R & ~31) + perm32(R & 31)) : R;
        voffA[i] = (unsigned)(R * K + C) * 2u; voffB[i] = (unsigned)(Rb * K + C) * 2u; }
    const size_t kstep = (size_t)(BK * 2);
    const size_t hstep = (size_t)HALF * K * 2;
    const size_t tstep = 2 * hstep;
    const unsigned ldsw = (unsigned)wid * 1024u;
    const int aoff = lds_byte(wr * 64 + fr, fq * 8), boff = lds_byte(wc * 32 + fr, fq * 8);
#define PG8_SA(b, h) (((b) * 2 + (h)) * HTB)
#define PG8_SB(b, h) ((4 + (b) * 2 + (h)) * HTB)
#define PG8_STAGE(bufoff, gbase, voff) do { _Pragma("unroll") for (int _i = 0; _i < 2; ++_i) \
        __builtin_amdgcn_global_load_lds((const unsigned*)((const char*)(gbase) + (voff)[_i]), (PG8_LAS unsigned*)(lds + (bufoff) + ldsw + _i * 8192), 16, 0, 0); } while (0)
#define PG8_LDA(dst, b, h) do { _Pragma("unroll") for (int m = 0; m < 4; ++m) _Pragma("unroll") for (int k = 0; k < 2; ++k) dst[m][k] = *(const PG8_LAS bf16x8*)(lds + PG8_SA(b, h) + aoff + m * 2048 + k * 1024); } while (0)
#define PG8_LDB(dst, b, h) do { _Pragma("unroll") for (int n = 0; n < 2; ++n) _Pragma("unroll") for (int k = 0; k < 2; ++k) dst[n][k] = *(const PG8_LAS bf16x8*)(lds + PG8_SB(b, h) + boff + n * 2048 + k * 1024); } while (0)
#define PG8_MMA(ai, bj, At, Bt) do { __builtin_amdgcn_s_setprio(1); _Pragma("unroll") for (int m = 0; m < 4; ++m) _Pragma("unroll") for (int n = 0; n < 2; ++n) _Pragma("unroll") for (int k = 0; k < 2; ++k) \
        acc[ai][bj][m][n] = __builtin_amdgcn_mfma_f32_16x16x32_bf16(Bt[n][k], At[m][k], acc[ai][bj][m][n], 0, 0, 0); __builtin_amdgcn_s_setprio(0); } while (0)
#define PG8_WAIT_V(n) asm volatile("s_waitcnt vmcnt(" #n ")" ::: "memory")
#define PG8_WAIT_L(n) asm volatile("s_waitcnt lgkmcnt(" #n ")" ::: "memory")
#define PG8_BAR __builtin_amdgcn_s_barrier()
#define PG8_SCHED __builtin_amdgcn_sched_barrier(0)
    Unit cur, nxt; int ui = 0;
    if (!S.next(0, cur)) return;
    f32x4 acc[2][2][4][2];
#pragma unroll
    for (int a = 0; a < 2; ++a)
#pragma unroll
        for (int b = 0; b < 2; ++b)
#pragma unroll
            for (int m = 0; m < 4; ++m)
#pragma unroll
                for (int n = 0; n < 2; ++n) acc[a][b][m][n] = (f32x4){0.f, 0.f, 0.f, 0.f};
    bf16x8 At[4][2], B0[2][2], B1[2][2];
    const char* cA = (const char*)g.A + (size_t)cur.pm * tstep; const char* cB = (const char*)g.Bt + (size_t)cur.pn * tstep;
    S.a_ready(cur);
    if constexpr (SP2) {
        PG8_STAGE(PG8_SB(0, 0), cB, voffB); PG8_STAGE(PG8_SB(0, 1), cB + hstep, voffB); PG8_STAGE(PG8_SA(0, 0), cA, voffA); PG8_STAGE(PG8_SA(0, 1), cA + hstep, voffA);
        if (wr == 1) PG8_BAR;
        PG8_WAIT_V(2); PG8_BAR;
        PG8_STAGE(PG8_SB(1, 0), cB + kstep, voffB); PG8_STAGE(PG8_SA(1, 0), cA + kstep, voffA); PG8_STAGE(PG8_SB(1, 1), cB + hstep + kstep, voffB);
        PG8_WAIT_V(6); PG8_BAR;
    } else {
        PG8_STAGE(PG8_SB(0, 0), cB, voffB); PG8_STAGE(PG8_SA(0, 0), cA, voffA); PG8_STAGE(PG8_SB(0, 1), cB + hstep, voffB); PG8_STAGE(PG8_SA(0, 1), cA + hstep, voffA);
        if (wr == 1) PG8_BAR;
        PG8_WAIT_V(4); PG8_BAR;
        PG8_STAGE(PG8_SB(1, 0), cB + kstep, voffB); PG8_STAGE(PG8_SA(1, 0), cA + kstep, voffA); PG8_STAGE(PG8_SB(1, 1), cB + hstep + kstep, voffB);
        PG8_WAIT_V(6); PG8_BAR;
    }
    for (;;) {
        const bool has_next = S.next(ui + 1, nxt);
        const char* nA = has_next ? (const char*)g.A + (size_t)nxt.pm * tstep : cA; const char* nB = has_next ? (const char*)g.Bt + (size_t)nxt.pn * tstep : cB;
        for (int t = 0; t < nt; t += 2) {
            const bool last = (t == nt - 2);
            const char* a1 = cA + (size_t)(t + 1) * kstep;
            const char* a2 = last ? nA : cA + (size_t)(t + 2) * kstep; const char* b2 = last ? nB : cB + (size_t)(t + 2) * kstep;
            const char* a3 = a2 + kstep; const char* b3 = b2 + kstep;
            if (last && has_next) S.a_ready(nxt);
            if constexpr (SP2) {
            PG8_LDB(B0, 0, 0); PG8_LDB(B1, 0, 1); PG8_SCHED; PG8_LDA(At, 0, 0); PG8_STAGE(PG8_SA(1, 1), a1 + hstep, voffA);
            PG8_WAIT_V(8); PG8_WAIT_L(0); PG8_BAR; PG8_MMA(0, 0, At, B0); PG8_MMA(0, 1, At, B1); PG8_BAR; PG8_SCHED;
            PG8_LDA(At, 0, 1); PG8_STAGE(PG8_SB(0, 0), b2, voffB); PG8_STAGE(PG8_SB(0, 1), b2 + hstep, voffB); PG8_STAGE(PG8_SA(0, 0), a2, voffA);
            PG8_WAIT_V(8); PG8_WAIT_L(0); PG8_BAR; PG8_MMA(1, 0, At, B0); PG8_MMA(1, 1, At, B1); PG8_BAR; PG8_SCHED;
            PG8_LDB(B0, 1, 0); PG8_LDB(B1, 1, 1); PG8_SCHED; PG8_LDA(At, 1, 0); PG8_STAGE(PG8_SA(0, 1), a2 + hstep, voffA);
            PG8_WAIT_V(8); PG8_WAIT_L(0); PG8_BAR; PG8_MMA(0, 0, At, B0); PG8_MMA(0, 1, At, B1); PG8_BAR; PG8_SCHED;
            PG8_LDA(At, 1, 1); PG8_STAGE(PG8_SB(1, 0), b3, voffB); PG8_STAGE(PG8_SB(1, 1), b3 + hstep, voffB); PG8_STAGE(PG8_SA(1, 0), a3, voffA);
            PG8_WAIT_V(8); PG8_WAIT_L(0); PG8_BAR; PG8_MMA(1, 0, At, B0); PG8_MMA(1, 1, At, B1); PG8_BAR; PG8_SCHED;
            } else {
            PG8_LDB(B0, 0, 0); PG8_SCHED; PG8_LDA(At, 0, 0); PG8_STAGE(PG8_SA(1, 1), a1 + hstep, voffA);
            PG8_WAIT_L(8); PG8_BAR; PG8_WAIT_L(0); PG8_MMA(0, 0, At, B0); PG8_BAR; PG8_SCHED;
            PG8_LDB(B1, 0, 1); PG8_STAGE(PG8_SB(0, 0), b2, voffB);
            PG8_BAR; PG8_WAIT_L(0); PG8_MMA(0, 1, At, B1); PG8_BAR;
            PG8_LDA(At, 0, 1); PG8_STAGE(PG8_SA(0, 0), a2, voffA);
            PG8_BAR; PG8_WAIT_L(0); PG8_MMA(1, 0, At, B0); PG8_BAR; PG8_SCHED;
            PG8_STAGE(PG8_SB(0, 1), b2 + hstep, voffB);
            PG8_WAIT_V(6); PG8_BAR; PG8_MMA(1, 1, At, B1); PG8_BAR;
            PG8_LDB(B0, 1, 0); PG8_SCHED; PG8_LDA(At, 1, 0); PG8_STAGE(PG8_SA(0, 1), a2 + hstep, voffA);
            PG8_WAIT_L(8); PG8_BAR; PG8_WAIT_L(0); PG8_MMA(0, 0, At, B0); PG8_BAR; PG8_SCHED;
            PG8_LDB(B1, 1, 1); PG8_STAGE(PG8_SB(1, 0), b3, voffB);
            PG8_BAR; PG8_WAIT_L(0); PG8_MMA(0, 1, At, B1); PG8_BAR;
            PG8_LDA(At, 1, 1); PG8_STAGE(PG8_SA(1, 0), a3, voffA);
            PG8_BAR; PG8_WAIT_L(0); PG8_MMA(1, 0, At, B0); PG8_BAR; PG8_SCHED;
            PG8_STAGE(PG8_SB(1, 1), b3 + hstep, voffB);
            PG8_WAIT_V(6); PG8_BAR; PG8_MMA(1, 1, At, B1); PG8_BAR;
            }
        }
        if constexpr (ALIGN_EPI) { if (wr == 0) PG8_BAR; }
        if constexpr (!Epi::AFTER_DRAIN) { E(acc, cur, wr, wc, fr, fq); S.done(cur); }
        if (!has_next) break;
#pragma unroll
        for (int a = 0; a < 2; ++a)
#pragma unroll
            for (int b = 0; b < 2; ++b)
#pragma unroll
                for (int m = 0; m < 4; ++m)
#pragma unroll
                    for (int n = 0; n < 2; ++n) acc[a][b][m][n] = (f32x4){0.f, 0.f, 0.f, 0.f};
        cur = nxt; cA = nA; cB = nB; ++ui;
        if constexpr (ALIGN_EPI) { if (wr == 1) PG8_BAR; }
    }
    PG8_WAIT_V(0);
    if constexpr (!ALIGN_EPI) { if (wr == 0) PG8_BAR; }
    PG8_BAR;
    if constexpr (Epi::AFTER_DRAIN) { E.fused(acc, cur, wr, wc, fr, fq, lds, wid, lane); S.done(cur); }
#undef PG8_SA
#undef PG8_SB
#undef PG8_STAGE
#undef PG8_LDA
#undef PG8_LDB
#undef PG8_MMA
#undef PG8_WAIT_V
#undef PG8_WAIT_L
#undef PG8_BAR
#undef PG8_SCHED
}
}
constexpr int BATCH = 2, T = 4096, D = 2048, FF = 5632, DEPTH = 2;
constexpr int M = BATCH * T;
constexpr int DIN = 5912, GW = 512, HD = 128, NH = 4;
constexpr int ZBC = 2560, ZFC = 3584, ZC = ZBC + ZFC;
constexpr int ZB_FQ = 0, ZB_FK = 512, ZB_FV = 1024, ZB_NQ = 1536, ZB_NKS = 2048, ZB_NVS = 2176, ZB_NKW = 2304, ZB_NVW = 2432;
constexpr int ZF_GQ = 0, ZF_GK = 512, ZF_GV = 1024, ZF_GZ = 1536, ZF_LX = 2048, ZF_LG = 2560, ZF_NKC = 3072, ZF_NVC = 3200, ZF_FF = 3328, ZF_GA = 3332, ZF_GB = 3336, ZF_NG = 3340;
constexpr float EPS = 1e-6f;
constexpr int NCMP = 255, NCMPP = 256, NSLC = 64, NSEL = 16, WINDOW = 512, NBT = 791;
constexpr float LOG2E = 1.4426950408889634f;

__host__ __device__ __forceinline__ int zsrc(int zc) {
    if (zc < 1536) return zc;
    if (zc < 2048) return 4620 + (zc - 1536);
    if (zc < 2176) return 5388 + (zc - 2048);
    if (zc < 2304) return 5516 + (zc - 2176);
    if (zc < 2432) return 5644 + (zc - 2304);
    if (zc < 2560) return 5772 + (zc - 2432);
    const int c = zc - 2560;
    if (c < 512) return 1540 + c;
    if (c < 1024) return 2052 + (c - 512);
    if (c < 1536) return 2564 + (c - 1024);
    if (c < 2048) return 3084 + (c - 1536);
    if (c < 2560) return 3596 + (c - 2048);
    if (c < 3072) return 4108 + (c - 2560);
    if (c < 3200) return 5132 + (c - 3072);
    if (c < 3328) return 5260 + (c - 3200);
    if (c < 3332) return 1536 + (c - 3328);
    if (c < 3340) return 3076 + (c - 3332);
    if (c < 3352) return 5900 + (c - 3340);
    return -1;
}

constexpr size_t MiB = 1u << 20;
constexpr size_t WS_CTL = 0, CTL_ZERO_BYTES = 1 * MiB;
constexpr size_t WS_MISC = 1 * MiB;
constexpr size_t WS_W = 2 * MiB, W_LAYER = 164 * MiB;
constexpr size_t WO_GU1 = 0, WO_DN1 = 44 * MiB, WO_WIN = 66 * MiB, WO_WOUT = 90 * MiB, WO_GU2 = 98 * MiB, WO_DN2 = 142 * MiB;
constexpr size_t WS_XN = 330 * MiB;
constexpr size_t WS_ZB = 362 * MiB, WS_ZF = 402 * MiB;
constexpr size_t WS_ACT = 362 * MiB;
constexpr size_t WS_VFT = 514 * MiB, WS_VST = 522 * MiB, WS_VWT = 524 * MiB;
constexpr size_t WS_GPRE = 526 * MiB, GPRE_UNIT = 90112;
constexpr size_t GP_W = 0, GP_QT = 16384, GP_KDT = 32768, GP_QK = 49152, GP_U = 57344;
constexpr size_t WS_OFOX = 570 * MiB, WS_OGDN = 586 * MiB, WS_LA = 602 * MiB, WS_LU = 618 * MiB, WS_ONSA = 634 * MiB;
constexpr size_t WS_SMALL = 650 * MiB;
constexpr size_t SM_CFOX = 0;
constexpr size_t SM_GG = 128 * 1024;
constexpr size_t SM_GBETA = 256 * 1024;
constexpr size_t SM_NG = 384 * 1024;
constexpr size_t SM_KC = 768 * 1024;
constexpr size_t SM_VCT = 896 * 1024;
constexpr size_t SM_EGL = 1024 * 1024;
constexpr size_t WS_LH = 652 * MiB;
constexpr size_t WS_GSN = WS_OGDN, GSN_STEP = 4 * 8192;
constexpr size_t WS_GVN = 668 * MiB, GVN_STEP = 4 * 4096;
constexpr size_t WS_END = 676 * MiB;
constexpr int CW_BAR = 4096, CW_Q = 16384;

constexpr int LDS_BYTES = 160 * 1024;
constexpr int LDS_CTL_OFF = LDS_BYTES - 256;
constexpr int NWAVES = 8, NTHREADS = 512;

#define GAS __attribute__((address_space(1)))
#define LAS __attribute__((address_space(3)))
typedef unsigned short bf16;
typedef unsigned v4u __attribute__((ext_vector_type(4)));
typedef unsigned v2u __attribute__((ext_vector_type(2)));
typedef float f32x4 __attribute__((ext_vector_type(4)));
typedef float f32x16 __attribute__((ext_vector_type(16)));
typedef short bf16x8 __attribute__((ext_vector_type(8)));
#define LDS_WAIT() asm volatile("s_waitcnt lgkmcnt(0)" ::: "memory")
#define VM_WAIT() asm volatile("s_waitcnt vmcnt(0)" ::: "memory")
__device__ __forceinline__ unsigned f2bf(float f) { unsigned u = __builtin_bit_cast(unsigned, f); return (u + 0x7fffu + ((u >> 16) & 1u)) >> 16; }
__device__ __forceinline__ unsigned pk2(float lo, float hi) { return f2bf(lo) | (f2bf(hi) << 16); }
__device__ __forceinline__ float bf2f(unsigned short b) { return __builtin_bit_cast(float, (unsigned)b << 16); }
__device__ __forceinline__ float wave_sum(float v) {
#pragma unroll
    for (int o = 1; o < 64; o <<= 1) v += __shfl_xor(v, o);
    return v;
}
__device__ __forceinline__ float fast_exp(float x) { return __builtin_amdgcn_exp2f(x * LOG2E); }
__device__ __forceinline__ float sigmoid_f(float x) { return __builtin_amdgcn_rcpf(1.0f + fast_exp(-x)); }
__device__ __forceinline__ float silu_ff(float x) { return x * sigmoid_f(x); }
__device__ __forceinline__ float softplus_f(float x) { return x > 20.f ? x : log1pf(expf(x)); }
__device__ __forceinline__ float gelu_tanh_f(float x) { const float u = 0.7978845608028654f * (x + 0.044715f * x * x * x); return 0.5f * x * (1.0f + tanhf(u)); }

#define XB_TMO      128
#define XB_XCNT(j)  (256  + 64 * (j))
#define XB_XSUB(j)  (1280 + 64 * (j))
#define XB_XGEN(j)  (2304 + 64 * (j))
#define XB_TOP      3328
#define XB_TOPGEN   3392
#define XCD_BAR_WORDS 3456
#define XB_SPIN_CAP (1u << 18)

__device__ __forceinline__ unsigned xb_ld(unsigned* p)              { return __hip_atomic_load(p, __ATOMIC_RELAXED, __HIP_MEMORY_SCOPE_AGENT); }
__device__ __forceinline__ unsigned xb_add(unsigned* p, unsigned v) { return __hip_atomic_fetch_add(p, v, __ATOMIC_RELAXED, __HIP_MEMORY_SCOPE_AGENT); }
__device__ __forceinline__ unsigned xb_xcc_id() { return (unsigned)__builtin_amdgcn_s_getreg((3 << 11) | 20) & 0xFu; }
#define XB_SPIN(cond, bar) do { unsigned _sp = 0; while (cond) { __builtin_amdgcn_s_sleep(1); \
    if ((++_sp & 255u) == 0u) { if (xb_ld(&(bar)[XB_TMO])) break; if (_sp > XB_SPIN_CAP) { atomicAdd(&(bar)[XB_TMO], 1u); break; } } } } while (0)

struct XcdBarrier {
    unsigned* bar; unsigned x;
    volatile LAS unsigned* st;
};

__device__ __forceinline__ XcdBarrier xcd_barrier_post(unsigned* bar, volatile LAS unsigned* st) {
    XcdBarrier b; b.bar = bar; b.x = xb_xcc_id(); b.st = st;
    if (threadIdx.x == 0) (void)xb_add(&bar[XB_XCNT(b.x)], 1u);
    return b;
}
__device__ __forceinline__ void xcd_barrier_complete(unsigned* bar, unsigned x, unsigned& nloc, unsigned& nx) {
    const unsigned G = gridDim.x * gridDim.y * gridDim.z;
    unsigned sum, cnt, mine, sp = 0u;
    for (;;) {
        sum = 0u; cnt = 0u; mine = 0u;
#pragma unroll
        for (unsigned j = 0; j < 16; ++j) { const unsigned c = xb_ld(&bar[XB_XCNT(j)]); sum += c; cnt += (c > 0u) ? 1u : 0u; mine = (j == x) ? c : mine; }
        if (sum == G) break;
        __builtin_amdgcn_s_sleep(1);
        if ((++sp & 255u) == 0u) { if (xb_ld(&bar[XB_TMO])) break; if (sp > XB_SPIN_CAP) { atomicAdd(&bar[XB_TMO], 1u); break; } }
    }
    nloc = mine > 0u ? mine : 1u; nx = cnt > 0u ? cnt : 1u;
}

__device__ __forceinline__ void xcd_barrier(const XcdBarrier& b) {
    asm volatile("s_waitcnt vmcnt(0)" ::: "memory");
    __syncthreads();
    if (threadIdx.x == 0) {
        unsigned* bar = b.bar;
        __builtin_amdgcn_s_waitcnt(0);
        unsigned nloc = b.st[0], nx = b.st[1];
        if (nloc == 0u) { xcd_barrier_complete(bar, b.x, nloc, nx); b.st[0] = nloc; b.st[1] = nx; }
        const unsigned old = xb_add(&bar[XB_XSUB(b.x)], 1u);
        const unsigned gen = old / nloc;
        if (old + 1u == (gen + 1u) * nloc) {
            __builtin_amdgcn_fence(__ATOMIC_RELEASE, "agent");
            asm volatile("s_waitcnt vmcnt(0)" ::: "memory");
            const unsigned og = xb_add(&bar[XB_TOP], 1u);
            const unsigned tg = og / nx;
            if (og + 1u == (tg + 1u) * nx) xb_add(&bar[XB_TOPGEN], 1u);
            else XB_SPIN(xb_ld(&bar[XB_TOPGEN]) == tg, bar);
            __builtin_amdgcn_fence(__ATOMIC_ACQUIRE, "agent");
            xb_add(&bar[XB_XGEN(b.x)], 1u);
            asm volatile("s_waitcnt vmcnt(0)" ::: "memory");
        } else {
            XB_SPIN(xb_ld(&bar[XB_XGEN(b.x)]) == gen, bar);
            __builtin_amdgcn_fence(__ATOMIC_ACQUIRE, "agent");
            asm volatile("s_waitcnt vmcnt(0)" ::: "memory");
        }
    }
    __syncthreads();
}
struct Ctx {
    LAS unsigned char* lds;
    unsigned char* ws;
    int tid, lane, wave, G, bid;
};
enum { I_X = 0, I_F1G, I_F1WG, I_F1WU, I_F1WD, I_MIXG, I_WIN, I_BIN, I_GCONV, I_GALOG, I_GDT, I_GNORM, I_LCONVW, I_LCONVB, I_LWA, I_LBA, I_LWX, I_LBX, I_LLAM,
       I_PEK, I_W1K, I_W2K, I_PEV, I_W1V, I_W2V, I_RELB, I_ONG, I_WOUT, I_F2G, I_F2WG, I_F2WU, I_F2WD, I_FING, N_IN };
__device__ __forceinline__ float* hptr() {
    float* p; asm volatile("s_load_dwordx2 %0, %1, %2\n\ts_waitcnt lgkmcnt(0)" : "=s"(p) : "s"(__builtin_amdgcn_kernarg_segment_ptr()), "n"(N_IN * 8));
    return p;
}
template <int I> __device__ __forceinline__ const float* inp() {
    const float* p; asm volatile("s_load_dwordx2 %0, %1, %2\n\ts_waitcnt lgkmcnt(0)" : "=s"(p) : "s"(__builtin_amdgcn_kernarg_segment_ptr()), "n"(I * 8));
    return p;
}

__device__ __forceinline__ void refresh_ids(Ctx& C) {
    int l; asm volatile("v_mbcnt_lo_u32_b32 %0, -1, 0\n\tv_mbcnt_hi_u32_b32 %0, -1, %0" : "=v"(l));
    C.lane = l; C.tid = C.wave * 64 + l;
}
__device__ __forceinline__ int queue_pull(Ctx& C, int qi) {
    refresh_ids(C);
    volatile LAS int* slot = (volatile LAS int*)(C.lds + LDS_CTL_OFF + 16);
    __syncthreads();
    if (C.tid == 0) *slot = (int)__hip_atomic_fetch_add((unsigned*)C.ws + CW_Q + 64 * qi, 1u, __ATOMIC_RELAXED, __HIP_MEMORY_SCOPE_AGENT);
    __syncthreads();
    return *slot;
}

__device__ __forceinline__ void transpose_item(const float* colp, int ldn, bf16* WT, int K, int n0, int k0, LAS float* scr, int lane) {
#pragma unroll 8
    for (int i = 0; i < 32; ++i) { const int kk = 2 * i + (lane >> 5); scr[kk * 33 + (lane & 31)] = colp ? colp[(size_t)(k0 + kk) * ldn] : 0.f; }
    LDS_WAIT(); asm volatile("" ::: "memory");
    const int c = lane & 7;
#pragma unroll
    for (int j = 0; j < 4; ++j) { const int n = (lane >> 3) + 8 * j; const LAS float* s = scr + (8 * c) * 33 + n;
        v4u o; o.x = pk2(s[0 * 33], s[1 * 33]); o.y = pk2(s[2 * 33], s[3 * 33]); o.z = pk2(s[4 * 33], s[5 * 33]); o.w = pk2(s[6 * 33], s[7 * 33]);
        *(GAS v4u*)(WT + (size_t)(n0 + n) * K + k0 + 8 * c) = o; }
    LDS_WAIT(); asm volatile("" ::: "memory");
}
__device__ __forceinline__ void rms_row_bf16(const float* xrow, const float* g, bf16* orow, float* hcopy, int lane) {
    const GAS f32x4* xr = (const GAS f32x4*)xrow + lane;
    f32x4 v[8]; float s = 0.f;
#pragma unroll
    for (int j = 0; j < 8; ++j) { v[j] = xr[64 * j]; s += (v[j].x * v[j].x + v[j].y * v[j].y) + (v[j].z * v[j].z + v[j].w * v[j].w); }
    const float rstd = 1.0f / sqrtf(wave_sum(s) * (1.f / D) + EPS);
    if (hcopy) { GAS f32x4* hc = (GAS f32x4*)hcopy + lane;
#pragma unroll
        for (int j = 0; j < 8; ++j) hc[64 * j] = v[j]; }
    GAS v2u* o8 = (GAS v2u*)orow + lane;
#pragma unroll
    for (int j = 0; j < 8; ++j) { const f32x4 gg = ((const GAS f32x4*)g)[lane + 64 * j]; v2u w; w.x = pk2(v[j].x * rstd * gg.x, v[j].y * rstd * gg.y); w.y = pk2(v[j].z * rstd * gg.z, v[j].w * rstd * gg.w); o8[64 * j] = w; }
}
__device__ __forceinline__ void rms_row_f32(const float* xrow, const float* g, float* orow, int lane) {
    const GAS f32x4* xr = (const GAS f32x4*)xrow + lane;
    f32x4 v[8]; float s = 0.f;
#pragma unroll
    for (int j = 0; j < 8; ++j) { v[j] = xr[64 * j]; s += (v[j].x * v[j].x + v[j].y * v[j].y) + (v[j].z * v[j].z + v[j].w * v[j].w); }
    const float rstd = 1.0f / sqrtf(wave_sum(s) * (1.f / D) + EPS);
    GAS f32x4* o = (GAS f32x4*)orow + lane;
#pragma unroll
    for (int j = 0; j < 8; ++j) { const f32x4 gg = ((const GAS f32x4*)g)[lane + 64 * j]; o[64 * j] = v[j] * rstd * gg; }
}
__device__ __forceinline__ void norm_phase_bf16(Ctx& C, const float* g) {
    refresh_ids(C);
    bf16* XN = (bf16*)(C.ws + WS_XN);
    float* const hp = hptr();
    for (int m = C.bid * NWAVES + C.wave; m < M; m += C.G * NWAVES) rms_row_bf16(hp + (size_t)m * D, g, XN + (size_t)m * D, nullptr, C.lane);
}

__device__ __forceinline__ int t5_bucket(int n) {
    if (n < 16) return n;
    int b = 16;
    b += (n >= 21); b += (n >= 27); b += (n >= 35); b += (n >= 46); b += (n >= 59); b += (n >= 77); b += (n >= 99); b += (n >= 128);
    b += (n >= 166); b += (n >= 216); b += (n >= 280); b += (n >= 363); b += (n >= 470); b += (n >= 609); b += (n >= 790);
    return b;
}

__device__ __forceinline__ void prologue_phase(Ctx& C) {
    refresh_ids(C);
    LAS float* scr = (LAS float*)(C.lds + C.wave * 16384);
    const int gw = C.bid * NWAVES + C.wave, NGW = C.G * NWAVES;
    constexpr int I_GU = 32 * 352, I_DN = 88 * 64, I_WI = 32 * 192, I_WO = 32 * 64;
    constexpr int PER_LAYER = 2 * I_GU + 2 * I_DN + I_WI + I_WO;
    for (int it = gw; it < DEPTH * PER_LAYER; it += NGW) {
        const int l = it / PER_LAYER; int r = it % PER_LAYER;
        unsigned char* wl = C.ws + WS_W + (size_t)l * W_LAYER;
        int ffn = -1;
        if (r < I_GU) ffn = 0; else { r -= I_GU;
        if (r < I_DN) ffn = 2; else { r -= I_DN;
        if (r < I_WI) ffn = 4; else { r -= I_WI;
        if (r < I_WO) ffn = 5; else { r -= I_WO;
        if (r < I_GU) ffn = 1; else { r -= I_GU; ffn = 3; } } } } }
        if (ffn <= 1) {
            const int nb = r % 352, kb = r / 352, n0 = nb * 32, j = n0 / 256, rr = n0 % 256;
            const float* wg = (ffn == 0 ? inp<I_F1WG>() : inp<I_F2WG>()) + (size_t)l * D * FF; const float* wu = (ffn == 0 ? inp<I_F1WU>() : inp<I_F2WU>()) + (size_t)l * D * FF;
            const float* colp = (rr < 128 ? wg + 128 * j + rr : wu + 128 * j + rr - 128) + (C.lane & 31);
            transpose_item(colp, FF, (bf16*)(wl + (ffn == 0 ? WO_GU1 : WO_GU2)), D, n0, kb * 64, scr, C.lane);
        } else if (ffn <= 3) {
            const int nb = r % 64, kb = r / 64;
            const float* w = (ffn == 2 ? inp<I_F1WD>() : inp<I_F2WD>()) + (size_t)l * FF * D;
            transpose_item(w + nb * 32 + (C.lane & 31), D, (bf16*)(wl + (ffn == 2 ? WO_DN1 : WO_DN2)), FF, nb * 32, kb * 64, scr, C.lane);
        } else if (ffn == 4) {
            const int nb = r % 192, kb = r / 192;
            const int sc = zsrc(nb * 32 + (C.lane & 31));
            const float* w = inp<I_WIN>() + (size_t)l * D * DIN;
            transpose_item(sc >= 0 ? w + sc : nullptr, DIN, (bf16*)(wl + WO_WIN), D, nb * 32, kb * 64, scr, C.lane);
        } else {
            const int nb = r % 64, kb = r / 64;
            const float* w = inp<I_WOUT>() + (size_t)l * D * D;
            transpose_item(w + nb * 32 + (C.lane & 31), D, (bf16*)(wl + WO_WOUT), D, nb * 32, kb * 64, scr, C.lane);
        }
    }
    float* bz = (float*)(C.ws + WS_MISC);
    for (int i = C.bid * NTHREADS + C.tid; i < DEPTH * ZC; i += C.G * NTHREADS) { const int l = i / ZC, zc = i % ZC, sc = zsrc(zc); bz[i] = sc >= 0 ? inp<I_BIN>()[l * DIN + sc] : 0.f; }
    float* tb = (float*)(C.ws + WS_MISC + 65536);
    for (int i = C.bid * NTHREADS + C.tid; i < NH * NBT; i += C.G * NTHREADS) { const int hh = i / NBT, d = i % NBT; tb[i] = inp<I_RELB>()[t5_bucket(d) * NH + hh] * LOG2E; }
    bf16* XN = (bf16*)(C.ws + WS_XN);
    float* const hp = hptr();
    for (int m = gw; m < M; m += NGW) rms_row_bf16(inp<I_X>() + (size_t)m * D, inp<I_F1G>(), XN + (size_t)m * D, hp + (size_t)m * D, C.lane);
}
typedef float f32x4v __attribute__((ext_vector_type(4)));
__device__ __forceinline__ f32x4 mfma16(bf16x8 a, bf16x8 b, f32x4 c) { return __builtin_amdgcn_mfma_f32_16x16x32_bf16(a, b, c, 0, 0, 0); }

__device__ __forceinline__ void gdn_pre_job(Ctx& C, const int l, const int job) {
    const int ch = job & 63, h = (job >> 6) & 3, b = job >> 8, t0 = ch * 64;
    const size_t row0 = (size_t)b * T + t0;
    const float* zf = (const float*)(C.ws + WS_ZF);
    unsigned char* gp = C.ws + WS_GPRE + (size_t)job * GPRE_UNIT;
    LAS float* XQ = (LAS float*)C.lds;
    LAS float* XK = XQ + 64 * 132;
    LAS float* XV = XK + 64 * 132;
    LAS bf16* KN = (LAS bf16*)(XV + 64 * 132);
    LAS bf16* KBt = KN + 64 * 136;
    LAS bf16* QN = KBt + 64 * 136;
    LAS float* SMg = (LAS float*)(QN + 64 * 136);
    LAS float* AM = XQ;
    const int tid = C.tid, lane = C.lane, wave = C.wave;
    const float* cw = inp<I_GCONV>() + (size_t)l * 4 * 1536;
    for (int idx = tid; idx < 64 * 96; idx += NTHREADS) {
        const int tt = idx / 96, c4 = idx % 96, col = c4 * 4, which = col >> 7, d = col & 127, cc = which * 512 + h * 128 + d;
        f32x4 acc = {0.f, 0.f, 0.f, 0.f};
#pragma unroll
        for (int j = 0; j < 4; ++j) { const int tq = t0 + tt - 3 + j;
            if (tq >= 0) { const f32x4 zv = *(const GAS f32x4*)(zf + ((size_t)b * T + tq) * ZFC + cc); const f32x4 wv = *(const GAS f32x4*)(cw + j * 1536 + cc); acc += zv * wv; } }
        f32x4 o; o.x = silu_ff(acc.x); o.y = silu_ff(acc.y); o.z = silu_ff(acc.z); o.w = silu_ff(acc.w);
        LAS float* dst = (which == 0 ? XQ : which == 1 ? XK : XV) + tt * 132 + d;
        *(LAS f32x4*)dst = o;
    }
    if (wave == 0) {
        const float ga = zf[(row0 + lane) * ZFC + ZF_GA + h], gb = zf[(row0 + lane) * ZFC + ZF_GB + h];
        const float g = -expf(inp<I_GALOG>()[l * 4 + h]) * softplus_f(ga + inp<I_GDT>()[l * 4 + h]);
        float gc = g;
#pragma unroll
        for (int o = 1; o < 64; o <<= 1) { const float v = __shfl_up(gc, o); if (lane >= o) gc += v; }
        const float gl = __shfl(gc, 63);
        SMg[lane] = gc; SMg[64 + lane] = sigmoid_f(gb); SMg[128 + lane] = expf(gc); SMg[192 + lane] = expf(gl - gc);
        if (lane == 0) ((float*)(C.ws + WS_SMALL + SM_EGL))[job] = expf(gl);
    }
    __syncthreads();
    for (int r = wave * 8; r < wave * 8 + 8; ++r) {
        const float q0 = XQ[r * 132 + lane], q1 = XQ[r * 132 + 64 + lane], k0 = XK[r * 132 + lane], k1 = XK[r * 132 + 64 + lane];
        const float sq = wave_sum(q0 * q0 + q1 * q1), sk = wave_sum(k0 * k0 + k1 * k1);
        if (lane == 0) { SMg[256 + r] = 1.0f / sqrtf(sq + EPS); SMg[320 + r] = 1.0f / sqrtf(sk + EPS); }
    }
    __syncthreads();
    const float qscale = 0.08838834764831845f;
    for (int idx = tid; idx < 1024; idx += NTHREADS) {
        const int tt = idx >> 4, d0 = (idx & 15) * 8;
        const float rq = SMg[256 + tt] * qscale, rk = SMg[320 + tt], be = SMg[64 + tt], eg = SMg[128 + tt];
        const f32x4 qa = *(LAS f32x4*)(XQ + tt * 132 + d0), qb = *(LAS f32x4*)(XQ + tt * 132 + d0 + 4), ka = *(LAS f32x4*)(XK + tt * 132 + d0), kb = *(LAS f32x4*)(XK + tt * 132 + d0 + 4);
        v4u w;
        w.x = pk2(ka.x * rk, ka.y * rk); w.y = pk2(ka.z * rk, ka.w * rk); w.z = pk2(kb.x * rk, kb.y * rk); w.w = pk2(kb.z * rk, kb.w * rk);
        *(LAS v4u*)(KN + tt * 136 + d0) = w;
        const float rkb = rk * be;
        w.x = pk2(ka.x * rkb, ka.y * rkb); w.y = pk2(ka.z * rkb, ka.w * rkb); w.z = pk2(kb.x * rkb, kb.y * rkb); w.w = pk2(kb.z * rkb, kb.w * rkb);
        *(LAS v4u*)(KBt + tt * 136 + d0) = w;
        w.x = pk2(qa.x * rq, qa.y * rq); w.y = pk2(qa.z * rq, qa.w * rq); w.z = pk2(qb.x * rq, qb.y * rq); w.w = pk2(qb.z * rq, qb.w * rq);
        *(LAS v4u*)(QN + tt * 136 + d0) = w;
        const float rqe = rq * eg;
        w.x = pk2(qa.x * rqe, qa.y * rqe); w.y = pk2(qa.z * rqe, qa.w * rqe); w.z = pk2(qb.x * rqe, qb.y * rqe); w.w = pk2(qb.z * rqe, qb.w * rqe);
        *(GAS v4u*)(gp + GP_QT + (size_t)(tt * 128 + d0) * 2) = w;
    }
    for (int idx = tid; idx < 1024; idx += NTHREADS) {
        const int d = idx & 127, tg = (idx >> 7) * 8;
        float v[8];
#pragma unroll
        for (int i = 0; i < 8; ++i) v[i] = XK[(tg + i) * 132 + d] * SMg[320 + tg + i] * SMg[192 + tg + i];
        v4u w; w.x = pk2(v[0], v[1]); w.y = pk2(v[2], v[3]); w.z = pk2(v[4], v[5]); w.w = pk2(v[6], v[7]);
        *(GAS v4u*)(gp + GP_KDT + (size_t)(d * 64 + tg) * 2) = w;
    }
    __syncthreads();
    for (int jj = wave; jj < 26; jj += NWAVES) {
        bf16* qkout = (bf16*)(gp + GP_QK);
        const int fr = lane & 15, fq = lane >> 4;
        if (jj >= 20) {
            const int z = jj - 20, ti = z < 3 ? 0 : (z < 5 ? 1 : 2), tj = z < 3 ? z + 1 : (z < 5 ? z - 1 : 3);
#pragma unroll
            for (int r = 0; r < 4; ++r) qkout[(16 * ti + 4 * fq + r) * 64 + 16 * tj + fr] = 0;
            continue;
        }
        const int which = jj / 10, tix = jj % 10;
        const int ti = tix < 1 ? 0 : (tix < 3 ? 1 : (tix < 6 ? 2 : 3)), tj = tix - (ti * (ti + 1)) / 2;
        const LAS bf16* Ap = (which == 0 ? KBt : QN) + (16 * ti + fr) * 136 + 8 * fq;
        const LAS bf16* Bp = KN + (16 * tj + fr) * 136 + 8 * fq;
        f32x4 acc = {0.f, 0.f, 0.f, 0.f};
#pragma unroll
        for (int kk = 0; kk < 4; ++kk) acc = mfma16(*(const LAS bf16x8*)(Ap + 32 * kk), *(const LAS bf16x8*)(Bp + 32 * kk), acc);
        const int j = 16 * tj + fr; const float gcj = SMg[j];
#pragma unroll
        for (int r = 0; r < 4; ++r) { const int i = 16 * ti + 4 * fq + r; const float dec = expf(SMg[i] - gcj);
            if (which == 0) AM[i * 68 + j] = (i > j) ? acc[r] * dec : 0.f;
            else qkout[i * 64 + j] = (bf16)f2bf((i >= j) ? acc[r] * dec : 0.f); }
    }
    __syncthreads();
    if (wave < 4) {
        const int c = wave * 64 + lane, d = c & 127; const bool isW = c >= 128;
        int vzero; asm volatile("v_mov_b32 %0, 0" : "=v"(vzero));
        const LAS float* AMv = AM + vzero; const LAS float* SMv = SMg + vzero;
        float X[64];
#pragma unroll
        for (int i = 0; i < 64; ++i) X[i] = isW ? XK[i * 132 + d] * SMv[320 + i] * SMv[64 + i] * SMv[128 + i] : XV[i * 132 + d] * SMv[64 + i];
#pragma unroll
        for (int i = 1; i < 64; ++i) {
            float s = X[i];
#pragma unroll
            for (int j4 = 0; j4 < (i + 3) / 4; ++j4) { const f32x4 a = *(const LAS f32x4*)(AMv + i * 68 + 4 * j4);
                if (4 * j4 + 0 < i) s -= a.x * X[4 * j4 + 0];
                if (4 * j4 + 1 < i) s -= a.y * X[4 * j4 + 1];
                if (4 * j4 + 2 < i) s -= a.z * X[4 * j4 + 2];
                if (4 * j4 + 3 < i) s -= a.w * X[4 * j4 + 3]; }
            X[i] = s;
        }
        if (isW) { bf16* Wo = (bf16*)(gp + GP_W);
#pragma unroll
            for (int i = 0; i < 64; ++i) Wo[i * 128 + d] = (bf16)f2bf(X[i]); }
        else { float* Uo = (float*)(gp + GP_U);
#pragma unroll
            for (int i = 0; i < 64; ++i) Uo[i * 128 + d] = X[i]; }
    }
}

__device__ __forceinline__ void nsa_compress_job(Ctx& C, const int l, const int job) {
    const int rg = job & 31, b = (job >> 5) & 1, kv = job >> 6, n0 = rg * 8;
    const float* zf = (const float*)(C.ws + WS_ZF) + (kv ? ZF_NVC : ZF_NKC);
    const float* pe = (kv ? inp<I_PEV>() : inp<I_PEK>()) + (size_t)l * 32 * 128;
    const float* w1 = (kv ? inp<I_W1V>() : inp<I_W1K>()) + (size_t)l * 4096 * 128;
    const float* w2 = (kv ? inp<I_W2V>() : inp<I_W2K>()) + (size_t)l * 128 * 128;
    LAS float* XS = (LAS float*)C.lds;
    LAS float* PE = XS + 144 * 128;
    LAS float* RED = PE + 32 * 128;
    LAS float* HID = RED + 4 * 9 * 128;
    const int tid = C.tid;
    for (int idx = tid; idx < 144 * 32; idx += NTHREADS) { const int tk = idx >> 5, d4 = (idx & 31) * 4, t = 16 * n0 + tk;
        f32x4 v = {0.f, 0.f, 0.f, 0.f}; if (t < T) v = *(const GAS f32x4*)(zf + ((size_t)b * T + t) * ZFC + d4);
        *(LAS f32x4*)(XS + tk * 128 + d4) = v; }
    for (int idx = tid; idx < 32 * 32; idx += NTHREADS) *(LAS f32x4*)(PE + idx * 4) = *(const GAS f32x4*)(pe + idx * 4);
    __syncthreads();
    const int c = tid & 127, kq = tid >> 7;
    float acc[8], accp = 0.f;
#pragma unroll
    for (int r = 0; r < 8; ++r) acc[r] = 0.f;
    for (int i = 8 * kq; i < 8 * kq + 8; ++i) {
#pragma unroll 2
        for (int d4 = 0; d4 < 128; d4 += 4) {
            const float* wp = w1 + (size_t)(i * 128 + d4) * 128 + c;
            const float w0 = wp[0], w1v = wp[128], w2v = wp[256], w3 = wp[384];
            const f32x4 p = *(const LAS f32x4*)(PE + i * 128 + d4);
            accp += p.x * w0 + p.y * w1v + p.z * w2v + p.w * w3;
#pragma unroll
            for (int r = 0; r < 8; ++r) { const f32x4 x = *(const LAS f32x4*)(XS + (16 * r + i) * 128 + d4); acc[r] += x.x * w0 + x.y * w1v + x.z * w2v + x.w * w3; }
        }
    }
#pragma unroll
    for (int r = 0; r < 8; ++r) RED[(kq * 9 + r) * 128 + c] = acc[r];
    RED[(kq * 9 + 8) * 128 + c] = accp;
    __syncthreads();
    for (int idx = tid; idx < 8 * 128; idx += NTHREADS) { const int r = idx >> 7, cc = idx & 127;
        float s = 0.f;
#pragma unroll
        for (int q = 0; q < 4; ++q) s += RED[(q * 9 + r) * 128 + cc] + RED[(q * 9 + 8) * 128 + cc];
        HID[r * 128 + cc] = gelu_tanh_f(s); }
    __syncthreads();
    {
        float o0 = 0.f, o1 = 0.f;
#pragma unroll 4
        for (int cc = 0; cc < 128; ++cc) { const float w = w2[cc * 128 + c]; o0 += HID[(2 * kq) * 128 + cc] * w; o1 += HID[(2 * kq + 1) * 128 + cc] * w; }
        const int na = n0 + 2 * kq, nb = na + 1;
        if (na >= NCMP) o0 = 0.f; if (nb >= NCMP) o1 = 0.f;
        if (kv == 0) { bf16* KC = (bf16*)(C.ws + WS_SMALL + SM_KC) + (size_t)b * NCMPP * 128; KC[na * 128 + c] = (bf16)f2bf(o0); KC[nb * 128 + c] = (bf16)f2bf(o1); }
        else { bf16* VCT = (bf16*)(C.ws + WS_SMALL + SM_VCT) + (size_t)b * 128 * NCMPP; VCT[c * NCMPP + na] = (bf16)f2bf(o0); VCT[c * NCMPP + nb] = (bf16)f2bf(o1); }
    }
}

__device__ __forceinline__ void lru_gate_job(Ctx& C, const int l, const int job) {
    const int wave = C.wave, lane = C.lane, cbase = wave * 64, ch = cbase + lane;
    const size_t rowb = (size_t)job * 32; const int tpos = (int)(rowb % T);
    const float* zf = (const float*)(C.ws + WS_ZF) + ZF_LX + ch;
    LAS float* XS = (LAS float*)C.lds + wave * 2048;
    const float* cw = inp<I_LCONVW>() + (size_t)l * 4 * 512 + ch; const float cb = inp<I_LCONVB>()[l * 512 + ch];
    const float w0 = cw[0], w1 = cw[512], w2 = cw[1024], w3 = cw[1536];
    float xc[32];
    float zm3 = tpos >= 3 ? zf[(rowb - 3) * ZFC] : 0.f, zm2 = tpos >= 2 ? zf[(rowb - 2) * ZFC] : 0.f, zm1 = tpos >= 1 ? zf[(rowb - 1) * ZFC] : 0.f;
#pragma unroll
    for (int tt = 0; tt < 32; ++tt) { const float z0 = zf[(rowb + tt) * ZFC]; xc[tt] = w0 * zm3 + w1 * zm2 + w2 * zm1 + w3 * z0 + cb; zm3 = zm2; zm2 = zm1; zm1 = z0; }
#pragma unroll
    for (int t4 = 0; t4 < 8; ++t4) *(LAS f32x4*)(XS + lane * 32 + 4 * t4) = (f32x4){xc[4 * t4], xc[4 * t4 + 1], xc[4 * t4 + 2], xc[4 * t4 + 3]};
    LDS_WAIT(); asm volatile("" ::: "memory");
    float aA[32], aX[32];
#pragma unroll
    for (int tt = 0; tt < 32; ++tt) { aA[tt] = 0.f; aX[tt] = 0.f; }
    const float* wa = inp<I_LWA>() + ((size_t)l * 8 + wave) * 4096 + lane; const float* wx = inp<I_LWX>() + ((size_t)l * 8 + wave) * 4096 + lane;
#pragma unroll 2
    for (int d = 0; d < 64; ++d) { const float va = wa[d * 64], vx = wx[d * 64];
#pragma unroll
        for (int t4 = 0; t4 < 8; ++t4) { const f32x4 x = *(const LAS f32x4*)(XS + d * 32 + 4 * t4);
            aA[4 * t4] += x.x * va; aA[4 * t4 + 1] += x.y * va; aA[4 * t4 + 2] += x.z * va; aA[4 * t4 + 3] += x.w * va;
            aX[4 * t4] += x.x * vx; aX[4 * t4 + 1] += x.y * vx; aX[4 * t4 + 2] += x.z * vx; aX[4 * t4 + 3] += x.w * vx; } }
    const float ba = inp<I_LBA>()[l * 512 + ch], bx = inp<I_LBX>()[l * 512 + ch], spl = softplus_f(-inp<I_LLAM>()[l * 512 + ch]);
    float* LA = (float*)(C.ws + WS_LA) + ch; float* LU = (float*)(C.ws + WS_LU) + ch;
#pragma unroll
    for (int tt = 0; tt < 32; ++tt) { const float r = sigmoid_f(aA[tt] + ba), ig = sigmoid_f(aX[tt] + bx), la = -8.0f * r * spl;
        LA[(rowb + tt) * 512] = expf(la); LU[(rowb + tt) * 512] = sqrtf(-expm1f(2.0f * la)) * (ig * xc[tt]); }
    LDS_WAIT();
}

__device__ __forceinline__ void vtrans_job(Ctx& C, const int job) {
    const size_t rowb = (size_t)job * 64; const int b = (int)(rowb / T), t0 = (int)(rowb % T);
    const bf16* zb = (const bf16*)(C.ws + WS_ZB);
    LAS bf16* TL = (LAS bf16*)C.lds;
    for (int idx = C.tid; idx < 64 * 96; idx += NTHREADS) { const int tt = idx / 96, c8 = (idx % 96) * 8;
        const int sc = c8 < 512 ? ZB_FV + c8 : (c8 < 640 ? ZB_NVS + (c8 - 512) : ZB_NVW + (c8 - 640));
        *(LAS v4u*)(TL + tt * 776 + c8) = *(const GAS v4u*)(zb + (rowb + tt) * ZBC + sc); }
    __syncthreads();
    for (int idx = C.tid; idx < 768 * 8; idx += NTHREADS) { const int c = idx % 768, tg = (idx / 768) * 8;
        unsigned short v[8];
#pragma unroll
        for (int i = 0; i < 8; ++i) v[i] = TL[(tg + i) * 776 + c];
        v4u w; w.x = v[0] | ((unsigned)v[1] << 16); w.y = v[2] | ((unsigned)v[3] << 16); w.z = v[4] | ((unsigned)v[5] << 16); w.w = v[6] | ((unsigned)v[7] << 16);
        bf16* dst = c < 512 ? (bf16*)(C.ws + WS_VFT) + ((size_t)(b * 4 + (c >> 7)) * 128 + (c & 127)) * T
                  : (c < 640 ? (bf16*)(C.ws + WS_VST) + ((size_t)b * 128 + (c - 512)) * T : (bf16*)(C.ws + WS_VWT) + ((size_t)b * 128 + (c - 640)) * T);
        *(GAS v4u*)(dst + t0 + tg) = w; }
}

__device__ __forceinline__ void fox_cumsum_job(Ctx& C, const int job) {
    const int b = job >> 2, h = job & 3;
    const float* zf = (const float*)(C.ws + WS_ZF) + ZF_FF + h;
    float* cf = (float*)(C.ws + WS_SMALL + SM_CFOX) + (size_t)job * T;
    LAS double* WS8 = (LAS double*)C.lds;
    double v[8], run = 0.0;
#pragma unroll
    for (int i = 0; i < 8; ++i) { const float x = zf[((size_t)b * T + C.tid * 8 + i) * ZFC]; const float ls = fminf(x, 0.f) - log1pf(expf(-fabsf(x))); run += (double)ls; v[i] = run; }
    double sc = run;
#pragma unroll
    for (int o = 1; o < 64; o <<= 1) { const double u = __shfl_up(sc, o); if (C.lane >= o) sc += u; }
    if (C.lane == 63) WS8[C.wave] = sc;
    __syncthreads();
    double off = sc - run;
    for (int w = 0; w < C.wave; ++w) off += WS8[w];
#pragma unroll
    for (int i = 0; i < 8; ++i) cf[C.tid * 8 + i] = (float)(off + v[i]);
}

#define QUEUE_LOOP(qi, njobs, call) for (;;) { const int j = queue_pull(C, (qi)); if (j >= (njobs)) break; call; }
__device__ __forceinline__ void pre_phase(Ctx& C, const int l, const int qoff) {
    const int q0 = 16 * l + qoff;
    QUEUE_LOOP(q0 + 0, 128, nsa_compress_job(C, l, j));
    QUEUE_LOOP(q0 + 1, 512, gdn_pre_job(C, l, j));
    QUEUE_LOOP(q0 + 2, 256, lru_gate_job(C, l, j));
    QUEUE_LOOP(q0 + 3, 128, vtrans_job(C, j));
    QUEUE_LOOP(q0 + 4, 8, fox_cumsum_job(C, j));
}
__device__ __forceinline__ f32x16 mfma32(bf16x8 a, bf16x8 b, f32x16 c) { return __builtin_amdgcn_mfma_f32_32x32x16_bf16(a, b, c, 0, 0, 0); }
__device__ __forceinline__ bf16x8 pack8(float a0, float a1, float a2, float a3, float a4, float a5, float a6, float a7) {
    v4u w; w.x = pg8::cvt_pk_bf16(a0, a1); w.y = pg8::cvt_pk_bf16(a2, a3); w.z = pg8::cvt_pk_bf16(a4, a5); w.w = pg8::cvt_pk_bf16(a6, a7);
    return __builtin_bit_cast(bf16x8, w);
}
constexpr int AT_KT = 0, AT_VT = 17408, AT_CT = 35840, AT_BT = 36096, AT_IMP = 49152, AT_SEL = 65536, AT_Q = 66560;
constexpr float SC_LOG2 = 0.1275174326f;
enum { MODE_FOX = 0, MODE_CMP = 1, MODE_SEL = 2, MODE_WIN = 3 };

struct TileSrc { const bf16* K; int ldk; const bf16* VT; int ldv; };
struct TileRegs { v4u k[2], v[2]; };
struct TileOff { unsigned k[2], v[2]; };
__device__ __forceinline__ void tile_offsets(const TileSrc& s, int tid, TileOff& o) {
#pragma unroll
    for (int i = 0; i < 2; ++i) { const int ck = tid + NTHREADS * i;
        o.k[i] = (unsigned)(((ck >> 4) * s.ldk + (ck & 15) * 8) * 2);
        o.v[i] = (unsigned)(((ck >> 3) * s.ldv + (ck & 7) * 8) * 2); }
}
__device__ __forceinline__ void load_tile(const TileSrc& s, const TileOff& o, int k0, TileRegs& r) {
    const char* kb = (const char*)s.K + (size_t)k0 * s.ldk * 2; const char* vb = (const char*)s.VT + (size_t)k0 * 2;
#pragma unroll
    for (int i = 0; i < 2; ++i) { r.k[i] = *(const GAS v4u*)(kb + o.k[i]); r.v[i] = *(const GAS v4u*)(vb + o.v[i]); }
}
__device__ __forceinline__ void store_tile(LAS unsigned char* lds, int tid, const TileRegs& r) {
    LAS bf16* KT = (LAS bf16*)(lds + AT_KT); LAS bf16* VT = (LAS bf16*)(lds + AT_VT);
#pragma unroll
    for (int i = 0; i < 2; ++i) { const int ck = tid + NTHREADS * i;
        *(LAS v4u*)(KT + (ck >> 4) * 136 + (ck & 15) * 8) = r.k[i];
        *(LAS v4u*)(VT + (ck >> 3) * 72 + (ck & 7) * 8) = r.v[i]; }
}
template <bool QL>
__device__ __forceinline__ f32x16 score_block(const LAS bf16* KT, const bf16x8 (&qf)[8], const LAS bf16* ql, const int kb, const int lane) {
    const int r32 = lane & 31, hi = lane >> 5;
    const int prow = (r32 & 19) | ((r32 & 4) << 1) | ((r32 & 8) >> 1);
    const LAS bf16* p = KT + (32 * kb + prow) * 136 + 8 * hi;
    const LAS bf16* q = ql + r32 * 136 + 8 * hi;
    __builtin_amdgcn_sched_barrier(0);
    bf16x8 kf[8], qq[8];
#pragma unroll
    for (int c = 0; c < 8; ++c) { kf[c] = *(const LAS bf16x8*)(p + 16 * c); if (QL) qq[c] = *(const LAS bf16x8*)(q + 16 * c); }
    __builtin_amdgcn_sched_barrier(0);
    f32x16 sa, sb;
#pragma unroll
    for (int i = 0; i < 16; ++i) { sa[i] = 0.f; sb[i] = 0.f; }
#pragma unroll
    for (int c = 0; c < 8; c += 2) { sa = mfma32(kf[c], QL ? qq[c] : qf[c], sa); sb = mfma32(kf[c + 1], QL ? qq[c + 1] : qf[c + 1], sb); }
    __builtin_amdgcn_sched_barrier(0);
    return sa + sb;
}
__device__ __forceinline__ void pv_block(const LAS bf16* VT, const f32x16& p, const int kb, f32x16 (&O)[4], const int lane) {
    const int r32 = lane & 31, hi = lane >> 5;
    bf16x8 vf[2][4];
#pragma unroll
    for (int cc = 0; cc < 2; ++cc)
#pragma unroll
        for (int db = 0; db < 4; ++db) vf[cc][db] = *(const LAS bf16x8*)(VT + (32 * db + r32) * 72 + 32 * kb + 16 * cc + 8 * hi);
    const bf16x8 pf0 = pack8(p[0], p[1], p[2], p[3], p[4], p[5], p[6], p[7]), pf1 = pack8(p[8], p[9], p[10], p[11], p[12], p[13], p[14], p[15]);
    __builtin_amdgcn_sched_barrier(0);
#pragma unroll
    for (int db = 0; db < 4; ++db) O[db] = mfma32(vf[0][db], pf0, O[db]);
#pragma unroll
    for (int db = 0; db < 4; ++db) O[db] = mfma32(vf[1][db], pf1, O[db]);
    __builtin_amdgcn_sched_barrier(0);
}

#define SOFTMAX_RESCALE(mx) do { mx = fmaxf(mx, __shfl_xor(mx, 32)); \
        if (__builtin_amdgcn_ballot_w64(mx > m) != 0ull) { const float alpha_ = __builtin_amdgcn_exp2f(m - mx); l *= alpha_; \
            _Pragma("unroll") for (int db_ = 0; db_ < 4; ++db_) O[db_] *= alpha_; } \
        m = mx; } while (0)
template <int MODE>
__device__ __forceinline__ void compute_tile(LAS unsigned char* lds, const int j, const bf16x8 (&qf)[8], const LAS bf16* ql, f32x16 (&O)[4], float& m, float& l,
                                             const int tq, const int q0w, const float ctq2  , const int head, const bool selbit, const int lane) {
    const LAS bf16* KT = (const LAS bf16*)(lds + AT_KT); const LAS bf16* VT = (const LAS bf16*)(lds + AT_VT);
    const LAS float* CT = (const LAS float*)(lds + AT_CT); const LAS float* BT = (const LAS float*)(lds + AT_BT) + head * 792;
    const int hi = lane >> 5, k0 = 64 * j;
    if constexpr (MODE == MODE_FOX) {
#pragma unroll
        for (int kb = 0; kb < 2; ++kb) {
            f32x16 s = score_block<false>(KT, qf, ql, kb, lane);
            const LAS float* ct = CT + 32 * kb + 8 * hi;
            float mx = m, rs = 0.f;
            if (k0 + 32 * kb + 31 <= q0w) {
#pragma unroll
                for (int r = 0; r < 16; ++r) { const float v = __builtin_fmaf(s[r], SC_LOG2, ctq2 - ct[16 * (r >> 3) + (r & 7)]); s[r] = v; mx = fmaxf(mx, v); }
                SOFTMAX_RESCALE(mx);
#pragma unroll
                for (int r = 0; r < 16; ++r) { const float p = __builtin_amdgcn_exp2f(s[r] - mx); s[r] = p; rs += p; }
            } else {
                const int lim = tq - k0 - 32 * kb - 8 * hi;
#pragma unroll
                for (int r = 0; r < 16; ++r) {
                    float v = __builtin_fmaf(s[r], SC_LOG2, ctq2 - ct[16 * (r >> 3) + (r & 7)]);
                    v = (16 * (r >> 3) + (r & 7) <= lim) ? v : -1e30f; s[r] = v; mx = fmaxf(mx, v);
                }
                SOFTMAX_RESCALE(mx);
#pragma unroll
                for (int r = 0; r < 16; ++r) { const float p = s[r] > -1e29f ? __builtin_amdgcn_exp2f(s[r] - mx) : 0.f; s[r] = p; rs += p; }
            }
            l += rs;
            pv_block(VT, s, kb, O, lane);
        }
    } else {
        const bool far = (MODE == MODE_SEL) && (q0w - (k0 + 63) >= 790);
        const float bfar = BT[790];
#pragma unroll
        for (int kb = 0; kb < 2; ++kb) {
            f32x16 s = score_block<true>(KT, qf, ql, kb, lane);
            float rs = 0.f;
            if (far) {
                float smax = s[0];
#pragma unroll
                for (int r = 1; r < 16; ++r) smax = fmaxf(smax, s[r]);
                float mx = fmaxf(m, selbit ? __builtin_fmaf(smax, SC_LOG2, bfar) : -1e30f);
                SOFTMAX_RESCALE(mx);
                const float c0 = selbit ? bfar - mx : -1e30f;
#pragma unroll
                for (int r = 0; r < 16; ++r) { const float p = __builtin_amdgcn_exp2f(__builtin_fmaf(s[r], SC_LOG2, c0)); s[r] = p; rs += p; }
            } else {
                float mx = m;
#pragma unroll
                for (int r = 0; r < 16; ++r) {
                    const int dist = tq - (k0 + 32 * kb + 16 * (r >> 3) + 8 * hi + (r & 7));
                    const bool valid = (MODE == MODE_SEL) ? (selbit && dist >= 0) : (dist >= 0 && dist < WINDOW);
                    const int di = dist < 0 ? 0 : (dist > 790 ? 790 : dist);
                    float v = __builtin_fmaf(s[r], SC_LOG2, BT[di]);
                    v = valid ? v : -1e30f; s[r] = v; mx = fmaxf(mx, v);
                }
                SOFTMAX_RESCALE(mx);
#pragma unroll
                for (int r = 0; r < 16; ++r) { const float p = s[r] > -1e29f ? __builtin_amdgcn_exp2f(s[r] - mx) : 0.f; s[r] = p; rs += p; }
            }
            l += rs;
            pv_block(VT, s, kb, O, lane);
        }
    }
}

template <int MODE>
__device__ __forceinline__ void run_branch(Ctx& C, const TileSrc& src, unsigned long long tmask, const bf16x8 (&qf)[8], const LAS bf16* ql, f32x16 (&O)[4], float& m, float& l,
                                           const int tq, const int q0w, const float* cfrow, const float ctq, const int head, const unsigned long long selq) {
    if (tmask == 0ull) return;
    LAS float* CT = (LAS float*)(C.lds + AT_CT);
    constexpr bool PREF = true;
    TileRegs tr; float creg = 0.f; TileOff toff; tile_offsets(src, C.tid, toff);
    int j = __builtin_ctzll(tmask); tmask &= tmask - 1;
    if (PREF) { load_tile(src, toff, 64 * j, tr); if (MODE == MODE_FOX && C.tid < 64) creg = cfrow[64 * j + C.tid]; }
    for (;;) {
        __syncthreads();
        if (!PREF) load_tile(src, toff, 64 * j, tr);
        store_tile(C.lds, C.tid, tr);
        if (MODE == MODE_FOX && C.tid < 64) CT[C.tid] = creg * LOG2E;
        __syncthreads();
        const int jn = tmask ? __builtin_ctzll(tmask) : -1;
        if (jn >= 0) { tmask &= tmask - 1; if (PREF) { load_tile(src, toff, 64 * jn, tr); if (MODE == MODE_FOX && C.tid < 64) creg = cfrow[64 * jn + C.tid]; } }
        bool active = true;
        if (MODE == MODE_FOX || MODE == MODE_SEL) active = (64 * j <= q0w + 31);
        if (MODE == MODE_WIN) active = (64 * j <= q0w + 31) && (64 * j + 63 >= q0w - (WINDOW - 1));
        if (active) compute_tile<MODE>(C.lds, j, qf, ql, O, m, l, tq, q0w, ctq * LOG2E, head, (bool)((selq >> j) & 1ull), C.lane);
        if (jn < 0) break;
        j = jn;
    }
}
__device__ __forceinline__ void store_out(float* outp  , const f32x16 (&O)[4], const float sc, const int hi, const bool accumulate) {
#pragma unroll
    for (int db = 0; db < 4; ++db)
#pragma unroll
        for (int r4 = 0; r4 < 4; ++r4) { float* p = outp + 32 * db + 8 * r4 + 4 * hi;
            f32x4 v = {O[db][4 * r4] * sc, O[db][4 * r4 + 1] * sc, O[db][4 * r4 + 2] * sc, O[db][4 * r4 + 3] * sc};
            if (accumulate) v += *(const GAS f32x4*)p;
            *(GAS f32x4*)p = v; }
}
__device__ __forceinline__ void load_q(const bf16* qrow  , bf16x8 (&qf)[8], const int hi) {
#pragma unroll
    for (int c = 0; c < 8; ++c) qf[c] = *(const GAS bf16x8*)(qrow + 16 * c + 8 * hi);
}
#define ZERO_STATE(O, m, l) do { _Pragma("unroll") for (int _d = 0; _d < 4; ++_d) _Pragma("unroll") for (int _i = 0; _i < 16; ++_i) O[_d][_i] = 0.f; m = -1e30f; l = 0.f; } while (0)

__device__ __forceinline__ void fox_item(Ctx& C, const int b, const int h, const int qb) {
    const int lane = C.lane, hi = lane >> 5, q0w = 256 * qb + 32 * C.wave, tq = q0w + (lane & 31);
    const bf16* zb = (const bf16*)(C.ws + WS_ZB);
    const size_t row = (size_t)b * T + tq;
    bf16x8 qf[8]; load_q(zb + row * ZBC + ZB_FQ + h * 128, qf, hi);
    const float* cf = (const float*)(C.ws + WS_SMALL + SM_CFOX) + (size_t)(b * 4 + h) * T;
    const float ctq = cf[tq];
    TileSrc src{zb + (size_t)b * T * ZBC + ZB_FK + h * 128, ZBC, (const bf16*)(C.ws + WS_VFT) + (size_t)(b * 4 + h) * 128 * T, T};
    f32x16 O[4]; float m, l; ZERO_STATE(O, m, l);
    const int nt = 4 * qb + 4;
    run_branch<MODE_FOX>(C, src, nt >= 64 ? ~0ull : ((1ull << nt) - 1ull), qf, (const LAS bf16*)C.lds, O, m, l, tq, q0w, cf, ctq, 0, 0ull);
    const float lt = l + __shfl_xor(l, 32);
    store_out((float*)(C.ws + WS_OFOX) + row * 512 + h * 128, O, lt > 0.f ? 1.0f / lt : 0.f, hi, false);
}

__device__ __forceinline__ void nsa_item(Ctx& C, const int b, const int ub) {
    const int lane = C.lane, r32 = lane & 31, hi = lane >> 5, wave = C.wave, h = wave & 3, qh = wave >> 2;
    const int t0 = 64 * ub, q0w = t0 + 32 * qh, tq = q0w + r32, cur = ub;
    const size_t row = (size_t)b * T + tq;
    const bf16* zb = (const bf16*)(C.ws + WS_ZB);
    const float* zf = (const float*)(C.ws + WS_ZF);
    LAS float* BT = (LAS float*)(C.lds + AT_BT); LAS float* IMP = (LAS float*)(C.lds + AT_IMP);
    LAS unsigned long long* SEL = (LAS unsigned long long*)(C.lds + AT_SEL);
    { const float* tb = (const float*)(C.ws + WS_MISC + 65536);
      for (int i = C.tid; i < NH * NBT; i += NTHREADS) BT[(i / NBT) * 792 + (i % NBT)] = tb[i]; }
    bf16x8 qf[8];
#pragma unroll
    for (int c = 0; c < 8; ++c) qf[c] = (bf16x8){0, 0, 0, 0, 0, 0, 0, 0};
    LAS bf16* QL = (LAS bf16*)(C.lds + AT_Q) + wave * (32 * 136);
#pragma unroll
    for (int i = 0; i < 8; ++i) { const int id = lane + 64 * i, rr = id >> 4, c16 = id & 15;
        *(LAS v4u*)(QL + rr * 136 + c16 * 8) = *(const GAS v4u*)(zb + ((size_t)b * T + q0w + rr) * ZBC + ZB_NQ + h * 128 + c16 * 8); }
    f32x16 O[4]; float m, l;
    {
        ZERO_STATE(O, m, l);
        float G[32];
#pragma unroll
        for (int i = 0; i < 32; ++i) G[i] = 0.f;
        float xprev = 0.f;
        const int nkeys = 4 * ub + 3, ntc = (nkeys + 63) >> 6;
        TileSrc src{(const bf16*)(C.ws + WS_SMALL + SM_KC) + (size_t)b * NCMPP * 128, 128, (const bf16*)(C.ws + WS_SMALL + SM_VCT) + (size_t)b * 128 * NCMPP, NCMPP};
        const LAS bf16* KT = (const LAS bf16*)(C.lds + AT_KT); const LAS bf16* VT = (const LAS bf16*)(C.lds + AT_VT); const LAS float* BTh = BT + h * 792;
#pragma unroll
        for (int j = 0; j < 4; ++j) {
            if (j < ntc) {
                TileRegs tr; TileOff toff; tile_offsets(src, C.tid, toff); load_tile(src, toff, 64 * j, tr);
                __syncthreads();
                store_tile(C.lds, C.tid, tr);
                __syncthreads();
                f32x16 s[2];
                s[0] = score_block<true>(KT, qf, QL, 0, lane); s[1] = score_block<true>(KT, qf, QL, 1, lane);
                float mx = m;
#pragma unroll
                for (int kb = 0; kb < 2; ++kb)
#pragma unroll
                    for (int r = 0; r < 16; ++r) {
                        const int n = 64 * j + 32 * kb + 16 * (r >> 3) + 8 * hi + (r & 7), dist = tq - 16 * n - 31;
                        const int di = dist < 0 ? 0 : (dist > 790 ? 790 : dist);
                        float v = s[kb][r] * SC_LOG2 + BTh[di];
                        v = dist >= 0 ? v : -1e30f; s[kb][r] = v; mx = fmaxf(mx, v);
                    }
                mx = fmaxf(mx, __shfl_xor(mx, 32));
                const float alpha = __builtin_amdgcn_exp2f(m - mx); m = mx;
                float rs = 0.f;
#pragma unroll
                for (int kb = 0; kb < 2; ++kb)
#pragma unroll
                    for (int r = 0; r < 16; ++r) { const float p = s[kb][r] > -1e29f ? __builtin_amdgcn_exp2f(s[kb][r] - mx) : 0.f; s[kb][r] = p; rs += p; }
                l = l * alpha + rs;
#pragma unroll
                for (int db = 0; db < 4; ++db) O[db] *= alpha;
#pragma unroll
                for (int gi = 0; gi < 8 * j; ++gi) G[gi] *= alpha;
                xprev *= alpha;
#pragma unroll
                for (int kb = 0; kb < 2; ++kb) {
                    const float x7 = __shfl_xor(s[kb][7], 32), x15 = __shfl_xor(s[kb][15], 32);
                    const float gs0 = (s[kb][0] + s[kb][1]) + (s[kb][2] + s[kb][3]), gs1 = (s[kb][4] + s[kb][5]) + (s[kb][6] + s[kb][7]);
                    const float gs2 = (s[kb][8] + s[kb][9]) + (s[kb][10] + s[kb][11]), gs3 = (s[kb][12] + s[kb][13]) + (s[kb][14] + s[kb][15]);
                    const int gb = 4 * (2 * j + kb);
                    G[gb + 0] = gs0 + (hi ? x7 : xprev);
                    G[gb + 1] = gs1 + s[kb][3];
                    G[gb + 2] = gs2 + (hi ? x15 : x7);
                    G[gb + 3] = gs3 + s[kb][11];
                    xprev = x15;
                }
                pv_block(VT, s[0], 0, O, lane); pv_block(VT, s[1], 1, O, lane);
            }
        }
        const float lt = l + __shfl_xor(l, 32), inv = lt > 0.f ? 1.0f / lt : 0.f;
        store_out((float*)(C.ws + WS_ONSA) + row * 512 + h * 128, O, inv * sigmoid_f(zf[row * ZFC + ZF_NG + h * 3 + 0]), hi, false);
        LAS float* slab = IMP + (qh * 32 + r32) * 64 + 2 * hi;
#pragma unroll
        for (int hh = 0; hh < 4; ++hh) {
            if (h == hh) {
#pragma unroll
                for (int gi = 0; gi < 32; ++gi) { LAS float* p = slab + 8 * (gi >> 2) + 4 * ((gi & 3) >> 1) + (gi & 1); const float v = G[gi] * inv; *p = (hh == 0) ? v : (*p + v); }
            }
            __syncthreads();
        }
    }
    for (int qq = 0; qq < 8; ++qq) {
        const int qi = 8 * wave + qq, qh2 = qi >> 5, rr = qi & 31;
        float v = IMP[(qh2 * 32 + rr) * 64 + lane];
        if (lane == 0 || lane == cur || lane == cur - 1) v = 1.0e6f;
        if (lane > cur) v = -1.0f;
        int rank = 0;
        for (int i = 0; i < 64; ++i) { const float vi = __builtin_bit_cast(float, __builtin_amdgcn_readlane(__builtin_bit_cast(int, v), i)); rank += (vi > v || (vi == v && i < lane)) ? 1 : 0; }
        const unsigned long long mask = __ballot(rank < NSEL);
        if (lane == 0) SEL[qi] = mask;
    }
    __syncthreads();
    unsigned long long uni = SEL[lane];
#pragma unroll
    for (int o = 1; o < 64; o <<= 1) uni |= __shfl_xor(uni, o);
    const unsigned long long selq = SEL[32 * qh + r32];
    const unsigned long long upto = cur >= 63 ? ~0ull : ((2ull << cur) - 1ull);
    {
        ZERO_STATE(O, m, l);
        TileSrc src{zb + (size_t)b * T * ZBC + ZB_NKS, ZBC, (const bf16*)(C.ws + WS_VST) + (size_t)b * 128 * T, T};
        run_branch<MODE_SEL>(C, src, uni & upto, qf, QL, O, m, l, tq, q0w, nullptr, 0.f, h, selq);
        const float lt = l + __shfl_xor(l, 32);
        store_out((float*)(C.ws + WS_ONSA) + row * 512 + h * 128, O, (lt > 0.f ? 1.0f / lt : 0.f) * sigmoid_f(zf[row * ZFC + ZF_NG + h * 3 + 1]), hi, true);
    }
    {
        ZERO_STATE(O, m, l);
        TileSrc src{zb + (size_t)b * T * ZBC + ZB_NKW, ZBC, (const bf16*)(C.ws + WS_VWT) + (size_t)b * 128 * T, T};
        const int jlo = cur >= 8 ? cur - 8 : 0;
        run_branch<MODE_WIN>(C, src, upto & ~((1ull << jlo) - 1ull), qf, QL, O, m, l, tq, q0w, nullptr, 0.f, h, 0ull);
        const float lt = l + __shfl_xor(l, 32);
        store_out((float*)(C.ws + WS_ONSA) + row * 512 + h * 128, O, (lt > 0.f ? 1.0f / lt : 0.f) * sigmoid_f(zf[row * ZFC + ZF_NG + h * 3 + 2]), hi, true);
    }
}

struct GdnFrags { bf16x8 w[4], kd[2][2]; float u[4]; float egl; };
struct GdnOff { unsigned a, c, u; };
__device__ __forceinline__ void gdn_offsets(const int tr, const int tc, const int cb, const int lane, GdnOff& o) {
    const int fr = lane & 15, fq = lane >> 4;
    o.a = (unsigned)(((16 * tr + fr) * 128 + 8 * fq) * 2);
    o.c = (unsigned)(((32 * tr + fr) * 64 + 8 * fq) * 2);
    o.u = (unsigned)(((16 * tr + 4 * fq) * 128 + 32 * cb + 16 * tc + fr) * 4);
}
__device__ __forceinline__ void gdn_load(const unsigned char* gp  , const float* eglp, const GdnOff& o, GdnFrags& f) {
#pragma unroll
    for (int kk = 0; kk < 4; ++kk) f.w[kk] = *(const GAS bf16x8*)(gp + GP_W + o.a + 64 * kk);
#pragma unroll
    for (int kk = 0; kk < 2; ++kk)
#pragma unroll
        for (int t2 = 0; t2 < 2; ++t2) f.kd[t2][kk] = *(const GAS bf16x8*)(gp + GP_KDT + o.c + 2048 * t2 + 64 * kk);
#pragma unroll
    for (int r = 0; r < 4; ++r) f.u[r] = *(const GAS float*)(gp + GP_U + o.u + 512 * r);
    f.egl = *eglp;
}
constexpr int GS_ST = 8704, GS_VN = 4608, GS_VN0 = 8 * GS_ST;
__device__ __forceinline__ void gdn_step(const GdnFrags& f, const int n, LAS unsigned char* lds, f32x4 (&S)[2], const int tr, const int tc, const int fr, const int fq) {
    const LAS bf16* STp = (const LAS bf16*)(lds + ((n + 7) & 7) * GS_ST);
    LAS bf16* STn = (LAS bf16*)(lds + (n & 7) * GS_ST);
    LAS bf16* VNT = (LAS bf16*)(lds + GS_VN0 + (n & 7) * GS_VN);
    f32x4 av = {0.f, 0.f, 0.f, 0.f};
#pragma unroll
    for (int kk = 0; kk < 4; ++kk) av = mfma16(f.w[kk], *(const LAS bf16x8*)(STp + (16 * tc + fr) * 136 + 32 * kk + 8 * fq), av);
    { v2u w; w.x = pk2(f.u[0] - av[0], f.u[1] - av[1]); w.y = pk2(f.u[2] - av[2], f.u[3] - av[3]); *(LAS v2u*)(VNT + (16 * tc + fr) * 72 + 16 * tr + 4 * fq) = w; }
    __syncthreads();
    bf16x8 vf[2];
#pragma unroll
    for (int kk = 0; kk < 2; ++kk) vf[kk] = *(const LAS bf16x8*)(VNT + (16 * tc + fr) * 72 + 32 * kk + 8 * fq);
#pragma unroll
    for (int t2 = 0; t2 < 2; ++t2) { S[t2] *= f.egl;
#pragma unroll
        for (int kk = 0; kk < 2; ++kk) S[t2] = mfma16(f.kd[t2][kk], vf[kk], S[t2]);
        v2u w; w.x = pk2(S[t2][0], S[t2][1]); w.y = pk2(S[t2][2], S[t2][3]);
        *(LAS v2u*)(STn + (16 * tc + fr) * 136 + 16 * (2 * tr + t2) + 4 * fq) = w; }
    __syncthreads();
}
__device__ __forceinline__ void gdn_flush(const LAS unsigned char* lds, unsigned char* sn  , unsigned char* vn, const int tid) {
#pragma unroll
    for (int i = 0; i < 8; ++i) { const int idx = tid + NTHREADS * i, slot = idx >> 9, rem = idx & 511, col = rem >> 4, c16 = rem & 15;
        *(GAS v4u*)(sn + (size_t)slot * GSN_STEP + (col * 128 + c16 * 8) * 2) = *(const LAS v4u*)(lds + slot * GS_ST + (col * 136 + c16 * 8) * 2); }
#pragma unroll
    for (int i = 0; i < 4; ++i) { const int idx = tid + NTHREADS * i, slot = idx >> 8, rem = idx & 255, col = rem >> 3, c8 = rem & 7;
        *(GAS v4u*)(vn + (size_t)slot * GVN_STEP + (col * 64 + c8 * 8) * 2) = *(const LAS v4u*)(lds + GS_VN0 + slot * GS_VN + (col * 72 + c8 * 8) * 2); }
    __syncthreads();
}
__device__ __forceinline__ void gdn_scan_item(Ctx& C, const int item) {
    const int cb = item & 3, bh = item >> 2;
    const int lane = C.lane, wave = C.wave, tr = wave >> 1, tc = wave & 1, fr = lane & 15, fq = lane >> 4;
    for (int i = C.tid; i < GS_ST / 4; i += NTHREADS) ((LAS unsigned*)(C.lds + 7 * GS_ST))[i] = 0u;
    const unsigned char* gp0 = C.ws + WS_GPRE + (size_t)bh * 64 * GPRE_UNIT;
    const float* egl0 = (const float*)(C.ws + WS_SMALL + SM_EGL) + bh * 64;
    unsigned char* sn0 = C.ws + WS_GSN + ((size_t)bh * 64 * 4 + cb) * 8192;
    unsigned char* vn0 = C.ws + WS_GVN + ((size_t)bh * 64 * 4 + cb) * 4096;
    f32x4 S[2]; S[0] = (f32x4){0.f, 0.f, 0.f, 0.f}; S[1] = S[0];
    GdnFrags f0, f1, f2, f3; GdnOff go; gdn_offsets(tr, tc, cb, lane, go);
    gdn_load(gp0, egl0, go, f0); gdn_load(gp0 + GPRE_UNIT, egl0 + 1, go, f1); gdn_load(gp0 + 2 * GPRE_UNIT, egl0 + 2, go, f2);
    __syncthreads();
    for (int n = 0; n < 64; n += 4) {
        gdn_load(gp0 + (size_t)(n + 3) * GPRE_UNIT, egl0 + n + 3, go, f3);
        gdn_step(f0, n, C.lds, S, tr, tc, fr, fq);
        if (n + 4 < 64) gdn_load(gp0 + (size_t)(n + 4) * GPRE_UNIT, egl0 + n + 4, go, f0);
        gdn_step(f1, n + 1, C.lds, S, tr, tc, fr, fq);
        if (n + 5 < 64) gdn_load(gp0 + (size_t)(n + 5) * GPRE_UNIT, egl0 + n + 5, go, f1);
        gdn_step(f2, n + 2, C.lds, S, tr, tc, fr, fq);
        if (n + 6 < 64) gdn_load(gp0 + (size_t)(n + 6) * GPRE_UNIT, egl0 + n + 6, go, f2);
        gdn_step(f3, n + 3, C.lds, S, tr, tc, fr, fq);
        if ((n & 7) == 4) gdn_flush(C.lds, sn0 + (size_t)(n - 4) * GSN_STEP, vn0 + (size_t)(n - 4) * GVN_STEP, C.tid);
    }
}

__device__ __forceinline__ void lru_scan_item(Ctx& C, const int item) {
    const int b = item >> 3, ch = (item & 7) * 64 + C.lane, wave = C.wave;
    const float* LA = (const float*)(C.ws + WS_LA) + ((size_t)b * T + 512 * wave) * 512 + ch;
    const float* LU = (const float*)(C.ws + WS_LU) + ((size_t)b * T + 512 * wave) * 512 + ch;
    float* LH = (float*)(C.ws + WS_LH) + ((size_t)b * T + 512 * wave) * 512 + ch;
    LAS float* HE = (LAS float*)C.lds; LAS float* PE = HE + 8 * 64;
    float hh = 0.f, pp = 1.f;
    for (int t = 0; t < 512; t += 8) {
        float a[8], u[8];
#pragma unroll
        for (int i = 0; i < 8; ++i) { a[i] = LA[(size_t)(t + i) * 512]; u[i] = LU[(size_t)(t + i) * 512]; }
#pragma unroll
        for (int i = 0; i < 8; ++i) { hh = a[i] * hh + u[i]; pp *= a[i]; }
    }
    HE[wave * 64 + C.lane] = hh; PE[wave * 64 + C.lane] = pp;
    __syncthreads();
    float H = 0.f;
    for (int s = 0; s < wave; ++s) H = PE[s * 64 + C.lane] * H + HE[s * 64 + C.lane];
    for (int t = 0; t < 512; t += 8) {
        float a[8], u[8];
#pragma unroll
        for (int i = 0; i < 8; ++i) { a[i] = LA[(size_t)(t + i) * 512]; u[i] = LU[(size_t)(t + i) * 512]; }
#pragma unroll
        for (int i = 0; i < 8; ++i) { H = a[i] * H + u[i]; LH[(size_t)(t + i) * 512] = H; }
    }
}

__device__ __forceinline__ void mix_phase(Ctx& C, const int l, const int qoff) {
    const int q0 = 16 * l + 8 + qoff;
    QUEUE_LOOP(q0 + 0, 32, gdn_scan_item(C, j));
    QUEUE_LOOP(q0 + 1, 16, lru_scan_item(C, j));
    QUEUE_LOOP(q0 + 2, 128, fox_item(C, (j & 7) >> 2, j & 3, 15 - (j >> 3)));
    QUEUE_LOOP(q0 + 3, 128, nsa_item(C, j & 1, 63 - (j >> 1)));
}
__device__ __forceinline__ void gdn_out_job(Ctx& C, const int l, const int job) {
    const int n = job & 63, bh = job >> 6, b = bh >> 2, h = bh & 3;
    const int lane = C.lane, wave = C.wave, tr = wave >> 1, chalf = wave & 1, fr = lane & 15, fq = lane >> 4;
    const unsigned char* gp = C.ws + WS_GPRE + (size_t)job * GPRE_UNIT;
    bf16x8 qt[4], qk[2];
#pragma unroll
    for (int kk = 0; kk < 4; ++kk) qt[kk] = *(const GAS bf16x8*)(gp + GP_QT + ((16 * tr + fr) * 128 + 32 * kk + 8 * fq) * 2);
#pragma unroll
    for (int kk = 0; kk < 2; ++kk) qk[kk] = *(const GAS bf16x8*)(gp + GP_QK + ((16 * tr + fr) * 64 + 32 * kk + 8 * fq) * 2);
    f32x4 acc[4];
#pragma unroll
    for (int i = 0; i < 4; ++i) {
        acc[i] = (f32x4){0.f, 0.f, 0.f, 0.f};
        const int ct = 4 * chalf + i, cb = ct >> 1, within = (ct & 1) * 16 + fr;
        if (n > 0) { const unsigned char* sn = C.ws + WS_GSN + ((size_t)(job - 1) * 4 + cb) * 8192 + (within * 128 + 8 * fq) * 2;
#pragma unroll
            for (int kk = 0; kk < 4; ++kk) acc[i] = mfma16(qt[kk], *(const GAS bf16x8*)(sn + 64 * kk), acc[i]); }
        const unsigned char* vn = C.ws + WS_GVN + ((size_t)job * 4 + cb) * 4096 + (within * 64 + 8 * fq) * 2;
#pragma unroll
        for (int kk = 0; kk < 2; ++kk) acc[i] = mfma16(qk[kk], *(const GAS bf16x8*)(vn + 64 * kk), acc[i]);
    }
    LAS float* PS = (LAS float*)C.lds;
    float ss[4];
#pragma unroll
    for (int r = 0; r < 4; ++r) { float s = acc[0][r] * acc[0][r] + acc[1][r] * acc[1][r] + acc[2][r] * acc[2][r] + acc[3][r] * acc[3][r];
        s += __shfl_xor(s, 1); s += __shfl_xor(s, 2); s += __shfl_xor(s, 4); s += __shfl_xor(s, 8); ss[r] = s; }
    if (fr == 0) {
#pragma unroll
        for (int r = 0; r < 4; ++r) PS[(16 * tr + 4 * fq + r) * 2 + chalf] = ss[r]; }
    __syncthreads();
    const float* gng = inp<I_GNORM>() + l * 128;
    const float* zf = (const float*)(C.ws + WS_ZF);
    bf16* Y = (bf16*)(C.ws + WS_XN);
#pragma unroll
    for (int r = 0; r < 4; ++r) {
        const int row = 16 * tr + 4 * fq + r; const size_t m = (size_t)b * T + 64 * n + row;
        const float rstd = 1.0f / sqrtf((PS[row * 2] + PS[row * 2 + 1]) * (1.f / 128.f) + EPS);
#pragma unroll
        for (int i = 0; i < 4; ++i) { const int col = 16 * (4 * chalf + i) + fr;
            const float gz = zf[m * ZFC + ZF_GZ + h * 128 + col];
            Y[m * D + 512 + h * 128 + col] = (bf16)f2bf(acc[i][r] * rstd * gng[col] * silu_ff(gz)); }
    }
}
__device__ __forceinline__ void post_phase(Ctx& C, const int l) {
    QUEUE_LOOP(16 * l + 12, 512, gdn_out_job(C, l, j));
    refresh_ids(C);
    const int lane = C.lane;
    bf16* Y = (bf16*)(C.ws + WS_XN);
    const float* zf = (const float*)(C.ws + WS_ZF);
    const float* ong = inp<I_ONG>() + (size_t)l * 3 * 512;
    for (int m = C.bid * NWAVES + C.wave; m < M; m += C.G * NWAVES) {
        const size_t r512 = (size_t)m * 512 + 8 * lane;
        f32x4 a0 = *(const GAS f32x4*)((const float*)(C.ws + WS_OFOX) + r512), a1 = *(const GAS f32x4*)((const float*)(C.ws + WS_OFOX) + r512 + 4);
        f32x4 c0 = *(const GAS f32x4*)((const float*)(C.ws + WS_LH) + r512), c1 = *(const GAS f32x4*)((const float*)(C.ws + WS_LH) + r512 + 4);
        f32x4 d0 = *(const GAS f32x4*)((const float*)(C.ws + WS_ONSA) + r512), d1 = *(const GAS f32x4*)((const float*)(C.ws + WS_ONSA) + r512 + 4);
        const f32x4 lg0 = *(const GAS f32x4*)(zf + (size_t)m * ZFC + ZF_LG + 8 * lane), lg1 = *(const GAS f32x4*)(zf + (size_t)m * ZFC + ZF_LG + 8 * lane + 4);
#pragma unroll
        for (int i = 0; i < 4; ++i) { c0[i] *= gelu_tanh_f(lg0[i]); c1[i] *= gelu_tanh_f(lg1[i]); }
#define SS8(x0, x1) ((x0.x * x0.x + x0.y * x0.y) + (x0.z * x0.z + x0.w * x0.w) + (x1.x * x1.x + x1.y * x1.y) + (x1.z * x1.z + x1.w * x1.w))
        const float ra = 1.0f / sqrtf(wave_sum(SS8(a0, a1)) * (1.f / 512.f) + EPS);
        const float rc = 1.0f / sqrtf(wave_sum(SS8(c0, c1)) * (1.f / 512.f) + EPS);
        const float rd = 1.0f / sqrtf(wave_sum(SS8(d0, d1)) * (1.f / 512.f) + EPS);
#undef SS8
        const f32x4 ga0 = *(const GAS f32x4*)(ong + 8 * lane), ga1 = *(const GAS f32x4*)(ong + 8 * lane + 4);
        const f32x4 gc0 = *(const GAS f32x4*)(ong + 512 + 8 * lane), gc1 = *(const GAS f32x4*)(ong + 512 + 8 * lane + 4);
        const f32x4 gd0 = *(const GAS f32x4*)(ong + 1024 + 8 * lane), gd1 = *(const GAS f32x4*)(ong + 1024 + 8 * lane + 4);
        bf16* yr = Y + (size_t)m * D + 8 * lane;
        v4u w;
        w.x = pk2(a0.x * ra * ga0.x, a0.y * ra * ga0.y); w.y = pk2(a0.z * ra * ga0.z, a0.w * ra * ga0.w); w.z = pk2(a1.x * ra * ga1.x, a1.y * ra * ga1.y); w.w = pk2(a1.z * ra * ga1.z, a1.w * ra * ga1.w);
        *(GAS v4u*)yr = w;
        w.x = pk2(c0.x * rc * gc0.x, c0.y * rc * gc0.y); w.y = pk2(c0.z * rc * gc0.z, c0.w * rc * gc0.w); w.z = pk2(c1.x * rc * gc1.x, c1.y * rc * gc1.y); w.w = pk2(c1.z * rc * gc1.z, c1.w * rc * gc1.w);
        *(GAS v4u*)(yr + 1024) = w;
        w.x = pk2(d0.x * rd * gd0.x, d0.y * rd * gd0.y); w.y = pk2(d0.z * rd * gd0.z, d0.w * rd * gd0.w); w.z = pk2(d1.x * rd * gd1.x, d1.y * rd * gd1.y); w.w = pk2(d1.z * rd * gd1.z, d1.w * rd * gd1.w);
        *(GAS v4u*)(yr + 1536) = w;
    }
}
#ifndef N_LAUNCHES
#define N_LAUNCHES 1
#endif
constexpr int PH_PER_LAYER = 12, NPHASES = 1 + DEPTH * PH_PER_LAYER;
struct Args { const float* in[N_IN]; float* out; unsigned char* ws; int ph_lo, ph_hi; };
static_assert(sizeof(Args) == (N_IN + 2) * 8 + 8, "Args has no padding");

#define IN_PH(k) (lo <= (k) && (k) < hi)
#define SEAM(k) do { if (IN_PH(k) && IN_PH((k) + 1)) xcd_barrier(bar); } while (0)
template <int l> __device__ __forceinline__ void layer_phases(Ctx& C, const XcdBarrier& bar, const int lo, const int hi) {
        const int pb = 1 + l * PH_PER_LAYER;
        unsigned char* wl = C.ws + WS_W + (size_t)l * W_LAYER;
        bf16* XN = (bf16*)(C.ws + WS_XN); bf16* ACT = (bf16*)(C.ws + WS_ACT);
        if (IN_PH(pb + 0)) {
            pg8::Gemm g{XN, (const bf16*)(wl + WO_GU1), M, 2 * FF, D}; pg8::StaticOrder S; S.init(M, 2 * FF, C.G, C.bid);
            pg8::EpiSwiGLU E{ACT, FF};
            pg8::gemm_phase<pg8::EpiSwiGLU, pg8::StaticOrder, true, true>(C.lds, g, S, E);
        }
        SEAM(pb + 0);
        if (IN_PH(pb + 1)) {
            pg8::Gemm g{ACT, (const bf16*)(wl + WO_DN1), M, D, FF}; pg8::StaticOrder S; S.init(M, D, C.G, C.bid);
            pg8::EpiResid E{hptr(), D, 0.5f};
            pg8::gemm_phase<pg8::EpiResid, pg8::StaticOrder, false, true>(C.lds, g, S, E);
        }
        SEAM(pb + 1);
        if (IN_PH(pb + 2)) norm_phase_bf16(C, inp<I_MIXG>() + l * D);
        SEAM(pb + 2);
        if (IN_PH(pb + 3)) {
            pg8::Gemm g{XN, (const bf16*)(wl + WO_WIN), M, ZC, D}; pg8::StaticOrder S; S.init(M, ZC, C.G, C.bid);
            pg8::EpiWin E{(bf16*)(C.ws + WS_ZB), ZBC, (float*)(C.ws + WS_ZF), ZFC, (const float*)(C.ws + WS_MISC) + l * ZC, ZBC / 256};
            pg8::gemm_phase<pg8::EpiWin, pg8::StaticOrder, true, true>(C.lds, g, S, E);
        }
        SEAM(pb + 3);
        if (IN_PH(pb + 4)) pre_phase(C, l, 0);
        SEAM(pb + 4);
        if (IN_PH(pb + 5)) mix_phase(C, l, 0);
        SEAM(pb + 5);
        if (IN_PH(pb + 6)) post_phase(C, l);
        SEAM(pb + 6);
#ifdef PROBE_ITEM
        if (IN_PH(pb + 5)) {
#if PROBE_ITEM == 0
            QUEUE_LOOP(16 * l + 40, 32, gdn_scan_item(C, j));
#elif PROBE_ITEM == 1
            QUEUE_LOOP(16 * l + 40, 128, fox_item(C, (j & 7) >> 2, j & 3, 15 - (j >> 3)));
#elif PROBE_ITEM == 2
            QUEUE_LOOP(16 * l + 40, 128, nsa_item(C, j & 1, 63 - (j >> 1)));
#elif PROBE_ITEM == 3
            QUEUE_LOOP(16 * l + 40, 16, lru_scan_item(C, j));
#endif
        }
        SEAM(pb + 5);
#endif
        if (IN_PH(pb + 7)) {
            pg8::Gemm g{XN, (const bf16*)(wl + WO_WOUT), M, D, D}; pg8::StaticOrder S; S.init(M, D, C.G, C.bid);
            pg8::EpiResid E{hptr(), D, 1.0f};
            pg8::gemm_phase<pg8::EpiResid, pg8::StaticOrder, false, true>(C.lds, g, S, E);
        }
        SEAM(pb + 7);
        if (IN_PH(pb + 8)) norm_phase_bf16(C, inp<I_F2G>() + l * D);
        SEAM(pb + 8);
        if (IN_PH(pb + 9)) {
            pg8::Gemm g{XN, (const bf16*)(wl + WO_GU2), M, 2 * FF, D}; pg8::StaticOrder S; S.init(M, 2 * FF, C.G, C.bid);
            pg8::EpiSwiGLU E{ACT, FF};
            pg8::gemm_phase<pg8::EpiSwiGLU, pg8::StaticOrder, true, true>(C.lds, g, S, E);
        }
        SEAM(pb + 9);
        if (IN_PH(pb + 10)) {
            pg8::Gemm g{ACT, (const bf16*)(wl + WO_DN2), M, D, FF}; pg8::StaticOrder S; S.init(M, D, C.G, C.bid);
            pg8::EpiResid E{hptr(), D, 0.5f};
            pg8::gemm_phase<pg8::EpiResid, pg8::StaticOrder, false, true>(C.lds, g, S, E);
        }
        SEAM(pb + 10);
        if (IN_PH(pb + 11)) {
            if (l + 1 < DEPTH) norm_phase_bf16(C, inp<I_F1G>() + (l + 1) * D);
            else { refresh_ids(C); float* const hp = hptr(); for (int m = C.bid * NWAVES + C.wave; m < M; m += C.G * NWAVES) rms_row_f32(hp + (size_t)m * D, inp<I_FING>(), hp + (size_t)m * D, C.lane); }
        }
        SEAM(pb + 11);
    }
__global__ void __launch_bounds__(NTHREADS, 2) fwd_kernel(Args args) {
    extern __shared__ __attribute__((aligned(16))) unsigned char lds_raw[];
    Ctx C;
    C.lds = (LAS unsigned char*)lds_raw;
    C.tid = threadIdx.x; C.lane = C.tid & 63; C.wave = __builtin_amdgcn_readfirstlane(C.tid >> 6);
    C.G = gridDim.x; C.bid = blockIdx.x;
    C.ws = args.ws;
    if (C.tid < 64) ((LAS unsigned*)(C.lds + LDS_CTL_OFF))[C.tid] = 0u;
    __syncthreads();
    XcdBarrier bar; bar.bar = (unsigned*)C.ws + CW_BAR; bar.x = 0; bar.st = nullptr;
    const int lo = args.ph_lo, hi = args.ph_hi;
    if (hi - lo > 1) bar = xcd_barrier_post((unsigned*)C.ws + CW_BAR, (volatile LAS unsigned*)(C.lds + LDS_CTL_OFF));

    if (IN_PH(0)) { prologue_phase(C); }
    SEAM(0);
    layer_phases<0>(C, bar, lo, hi);
    layer_phases<1>(C, bar, lo, hi);
    static_assert(DEPTH == 2, "two layers");
#undef IN_PH
#undef SEAM
}

extern "C" void kernel_launch(void* const* d_in, const int* in_sizes, int n_in, void* d_out, int out_size, void* d_ws, size_t ws_size, hipStream_t stream) {
    static int grid = 0;
    if (grid == 0) {
        if (n_in != N_IN || in_sizes[0] != M * D || out_size != M * D || ws_size < WS_END) { fprintf(stderr, "kernel_launch: unexpected shapes (n_in %d, in0 %d, out %d, ws %zu)\n", n_in, n_in > 0 ? in_sizes[0] : -1, out_size, ws_size); grid = -1; return; }
        int dev = 0, cus = 0, per_cu = 0;
        if (hipGetDevice(&dev) != hipSuccess || hipDeviceGetAttribute(&cus, hipDeviceAttributeMultiprocessorCount, dev) != hipSuccess) { grid = -1; return; }
        if (hipFuncSetAttribute((const void*)fwd_kernel, hipFuncAttributeMaxDynamicSharedMemorySize, LDS_BYTES) != hipSuccess) { fprintf(stderr, "kernel_launch: hipFuncSetAttribute failed\n"); grid = -1; return; }
        if (hipOccupancyMaxActiveBlocksPerMultiprocessor(&per_cu, (const void*)fwd_kernel, NTHREADS, LDS_BYTES) != hipSuccess || per_cu < 1) { fprintf(stderr, "kernel_launch: occupancy query reports %d\n", per_cu); }
        (void)hipGetLastError();
        grid = cus;
    }
    if (grid < 0) return;
    if (hipMemsetAsync((char*)d_ws + WS_CTL, 0, CTL_ZERO_BYTES, stream) != hipSuccess) return;
    Args a{};
    for (int i = 0; i < N_IN; ++i) a.in[i] = (const float*)d_in[i];
    a.out = (float*)d_out; a.ws = (unsigned char*)d_ws;
#if N_LAUNCHES == 1
    a.ph_lo = 0; a.ph_hi = NPHASES;
    hipLaunchKernelGGL(fwd_kernel, dim3(grid), dim3(NTHREADS), LDS_BYTES, stream, a);
#else
    for (int p = 0; p < NPHASES; ++p) { a.ph_lo = p; a.ph_hi = p + 1; hipLaunchKernelGGL(fwd_kernel, dim3(grid), dim3(NTHREADS), LDS_BYTES, stream, a); }
#endif
}
```

```cpp
#include <hip/hip_runtime.h>
#include <cstdio>
#include <cstdint>
#include <cmath>
namespace pg8 {
#define PG8_LAS __attribute__((address_space(3)))
typedef unsigned short bf16_t;
typedef short bf16x8 __attribute__((ext_vector_type(8)));
typedef float f32x4 __attribute__((ext_vector_type(4)));
typedef unsigned u32x4 __attribute__((ext_vector_type(4)));
constexpr int BM = 256, BK = 64, HALF = 128, HTB = HALF * BK * 2  , STAGE_BYTES = 8 * HTB, NXCD = 8, WGM = 8;

__host__ __device__ __forceinline__ int lds_byte(int r, int c) { const int st = (r >> 4) * 2 + (c >> 5), rr = r & 15, cc = c & 31, ob = rr * 64 + cc * 2; return st * 1024 + (ob ^ (((ob >> 9) & 1) << 5)); }
__host__ __device__ __forceinline__ void stage_rc(int b, int& R, int& C) { const int st = b / 1024, sb = b % 1024, swz = sb ^ (((sb >> 9) & 1) << 5); R = (st >> 1) * 16 + swz / 64; C = (st & 1) * 32 + (swz % 64) / 2; }
__host__ __device__ __forceinline__ int perm32(int rho) { const int n = rho >> 4, i = rho & 15; return 8 * (i >> 2) + 4 * n + (i & 3); }

struct Unit { int pm, pn; };
struct Gemm { const bf16_t* A; const bf16_t* Bt; int M, N, K; };

struct StaticOrder {
    int nM, nN, nwg, G, c;
    __host__ __device__ void init(int M, int N, int G_, int c_) { nM = M / BM; nN = N / BM; nwg = nM * nN; G = G_; c = c_; }
    __host__ __device__ bool next(int i, Unit& u) const {
        const long L = (long)i * G + c; if (L >= nwg) return false;
        int wgid = (int)L; { const int q = nwg / NXCD, r = nwg % NXCD, xcd = wgid % NXCD, off = wgid / NXCD; wgid = (xcd < r ? xcd * (q + 1) : r * (q + 1) + (xcd - r) * q) + off; }
        const int nig = WGM * nN, gid = wgid / nig, fm = gid * WGM, gsz = (nM - fm) < WGM ? (nM - fm) : WGM;
        u.pm = fm + ((wgid % nig) % gsz); u.pn = (wgid % nig) / gsz; return true;
    }
    __device__ __forceinline__ void a_ready(const Unit&) const {}
    __device__ __forceinline__ void done(const Unit&) const {}
};

__device__ __forceinline__ unsigned cvt_pk_bf16(float lo, float hi) { unsigned r; asm volatile("v_cvt_pk_bf16_f32 %0, %1, %2" : "=v"(r) : "v"(lo), "v"(hi)); return r; }
typedef unsigned u32x2v __attribute__((ext_vector_type(2)));
__device__ __forceinline__ float silu_f(float x) { return x * __builtin_amdgcn_rcpf(1.0f + __builtin_amdgcn_exp2f(-1.44269504f * x)); }

struct EpiSwiGLU {
    static constexpr bool PERM = true, AFTER_DRAIN = false;
    bf16_t* O; int ldc;
    __device__ __forceinline__ void operator()(const f32x4 (&acc)[2][2][4][2], const Unit& u, int wr, int wc, int fr, int fq) const {
        const int row0 = u.pm * BM + wr * 64 + fr, col0 = u.pn * HALF + wc * 32 + 8 * fq;
#pragma unroll
        for (int ai = 0; ai < 2; ++ai)
#pragma unroll
            for (int m = 0; m < 4; ++m) { bf16_t* rowp = O + (size_t)(row0 + ai * HALF + m * 16) * ldc + col0;
                const f32x4 g0 = acc[ai][0][m][0], g1 = acc[ai][0][m][1], u0 = acc[ai][1][m][0], u1 = acc[ai][1][m][1];
                u32x4 w;
                w.x = cvt_pk_bf16(silu_f(g0[0]) * u0[0], silu_f(g0[1]) * u0[1]); w.y = cvt_pk_bf16(silu_f(g0[2]) * u0[2], silu_f(g0[3]) * u0[3]);
                w.z = cvt_pk_bf16(silu_f(g1[0]) * u1[0], silu_f(g1[1]) * u1[1]); w.w = cvt_pk_bf16(silu_f(g1[2]) * u1[2], silu_f(g1[3]) * u1[3]);
                *(u32x4*)rowp = w; }
    }
};
struct EpiResid {
    static constexpr bool PERM = false, AFTER_DRAIN = false;
    float* C; int ldc; float scale;
    __device__ __forceinline__ void operator()(const f32x4 (&acc)[2][2][4][2], const Unit& u, int wr, int wc, int fr, int fq) const {
        const int row0 = u.pm * BM + wr * 64 + fr, col0 = u.pn * BM + wc * 32 + 4 * fq;
#pragma unroll
        for (int ai = 0; ai < 2; ++ai)
#pragma unroll
            for (int m = 0; m < 4; ++m) { float* rowp = C + (size_t)(row0 + ai * HALF + m * 16) * ldc + col0;
                f32x4 old[2][2];
#pragma unroll
                for (int bj = 0; bj < 2; ++bj)
#pragma unroll
                    for (int n = 0; n < 2; ++n) old[bj][n] = *(const f32x4*)(rowp + bj * HALF + n * 16);
#pragma unroll
                for (int bj = 0; bj < 2; ++bj)
#pragma unroll
                    for (int n = 0; n < 2; ++n) *(f32x4*)(rowp + bj * HALF + n * 16) = old[bj][n] + acc[ai][bj][m][n] * scale;
                asm volatile("" ::: "memory"); }
    }
};
struct EpiWin {
    static constexpr bool PERM = true, AFTER_DRAIN = false;
    bf16_t* ZB; int ldb; float* ZF; int ldf; const float* bias; int nb16;
    __device__ __forceinline__ void operator()(const f32x4 (&acc)[2][2][4][2], const Unit& u, int wr, int wc, int fr, int fq) const {
        const int row0 = u.pm * BM + wr * 64 + fr, col0 = u.pn * BM + wc * 32 + 8 * fq;
        if (u.pn < nb16) {
#pragma unroll
            for (int bj = 0; bj < 2; ++bj) { const f32x4 b0 = *(const f32x4*)(bias + col0 + bj * HALF), b1 = *(const f32x4*)(bias + col0 + bj * HALF + 4);
#pragma unroll
                for (int ai = 0; ai < 2; ++ai)
#pragma unroll
                    for (int m = 0; m < 4; ++m) { bf16_t* rowp = ZB + (size_t)(row0 + ai * HALF + m * 16) * ldb + col0 + bj * HALF;
                        const f32x4 v0 = acc[ai][bj][m][0] + b0, v1 = acc[ai][bj][m][1] + b1;
                        u32x4 w; w.x = cvt_pk_bf16(v0[0], v0[1]); w.y = cvt_pk_bf16(v0[2], v0[3]); w.z = cvt_pk_bf16(v1[0], v1[1]); w.w = cvt_pk_bf16(v1[2], v1[3]);
                        *(u32x4*)rowp = w; }
                asm volatile("" ::: "memory"); }
        } else {
            const int cf = col0 - nb16 * BM;
#pragma unroll
            for (int bj = 0; bj < 2; ++bj) { const f32x4 b0 = *(const f32x4*)(bias + col0 + bj * HALF), b1 = *(const f32x4*)(bias + col0 + bj * HALF + 4);
#pragma unroll
                for (int ai = 0; ai < 2; ++ai)
#pragma unroll
                    for (int m = 0; m < 4; ++m) { float* rowp = ZF + (size_t)(row0 + ai * HALF + m * 16) * ldf + cf + bj * HALF;
                        *(f32x4*)rowp = acc[ai][bj][m][0] + b0; *(f32x4*)(rowp + 4) = acc[ai][bj][m][1] + b1; }
                asm volatile("" ::: "memory"); }
        }
    }
};
template <class Epi, class Sched, bool ALIGN_EPI = false, bool SP2 = false>
__device__ __forceinline__ void gemm_phase(PG8_LAS unsigned char* lds, const Gemm g, const Sched& S, const Epi& E) {
    const int tid = threadIdx.x, wid = __builtin_amdgcn_readfirstlane(tid >> 6), lane = tid & 63, wr = wid >> 2, wc = wid & 3, fr = lane & 15, fq = lane >> 4;
    const int K = g.K, nt = K / BK;
    unsigned voffA[2], voffB[2];
#pragma unroll
    for (int i = 0; i < 2; ++i) { int R, C; stage_rc(tid * 16 + i * 8192, R, C); const int Rb = Epi::PERM ? ((R & ~31) + perm32(R & 31)) : R;
        voffA[i] = (unsigned)(R * K + C) * 2u; voffB[i] = (unsigned)(Rb * K + C) * 2u; }
    const size_t kstep = (size_t)(BK * 2);
    const size_t hstep = (size_t)HALF * K * 2;
    const size_t tstep = 2 * hstep;
    const unsigned ldsw = (unsigned)wid * 1024u;
    const int aoff = lds_byte(wr * 64 + fr, fq * 8), boff = lds_byte(wc * 32 + fr, fq * 8);
#define PG8_SA(b, h) (((b) * 2 + (h)) * HTB)
#define PG8_SB(b, h) ((4 + (b) * 2 + (h)) * HTB)
#define PG8_STAGE(bufoff, gbase, voff) do { _Pragma("unroll") for (int _i = 0; _i < 2; ++_i) \
        __builtin_amdgcn_global_load_lds((const unsigned*)((const char*)(gbase) + (voff)[_i]), (PG8_LAS unsigned*)(lds + (bufoff) + ldsw + _i * 8192), 16, 0, 0); } while (0)
#define PG8_LDA(dst, b, h) do { _Pragma("unroll") for (int m = 0; m < 4; ++m) _Pragma("unroll") for (int k = 0; k < 2; ++k) dst[m][k] = *(const PG8_LAS bf16x8*)(lds + PG8_SA(b, h) + aoff + m * 2048 + k * 1024); } while (0)
#define PG8_LDB(dst, b, h) do { _Pragma("unroll") for (int n = 0; n < 2; ++n) _Pragma("unroll") for (int k = 0; k < 2; ++k) dst[n][k] = *(const PG8_LAS bf16x8*)(lds + PG8_SB(b, h) + boff + n * 2048 + k * 1024); } while (0)
#define PG8_MMA(ai, bj, At, Bt) do { __builtin_amdgcn_s_setprio(1); _Pragma("unroll") for (int m = 0; m < 4; ++m) _Pragma("unroll") for (int n = 0; n < 2; ++n) _Pragma("unroll") for (int k = 0; k < 2; ++k) \
        acc[ai][bj][m][n] = __builtin_amdgcn_mfma_f32_16x16x32_bf16(Bt[n][k], At[m][k], acc[ai][bj][m][n], 0, 0, 0); __builtin_amdgcn_s_setprio(0); } while (0)
#define PG8_WAIT_V(n) asm volatile("s_waitcnt vmcnt(" #n ")" ::: "memory")
#define PG8_WAIT_L(n) asm volatile("s_waitcnt lgkmcnt(" #n ")" ::: "memory")
#define PG8_BAR __builtin_amdgcn_s_barrier()
#define PG8_SCHED __builtin_amdgcn_sched_barrier(0)
    Unit cur, nxt; int ui = 0;
    if (!S.next(0, cur)) return;
    f32x4 acc[2][2][4][2];
#pragma unroll
    for (int a = 0; a < 2; ++a)
#pragma unroll
        for (int b = 0; b < 2; ++b)
#pragma unroll
            for (int m = 0; m < 4; ++m)
#pragma unroll
                for (int n = 0; n < 2; ++n) acc[a][b][m][n] = (f32x4){0.f, 0.f, 0.f, 0.f};
    bf16x8 At[4][2], B0[2][2], B1[2][2];
    const char* cA = (const char*)g.A + (size_t)cur.pm * tstep; const char* cB = (const char*)g.Bt + (size_t)cur.pn * tstep;
    S.a_ready(cur);
    if constexpr (SP2) {
        PG8_STAGE(PG8_SB(0, 0), cB, voffB); PG8_STAGE(PG8_SB(0, 1), cB + hstep, voffB); PG8_STAGE(PG8_SA(0, 0), cA, voffA); PG8_STAGE(PG8_SA(0, 1), cA + hstep, voffA);
        if (wr == 1) PG8_BAR;
        PG8_WAIT_V(2); PG8_BAR;
        PG8_STAGE(PG8_SB(1, 0), cB + kstep, voffB); PG8_STAGE(PG8_SA(1, 0), cA + kstep, voffA); PG8_STAGE(PG8_SB(1, 1), cB + hstep + kstep, voffB);
        PG8_WAIT_V(6); PG8_BAR;
    } else {
        PG8_STAGE(PG8_SB(0, 0), cB, voffB); PG8_STAGE(PG8_SA(0, 0), cA, voffA); PG8_STAGE(PG8_SB(0, 1), cB + hstep, voffB); PG8_STAGE(PG8_SA(0, 1), cA + hstep, voffA);
        if (wr == 1) PG8_BAR;
        PG8_WAIT_V(4); PG8_BAR;
        PG8_STAGE(PG8_SB(1, 0), cB + kstep, voffB); PG8_STAGE(PG8_SA(1, 0), cA + kstep, voffA); PG8_STAGE(PG8_SB(1, 1), cB + hstep + kstep, voffB);
        PG8_WAIT_V(6); PG8_BAR;
    }
    for (;;) {
        const bool has_next = S.next(ui + 1, nxt);
        const char* nA = has_next ? (const char*)g.A + (size_t)nxt.pm * tstep : cA; const char* nB = has_next ? (const char*)g.Bt + (size_t)nxt.pn * tstep : cB;
        for (int t = 0; t < nt; t += 2) {
            const bool last = (t == nt - 2);
            const char* a1 = cA + (size_t)(t + 1) * kstep;
            const char* a2 = last ? nA : cA + (size_t)(t + 2) * kstep; const char* b2 = last ? nB : cB + (size_t)(t + 2) * kstep;
            const char* a3 = a2 + kstep; const char* b3 = b2 + kstep;
            if (last && has_next) S.a_ready(nxt);
            if constexpr (SP2) {
            PG8_LDB(B0, 0, 0); PG8_LDB(B1, 0, 1); PG8_SCHED; PG8_LDA(At, 0, 0); PG8_STAGE(PG8_SA(1, 1), a1 + hstep, voffA);
            PG8_WAIT_V(8); PG8_WAIT_L(0); PG8_BAR; PG8_MMA(0, 0, At, B0); PG8_MMA(0, 1, At, B1); PG8_BAR; PG8_SCHED;
            PG8_LDA(At, 0, 1); PG8_STAGE(PG8_SB(0, 0), b2, voffB); PG8_STAGE(PG8_SB(0, 1), b2 + hstep, voffB); PG8_STAGE(PG8_SA(0, 0), a2, voffA);
            PG8_WAIT_V(8); PG8_WAIT_L(0); PG8_BAR; PG8_MMA(1, 0, At, B0); PG8_MMA(1, 1, At, B1); PG8_BAR; PG8_SCHED;
            PG8_LDB(B0, 1, 0); PG8_LDB(B1, 1, 1); PG8_SCHED; PG8_LDA(At, 1, 0); PG8_STAGE(PG8_SA(0, 1), a2 + hstep, voffA);
            PG8_WAIT_V(8); PG8_WAIT_L(0); PG8_BAR; PG8_MMA(0, 0, At, B0); PG8_MMA(0, 1, At, B1); PG8_BAR; PG8_SCHED;
            PG8_LDA(At, 1, 1); PG8_STAGE(PG8_SB(1, 0), b3, voffB); PG8_STAGE(PG8_SB(1, 1), b3 + hstep, voffB); PG8_STAGE(PG8_SA(1, 0), a3, voffA);
            PG8_WAIT_V(8); PG8_WAIT_L(0); PG8_BAR; PG8_MMA(1, 0, At, B0); PG8_MMA(1, 1, At, B1); PG8_BAR; PG8_SCHED;
            } else {
            PG8_LDB(B0, 0, 0); PG8_SCHED; PG8_LDA(At, 0, 0); PG8_STAGE(PG8_SA(1, 1), a1 + hstep, voffA);
            PG8_WAIT_L(8); PG8_BAR; PG8_WAIT_L(0); PG8_MMA(0, 0, At, B0); PG8_BAR; PG8_SCHED;
            PG8_LDB(B1, 0, 1); PG8_STAGE(PG8_SB(0, 0), b2, voffB);
            PG8_BAR; PG8_WAIT_L(0); PG8_MMA(0, 1, At, B1); PG8_BAR;
            PG8_LDA(At, 0, 1); PG8_STAGE(PG8_SA(0, 0), a2, voffA);
            PG8_BAR; PG8_WAIT_L(0); PG8_MMA(1, 0, At, B0); PG8_BAR; PG8_SCHED;
            PG8_STAGE(PG8_SB(0, 1), b2 + hstep, voffB);
            PG8_WAIT_V(6); PG8_BAR; PG8_MMA(1, 1, At, B1); PG8_BAR;
            PG8_LDB(B0, 1, 0); PG8_SCHED; PG8_LDA(At, 1, 0); PG8_STAGE(PG8_SA(0, 1), a2 + hstep, voffA);
            PG8_WAIT_L(8); PG8_BAR; PG8_WAIT_L(0); PG8_MMA(0, 0, At, B0); PG8_BAR; PG8_SCHED;
            PG8_LDB(B1, 1, 1); PG8_STAGE(PG8_SB(1, 0), b3, voffB);
            PG8_BAR; PG8_WAIT_L(0); PG8_MMA(0, 1, At, B1); PG8_BAR;
            PG8_LDA(At, 1, 1); PG8_STAGE(PG8_SA(1, 0), a3, voffA);
            PG8_BAR; PG8_WAIT_L(0); PG8_MMA(1, 0, At, B0); PG8_BAR; PG8_SCHED;
            PG8_STAGE(PG8_SB(1, 1), b3 + hstep, voffB);
            PG8_WAIT_V(6); PG8_BAR; PG8_MMA(1, 1, At, B1); PG8_BAR;
            }
        }
        if constexpr (ALIGN_EPI) { if (wr == 0) PG8_BAR; }
        if constexpr (!Epi::AFTER_DRAIN) { E(acc, cur, wr, wc, fr, fq); S.done(cur); }
        if (!has_next) break;
#pragma unroll
        for (int a = 0; a < 2; ++a)
#pragma unroll
            for (int b = 0; b < 2; ++b)
#pragma unroll
                for (int m = 0; m < 4; ++m)
#pragma unroll
                    for (int n = 0; n < 2; ++n) acc[a][b][m][n] = (f32x4){0.f, 0.f, 0.f, 0.f};
        cur = nxt; cA = nA; cB = nB; ++ui;
        if constexpr (ALIGN_EPI) { if (wr == 1) PG8_BAR; }
    }
    PG8_WAIT_V(0);
    if constexpr (!ALIGN_EPI) { if (wr == 0) PG8_BAR; }
    PG8_BAR;
    if constexpr (Epi::AFTER_DRAIN) { E.fused(acc, cur, wr, wc, fr, fq, lds, wid, lane); S.done(cur); }
#undef PG8_SA
#undef PG8_SB
#undef PG8_STAGE
#undef PG8_LDA
#undef PG8_LDB
#undef PG8_MMA
#undef PG8_WAIT_V
#undef PG8_WAIT_L
#undef PG8_BAR
#undef PG8_SCHED
}
}
constexpr int BATCH = 2, T = 4096, D = 2048, FF = 5632, DEPTH = 2;
constexpr int M = BATCH * T;
constexpr int DIN = 5912, GW = 512, HD = 128, NH = 4;
constexpr int ZBC = 2560, ZFC = 3584, ZC = ZBC + ZFC;
constexpr int ZB_FQ = 0, ZB_FK = 512, ZB_FV = 1024, ZB_NQ = 1536, ZB_NKS = 2048, ZB_NVS = 2176, ZB_NKW = 2304, ZB_NVW = 2432;
constexpr int ZF_GQ = 0, ZF_GK = 512, ZF_GV = 1024, ZF_GZ = 1536, ZF_LX = 2048, ZF_LG = 2560, ZF_NKC = 3072, ZF_NVC = 3200, ZF_FF = 3328, ZF_GA = 3332, ZF_GB = 3336, ZF_NG = 3340;
constexpr float EPS = 1e-6f;
constexpr int NCMP = 255, NCMPP = 256, NSLC = 64, NSEL = 16, WINDOW = 512, NBT = 791;
constexpr float LOG2E = 1.4426950408889634f;

__host__ __device__ __forceinline__ int zsrc(int zc) {
    if (zc < 1536) return zc;
    if (zc < 2048) return 4620 + (zc - 1536);
    if (zc < 2176) return 5388 + (zc - 2048);
    if (zc < 2304) return 5516 + (zc - 2176);
    if (zc < 2432) return 5644 + (zc - 2304);
    if (zc < 2560) return 5772 + (zc - 2432);
    const int c = zc - 2560;
    if (c < 512) return 1540 + c;
    if (c < 1024) return 2052 + (c - 512);
    if (c < 1536) return 2564 + (c - 1024);
    if (c < 2048) return 3084 + (c - 1536);
    if (c < 2560) return 3596 + (c - 2048);
    if (c < 3072) return 4108 + (c - 2560);
    if (c < 3200) return 5132 + (c - 3072);
    if (c < 3328) return 5260 + (c - 3200);
    if (c < 3332) return 1536 + (c - 3328);
    if (c < 3340) return 3076 + (c - 3332);
    if (c < 3352) return 5900 + (c - 3340);
    return -1;
}

constexpr size_t MiB = 1u << 20;
constexpr size_t WS_CTL = 0, CTL_ZERO_BYTES = 1 * MiB;
constexpr size_t WS_MISC = 1 * MiB;
constexpr size_t WS_W = 2 * MiB, W_LAYER = 164 * MiB;
constexpr size_t WO_GU1 = 0, WO_DN1 = 44 * MiB, WO_WIN = 66 * MiB, WO_WOUT = 90 * MiB, WO_GU2 = 98 * MiB, WO_DN2 = 142 * MiB;
constexpr size_t WS_XN = 330 * MiB;
constexpr size_t WS_ZB = 362 * MiB, WS_ZF = 402 * MiB;
constexpr size_t WS_ACT = 362 * MiB;
constexpr size_t WS_VFT = 514 * MiB, WS_VST = 522 * MiB, WS_VWT = 524 * MiB;
constexpr size_t WS_GPRE = 526 * MiB, GPRE_UNIT = 90112;
constexpr size_t GP_W = 0, GP_QT = 16384, GP_KDT = 32768, GP_QK = 49152, GP_U = 57344;
constexpr size_t WS_OFOX = 570 * MiB, WS_OGDN = 586 * MiB, WS_LA = 602 * MiB, WS_LU = 618 * MiB, WS_ONSA = 634 * MiB;
constexpr size_t WS_SMALL = 650 * MiB;
constexpr size_t SM_CFOX = 0;
constexpr size_t SM_GG = 128 * 1024;
constexpr size_t SM_GBETA = 256 * 1024;
constexpr size_t SM_NG = 384 * 1024;
constexpr size_t SM_KC = 768 * 1024;
constexpr size_t SM_VCT = 896 * 1024;
constexpr size_t SM_EGL = 1024 * 1024;
constexpr size_t WS_LH = 652 * MiB;
constexpr size_t WS_GSN = WS_OGDN, GSN_STEP = 4 * 8192;
constexpr size_t WS_GVN = 668 * MiB, GVN_STEP = 4 * 4096;
constexpr size_t WS_END = 676 * MiB;
constexpr int CW_BAR = 4096, CW_Q = 16384;

constexpr int LDS_BYTES = 160 * 1024;
constexpr int LDS_CTL_OFF = LDS_BYTES - 256;
constexpr int NWAVES = 8, NTHREADS = 512;

#define GAS __attribute__((address_space(1)))
#define LAS __attribute__((address_space(3)))
typedef unsigned short bf16;
typedef unsigned v4u __attribute__((ext_vector_type(4)));
typedef unsigned v2u __attribute__((ext_vector_type(2)));
typedef float f32x4 __attribute__((ext_vector_type(4)));
typedef float f32x16 __attribute__((ext_vector_type(16)));
typedef short bf16x8 __attribute__((ext_vector_type(8)));
#define LDS_WAIT() asm volatile("s_waitcnt lgkmcnt(0)" ::: "memory")
#define VM_WAIT() asm volatile("s_waitcnt vmcnt(0)" ::: "memory")
__device__ __forceinline__ unsigned f2bf(float f) { unsigned u = __builtin_bit_cast(unsigned, f); return (u + 0x7fffu + ((u >> 16) & 1u)) >> 16; }
__device__ __forceinline__ unsigned pk2(float lo, float hi) { return f2bf(lo) | (f2bf(hi) << 16); }
__device__ __forceinline__ float bf2f(unsigned short b) { return __builtin_bit_cast(float, (unsigned)b << 16); }
__device__ __forceinline__ float wave_sum(float v) {
#pragma unroll
    for (int o = 1; o < 64; o <<= 1) v += __shfl_xor(v, o);
    return v;
}
__device__ __forceinline__ float fast_exp(float x) { return __builtin_amdgcn_exp2f(x * LOG2E); }
__device__ __forceinline__ float sigmoid_f(float x) { return __builtin_amdgcn_rcpf(1.0f + fast_exp(-x)); }
__device__ __forceinline__ float silu_ff(float x) { return x * sigmoid_f(x); }
__device__ __forceinline__ float softplus_f(float x) { return x > 20.f ? x : log1pf(expf(x)); }
__device__ __forceinline__ float gelu_tanh_f(float x) { const float u = 0.7978845608028654f * (x + 0.044715f * x * x * x); return 0.5f * x * (1.0f + tanhf(u)); }

#define XB_TMO      128
#define XB_XCNT(j)  (256  + 64 * (j))
#define XB_XSUB(j)  (1280 + 64 * (j))
#define XB_XGEN(j)  (2304 + 64 * (j))
#define XB_TOP      3328
#define XB_TOPGEN   3392
#define XCD_BAR_WORDS 3456
#define XB_SPIN_CAP (1u << 18)

__device__ __forceinline__ unsigned xb_ld(unsigned* p)              { return __hip_atomic_load(p, __ATOMIC_RELAXED, __HIP_MEMORY_SCOPE_AGENT); }
__device__ __forceinline__ unsigned xb_add(unsigned* p, unsigned v) { return __hip_atomic_fetch_add(p, v, __ATOMIC_RELAXED, __HIP_MEMORY_SCOPE_AGENT); }
__device__ __forceinline__ unsigned xb_xcc_id() { return (unsigned)__builtin_amdgcn_s_getreg((3 << 11) | 20) & 0xFu; }
#define XB_SPIN(cond, bar) do { unsigned _sp = 0; while (cond) { __builtin_amdgcn_s_sleep(1); \
    if ((++_sp & 255u) == 0u) { if (xb_ld(&(bar)[XB_TMO])) break; if (_sp > XB_SPIN_CAP) { atomicAdd(&(bar)[XB_TMO], 1u); break; } } } } while (0)

struct XcdBarrier {
    unsigned* bar; unsigned x;
    volatile LAS unsigned* st;
};

__device__ __forceinline__ XcdBarrier xcd_barrier_post(unsigned* bar, volatile LAS unsigned* st) {
    XcdBarrier b; b.bar = bar; b.x = xb_xcc_id(); b.st = st;
    if (threadIdx.x == 0) (void)xb_add(&bar[XB_XCNT(b.x)], 1u);
    return b;
}
__device__ __forceinline__ void xcd_barrier_complete(unsigned* bar, unsigned x, unsigned& nloc, unsigned& nx) {
    const unsigned G = gridDim.x * gridDim.y * gridDim.z;
    unsigned sum, cnt, mine, sp = 0u;
    for (;;) {
        sum = 0u; cnt = 0u; mine = 0u;
#pragma unroll
        for (unsigned j = 0; j < 16; ++j) { const unsigned c = xb_ld(&bar[XB_XCNT(j)]); sum += c; cnt += (c > 0u) ? 1u : 0u; mine = (j == x) ? c : mine; }
        if (sum == G) break;
        __builtin_amdgcn_s_sleep(1);
        if ((++sp & 255u) == 0u) { if (xb_ld(&bar[XB_TMO])) break; if (sp > XB_SPIN_CAP) { atomicAdd(&bar[XB_TMO], 1u); break; } }
    }
    nloc = mine > 0u ? mine : 1u; nx = cnt > 0u ? cnt : 1u;
}

__device__ __forceinline__ void xcd_barrier(const XcdBarrier& b) {
    asm volatile("s_waitcnt vmcnt(0)" ::: "memory");
    __syncthreads();
    if (threadIdx.x == 0) {
        unsigned* bar = b.bar;
        __builtin_amdgcn_s_waitcnt(0);
        unsigned nloc = b.st[0], nx = b.st[1];
        if (nloc == 0u) { xcd_barrier_complete(bar, b.x, nloc, nx); b.st[0] = nloc; b.st[1] = nx; }
        const unsigned old = xb_add(&bar[XB_XSUB(b.x)], 1u);
        const unsigned gen = old / nloc;
        if (old + 1u == (gen + 1u) * nloc) {
            __builtin_amdgcn_fence(__ATOMIC_RELEASE, "agent");
            asm volatile("s_waitcnt vmcnt(0)" ::: "memory");
            const unsigned og = xb_add(&bar[XB_TOP], 1u);
            const unsigned tg = og / nx;
            if (og + 1u == (tg + 1u) * nx) xb_add(&bar[XB_TOPGEN], 1u);
            else XB_SPIN(xb_ld(&bar[XB_TOPGEN]) == tg, bar);
            __builtin_amdgcn_fence(__ATOMIC_ACQUIRE, "agent");
            xb_add(&bar[XB_XGEN(b.x)], 1u);
            asm volatile("s_waitcnt vmcnt(0)" ::: "memory");
        } else {
            XB_SPIN(xb_ld(&bar[XB_XGEN(b.x)]) == gen, bar);
            __builtin_amdgcn_fence(__ATOMIC_ACQUIRE, "agent");
            asm volatile("s_waitcnt vmcnt(0)" ::: "memory");
        }
    }
    __syncthreads();
}
struct Ctx {
    LAS unsigned char* lds;
    unsigned char* ws;
    int tid, lane, wave, G, bid;
};
enum { I_X = 0, I_F1G, I_F1WG, I_F1WU, I_F1WD, I_MIXG, I_WIN, I_BIN, I_GCONV, I_GALOG, I_GDT, I_GNORM, I_LCONVW, I_LCONVB, I_LWA, I_LBA, I_LWX, I_LBX, I_LLAM,
       I_PEK, I_W1K, I_W2K, I_PEV, I_W1V, I_W2V, I_RELB, I_ONG, I_WOUT, I_F2G, I_F2WG, I_F2WU, I_F2WD, I_FING, N_IN };
__device__ __forceinline__ float* hptr() {
    float* p; asm volatile("s_load_dwordx2 %0, %1, %2\n\ts_waitcnt lgkmcnt(0)" : "=s"(p) : "s"(__builtin_amdgcn_kernarg_segment_ptr()), "n"(N_IN * 8));
    return p;
}
template <int I> __device__ __forceinline__ const float* inp() {
    const float* p; asm volatile("s_load_dwordx2 %0, %1, %2\n\ts_waitcnt lgkmcnt(0)" : "=s"(p) : "s"(__builtin_amdgcn_kernarg_segment_ptr()), "n"(I * 8));
    return p;
}

__device__ __forceinline__ void refresh_ids(Ctx& C) {
    int l; asm volatile("v_mbcnt_lo_u32_b32 %0, -1, 0\n\tv_mbcnt_hi_u32_b32 %0, -1, %0" : "=v"(l));
    C.lane = l; C.tid = C.wave * 64 + l;
}
__device__ __forceinline__ int queue_pull(Ctx& C, int qi) {
    refresh_ids(C);
    volatile LAS int* slot = (volatile LAS int*)(C.lds + LDS_CTL_OFF + 16);
    __syncthreads();
    if (C.tid == 0) *slot = (int)__hip_atomic_fetch_add((unsigned*)C.ws + CW_Q + 64 * qi, 1u, __ATOMIC_RELAXED, __HIP_MEMORY_SCOPE_AGENT);
    __syncthreads();
    return *slot;
}

__device__ __forceinline__ void transpose_item(const float* colp, int ldn, bf16* WT, int K, int n0, int k0, LAS float* scr, int lane) {
#pragma unroll 8
    for (int i = 0; i < 32; ++i) { const int kk = 2 * i + (lane >> 5); scr[kk * 33 + (lane & 31)] = colp ? colp[(size_t)(k0 + kk) * ldn] : 0.f; }
    LDS_WAIT(); asm volatile("" ::: "memory");
    const int c = lane & 7;
#pragma unroll
    for (int j = 0; j < 4; ++j) { const int n = (lane >> 3) + 8 * j; const LAS float* s = scr + (8 * c) * 33 + n;
        v4u o; o.x = pk2(s[0 * 33], s[1 * 33]); o.y = pk2(s[2 * 33], s[3 * 33]); o.z = pk2(s[4 * 33], s[5 * 33]); o.w = pk2(s[6 * 33], s[7 * 33]);
        *(GAS v4u*)(WT + (size_t)(n0 + n) * K + k0 + 8 * c) = o; }
    LDS_WAIT(); asm volatile("" ::: "memory");
}
__device__ __forceinline__ void rms_row_bf16(const float* xrow, const float* g, bf16* orow, float* hcopy, int lane) {
    const GAS f32x4* xr = (const GAS f32x4*)xrow + lane;
    f32x4 v[8]; float s = 0.f;
#pragma unroll
    for (int j = 0; j < 8; ++j) { v[j] = xr[64 * j]; s += (v[j].x * v[j].x + v[j].y * v[j].y) + (v[j].z * v[j].z + v[j].w * v[j].w); }
    const float rstd = 1.0f / sqrtf(wave_sum(s) * (1.f / D) + EPS);
    if (hcopy) { GAS f32x4* hc = (GAS f32x4*)hcopy + lane;
#pragma unroll
        for (int j = 0; j < 8; ++j) hc[64 * j] = v[j]; }
    GAS v2u* o8 = (GAS v2u*)orow + lane;
#pragma unroll
    for (int j = 0; j < 8; ++j) { const f32x4 gg = ((const GAS f32x4*)g)[lane + 64 * j]; v2u w; w.x = pk2(v[j].x * rstd * gg.x, v[j].y * rstd * gg.y); w.y = pk2(v[j].z * rstd * gg.z, v[j].w * rstd * gg.w); o8[64 * j] = w; }
}
__device__ __forceinline__ void rms_row_f32(const float* xrow, const float* g, float* orow, int lane) {
    const GAS f32x4* xr = (const GAS f32x4*)xrow + lane;
    f32x4 v[8]; float s = 0.f;
#pragma unroll
    for (int j = 0; j < 8; ++j) { v[j] = xr[64 * j]; s += (v[j].x * v[j].x + v[j].y * v[j].y) + (v[j].z * v[j].z + v[j].w * v[j].w); }
    const float rstd = 1.0f / sqrtf(wave_sum(s) * (1.f / D) + EPS);
    GAS f32x4* o = (GAS f32x4*)orow + lane;
#pragma unroll
    for (int j = 0; j < 8; ++j) { const f32x4 gg = ((const GAS f32x4*)g)[lane + 64 * j]; o[64 * j] = v[j] * rstd * gg; }
}
__device__ __forceinline__ void norm_phase_bf16(Ctx& C, const float* g) {
    refresh_ids(C);
    bf16* XN = (bf16*)(C.ws + WS_XN);
    float* const hp = hptr();
    for (int m = C.bid * NWAVES + C.wave; m < M; m += C.G * NWAVES) rms_row_bf16(hp + (size_t)m * D, g, XN + (size_t)m * D, nullptr, C.lane);
}

__device__ __forceinline__ int t5_bucket(int n) {
    if (n < 16) return n;
    int b = 16;
    b += (n >= 21); b += (n >= 27); b += (n >= 35); b += (n >= 46); b += (n >= 59); b += (n >= 77); b += (n >= 99); b += (n >= 128);
    b += (n >= 166); b += (n >= 216); b += (n >= 280); b += (n >= 363); b += (n >= 470); b += (n >= 609); b += (n >= 790);
    return b;
}

__device__ __forceinline__ void prologue_phase(Ctx& C) {
    refresh_ids(C);
    LAS float* scr = (LAS float*)(C.lds + C.wave * 16384);
    const int gw = C.bid * NWAVES + C.wave, NGW = C.G * NWAVES;
    constexpr int I_GU = 32 * 352, I_DN = 88 * 64, I_WI = 32 * 192, I_WO = 32 * 64;
    constexpr int PER_LAYER = 2 * I_GU + 2 * I_DN + I_WI + I_WO;
    for (int it = gw; it < DEPTH * PER_LAYER; it += NGW) {
        const int l = it / PER_LAYER; int r = it % PER_LAYER;
        unsigned char* wl = C.ws + WS_W + (size_t)l * W_LAYER;
        int ffn = -1;
        if (r < I_GU) ffn = 0; else { r -= I_GU;
        if (r < I_DN) ffn = 2; else { r -= I_DN;
        if (r < I_WI) ffn = 4; else { r -= I_WI;
        if (r < I_WO) ffn = 5; else { r -= I_WO;
        if (r < I_GU) ffn = 1; else { r -= I_GU; ffn = 3; } } } } }
        if (ffn <= 1) {
            const int nb = r % 352, kb = r / 352, n0 = nb * 32, j = n0 / 256, rr = n0 % 256;
            const float* wg = (ffn == 0 ? inp<I_F1WG>() : inp<I_F2WG>()) + (size_t)l * D * FF; const float* wu = (ffn == 0 ? inp<I_F1WU>() : inp<I_F2WU>()) + (size_t)l * D * FF;
            const float* colp = (rr < 128 ? wg + 128 * j + rr : wu + 128 * j + rr - 128) + (C.lane & 31);
            transpose_item(colp, FF, (bf16*)(wl + (ffn == 0 ? WO_GU1 : WO_GU2)), D, n0, kb * 64, scr, C.lane);
        } else if (ffn <= 3) {
            const int nb = r % 64, kb = r / 64;
            const float* w = (ffn == 2 ? inp<I_F1WD>() : inp<I_F2WD>()) + (size_t)l * FF * D;
            transpose_item(w + nb * 32 + (C.lane & 31), D, (bf16*)(wl + (ffn == 2 ? WO_DN1 : WO_DN2)), FF, nb * 32, kb * 64, scr, C.lane);
        } else if (ffn == 4) {
            const int nb = r % 192, kb = r / 192;
            const int sc = zsrc(nb * 32 + (C.lane & 31));
            const float* w = inp<I_WIN>() + (size_t)l * D * DIN;
            transpose_item(sc >= 0 ? w + sc : nullptr, DIN, (bf16*)(wl + WO_WIN), D, nb * 32, kb * 64, scr, C.lane);
        } else {
            const int nb = r % 64, kb = r / 64;
            const float* w = inp<I_WOUT>() + (size_t)l * D * D;
            transpose_item(w + nb * 32 + (C.lane & 31), D, (bf16*)(wl + WO_WOUT), D, nb * 32, kb * 64, scr, C.lane);
        }
    }
    float* bz = (float*)(C.ws + WS_MISC);
    for (int i = C.bid * NTHREADS + C.tid; i < DEPTH * ZC; i += C.G * NTHREADS) { const int l = i / ZC, zc = i % ZC, sc = zsrc(zc); bz[i] = sc >= 0 ? inp<I_BIN>()[l * DIN + sc] : 0.f; }
    float* tb = (float*)(C.ws + WS_MISC + 65536);
    for (int i = C.bid * NTHREADS + C.tid; i < NH * NBT; i += C.G * NTHREADS) { const int hh = i / NBT, d = i % NBT; tb[i] = inp<I_RELB>()[t5_bucket(d) * NH + hh] * LOG2E; }
    bf16* XN = (bf16*)(C.ws + WS_XN);
    float* const hp = hptr();
    for (int m = gw; m < M; m += NGW) rms_row_bf16(inp<I_X>() + (size_t)m * D, inp<I_F1G>(), XN + (size_t)m * D, hp + (size_t)m * D, C.lane);
}
typedef float f32x4v __attribute__((ext_vector_type(4)));
__device__ __forceinline__ f32x4 mfma16(bf16x8 a, bf16x8 b, f32x4 c) { return __builtin_amdgcn_mfma_f32_16x16x32_bf16(a, b, c, 0, 0, 0); }

__device__ __forceinline__ void gdn_pre_job(Ctx& C, const int l, const int job) {
    const int ch = job & 63, h = (job >> 6) & 3, b = job >> 8, t0 = ch * 64;
    const size_t row0 = (size_t)b * T + t0;
    const float* zf = (const float*)(C.ws + WS_ZF);
    unsigned char* gp = C.ws + WS_GPRE + (size_t)job * GPRE_UNIT;
    LAS float* XQ = (LAS float*)C.lds;
    LAS float* XK = XQ + 64 * 132;
    LAS float* XV = XK + 64 * 132;
    LAS bf16* KN = (LAS bf16*)(XV + 64 * 132);
    LAS bf16* KBt = KN + 64 * 136;
    LAS bf16* QN = KBt + 64 * 136;
    LAS float* SMg = (LAS float*)(QN + 64 * 136);
    LAS float* AM = XQ;
    const int tid = C.tid, lane = C.lane, wave = C.wave;
    const float* cw = inp<I_GCONV>() + (size_t)l * 4 * 1536;
    for (int idx = tid; idx < 64 * 96; idx += NTHREADS) {
        const int tt = idx / 96, c4 = idx % 96, col = c4 * 4, which = col >> 7, d = col & 127, cc = which * 512 + h * 128 + d;
        f32x4 acc = {0.f, 0.f, 0.f, 0.f};
#pragma unroll
        for (int j = 0; j < 4; ++j) { const int tq = t0 + tt - 3 + j;
            if (tq >= 0) { const f32x4 zv = *(const GAS f32x4*)(zf + ((size_t)b * T + tq) * ZFC + cc); const f32x4 wv = *(const GAS f32x4*)(cw + j * 1536 + cc); acc += zv * wv; } }
        f32x4 o; o.x = silu_ff(acc.x); o.y = silu_ff(acc.y); o.z = silu_ff(acc.z); o.w = silu_ff(acc.w);
        LAS float* dst = (which == 0 ? XQ : which == 1 ? XK : XV) + tt * 132 + d;
        *(LAS f32x4*)dst = o;
    }
    if (wave == 0) {
        const float ga = zf[(row0 + lane) * ZFC + ZF_GA + h], gb = zf[(row0 + lane) * ZFC + ZF_GB + h];
        const float g = -expf(inp<I_GALOG>()[l * 4 + h]) * softplus_f(ga + inp<I_GDT>()[l * 4 + h]);
        float gc = g;
#pragma unroll
        for (int o = 1; o < 64; o <<= 1) { const float v = __shfl_up(gc, o); if (lane >= o) gc += v; }
        const float gl = __shfl(gc, 63);
        SMg[lane] = gc; SMg[64 + lane] = sigmoid_f(gb); SMg[128 + lane] = expf(gc); SMg[192 + lane] = expf(gl - gc);
        if (lane == 0) ((float*)(C.ws + WS_SMALL + SM_EGL))[job] = expf(gl);
    }
    __syncthreads();
    for (int r = wave * 8; r < wave * 8 + 8; ++r) {
        const float q0 = XQ[r * 132 + lane], q1 = XQ[r * 132 + 64 + lane], k0 = XK[r * 132 + lane], k1 = XK[r * 132 + 64 + lane];
        const float sq = wave_sum(q0 * q0 + q1 * q1), sk = wave_sum(k0 * k0 + k1 * k1);
        if (lane == 0) { SMg[256 + r] = 1.0f / sqrtf(sq + EPS); SMg[320 + r] = 1.0f / sqrtf(sk + EPS); }
    }
    __syncthreads();
    const float qscale = 0.08838834764831845f;
    for (int idx = tid; idx < 1024; idx += NTHREADS) {
        const int tt = idx >> 4, d0 = (idx & 15) * 8;
        const float rq = SMg[256 + tt] * qscale, rk = SMg[320 + tt], be = SMg[64 + tt], eg = SMg[128 + tt];
        const f32x4 qa = *(LAS f32x4*)(XQ + tt * 132 + d0), qb = *(LAS f32x4*)(XQ + tt * 132 + d0 + 4), ka = *(LAS f32x4*)(XK + tt * 132 + d0), kb = *(LAS f32x4*)(XK + tt * 132 + d0 + 4);
        v4u w;
        w.x = pk2(ka.x * rk, ka.y * rk); w.y = pk2(ka.z * rk, ka.w * rk); w.z = pk2(kb.x * rk, kb.y * rk); w.w = pk2(kb.z * rk, kb.w * rk);
        *(LAS v4u*)(KN + tt * 136 + d0) = w;
        const float rkb = rk * be;
        w.x = pk2(ka.x * rkb, ka.y * rkb); w.y = pk2(ka.z * rkb, ka.w * rkb); w.z = pk2(kb.x * rkb, kb.y * rkb); w.w = pk2(kb.z * rkb, kb.w * rkb);
        *(LAS v4u*)(KBt + tt * 136 + d0) = w;
        w.x = pk2(qa.x * rq, qa.y * rq); w.y = pk2(qa.z * rq, qa.w * rq); w.z = pk2(qb.x * rq, qb.y * rq); w.w = pk2(qb.z * rq, qb.w * rq);
        *(LAS v4u*)(QN + tt * 136 + d0) = w;
        const float rqe = rq * eg;
        w.x = pk2(qa.x * rqe, qa.y * rqe); w.y = pk2(qa.z * rqe, qa.w * rqe); w.z = pk2(qb.x * rqe, qb.y * rqe); w.w = pk2(qb.z * rqe, qb.w * rqe);
        *(GAS v4u*)(gp + GP_QT + (size_t)(tt * 128 + d0) * 2) = w;
    }
    for (int idx = tid; idx < 1024; idx += NTHREADS) {
        const int d = idx & 127, tg = (idx >> 7) * 8;
        float v[8];
#pragma unroll
        for (int i = 0; i < 8; ++i) v[i] = XK[(tg + i) * 132 + d] * SMg[320 + tg + i] * SMg[192 + tg + i];
        v4u w; w.x = pk2(v[0], v[1]); w.y = pk2(v[2], v[3]); w.z = pk2(v[4], v[5]); w.w = pk2(v[6], v[7]);
        *(GAS v4u*)(gp + GP_KDT + (size_t)(d * 64 + tg) * 2) = w;
    }
    __syncthreads();
    for (int jj = wave; jj < 26; jj += NWAVES) {
        bf16* qkout = (bf16*)(gp + GP_QK);
        const int fr = lane & 15, fq = lane >> 4;
        if (jj >= 20) {
            const int z = jj - 20, ti = z < 3 ? 0 : (z < 5 ? 1 : 2), tj = z < 3 ? z + 1 : (z < 5 ? z - 1 : 3);
#pragma unroll
            for (int r = 0; r < 4; ++r) qkout[(16 * ti + 4 * fq + r) * 64 + 16 * tj + fr] = 0;
            continue;
        }
        const int which = jj / 10, tix = jj % 10;
        const int ti = tix < 1 ? 0 : (tix < 3 ? 1 : (tix < 6 ? 2 : 3)), tj = tix - (ti * (ti + 1)) / 2;
        const LAS bf16* Ap = (which == 0 ? KBt : QN) + (16 * ti + fr) * 136 + 8 * fq;
        const LAS bf16* Bp = KN + (16 * tj + fr) * 136 + 8 * fq;
        f32x4 acc = {0.f, 0.f, 0.f, 0.f};
#pragma unroll
        for (int kk = 0; kk < 4; ++kk) acc = mfma16(*(const LAS bf16x8*)(Ap + 32 * kk), *(const LAS bf16x8*)(Bp + 32 * kk), acc);
        const int j = 16 * tj + fr; const float gcj = SMg[j];
#pragma unroll
        for (int r = 0; r < 4; ++r) { const int i = 16 * ti + 4 * fq + r; const float dec = expf(SMg[i] - gcj);
            if (which == 0) AM[i * 68 + j] = (i > j) ? acc[r] * dec : 0.f;
            else qkout[i * 64 + j] = (bf16)f2bf((i >= j) ? acc[r] * dec : 0.f); }
    }
    __syncthreads();
    if (wave < 4) {
        const int c = wave * 64 + lane, d = c & 127; const bool isW = c >= 128;
        int vzero; asm volatile("v_mov_b32 %0, 0" : "=v"(vzero));
        const LAS float* AMv = AM + vzero; const LAS float* SMv = SMg + vzero;
        float X[64];
#pragma unroll
        for (int i = 0; i < 64; ++i) X[i] = isW ? XK[i * 132 + d] * SMv[320 + i] * SMv[64 + i] * SMv[128 + i] : XV[i * 132 + d] * SMv[64 + i];
#pragma unroll
        for (int i = 1; i < 64; ++i) {
            float s = X[i];
#pragma unroll
            for (int j4 = 0; j4 < (i + 3) / 4; ++j4) { const f32x4 a = *(const LAS f32x4*)(AMv + i * 68 + 4 * j4);
                if (4 * j4 + 0 < i) s -= a.x * X[4 * j4 + 0];
                if (4 * j4 + 1 < i) s -= a.y * X[4 * j4 + 1];
                if (4 * j4 + 2 < i) s -= a.z * X[4 * j4 + 2];
                if (4 * j4 + 3 < i) s -= a.w * X[4 * j4 + 3]; }
            X[i] = s;
        }
        if (isW) { bf16* Wo = (bf16*)(gp + GP_W);
#pragma unroll
            for (int i = 0; i < 64; ++i) Wo[i * 128 + d] = (bf16)f2bf(X[i]); }
        else { float* Uo = (float*)(gp + GP_U);
#pragma unroll
            for (int i = 0; i < 64; ++i) Uo[i * 128 + d] = X[i]; }
    }
}

__device__ __forceinline__ void nsa_compress_job(Ctx& C, const int l, const int job) {
    const int rg = job & 31, b = (job >> 5) & 1, kv = job >> 6, n0 = rg * 8;
    const float* zf = (const float*)(C.ws + WS_ZF) + (kv ? ZF_NVC : ZF_NKC);
    const float* pe = (kv ? inp<I_PEV>() : inp<I_PEK>()) + (size_t)l * 32 * 128;
    const float* w1 = (kv ? inp<I_W1V>() : inp<I_W1K>()) + (size_t)l * 4096 * 128;
    const float* w2 = (kv ? inp<I_W2V>() : inp<I_W2K>()) + (size_t)l * 128 * 128;
    LAS float* XS = (LAS float*)C.lds;
    LAS float* PE = XS + 144 * 128;
    LAS float* RED = PE + 32 * 128;
    LAS float* HID = RED + 4 * 9 * 128;
    const int tid = C.tid;
    for (int idx = tid; idx < 144 * 32; idx += NTHREADS) { const int tk = idx >> 5, d4 = (idx & 31) * 4, t = 16 * n0 + tk;
        f32x4 v = {0.f, 0.f, 0.f, 0.f}; if (t < T) v = *(const GAS f32x4*)(zf + ((size_t)b * T + t) * ZFC + d4);
        *(LAS f32x4*)(XS + tk * 128 + d4) = v; }
    for (int idx = tid; idx < 32 * 32; idx += NTHREADS) *(LAS f32x4*)(PE + idx * 4) = *(const GAS f32x4*)(pe + idx * 4);
    __syncthreads();
    const int c = tid & 127, kq = tid >> 7;
    float acc[8], accp = 0.f;
#pragma unroll
    for (int r = 0; r < 8; ++r) acc[r] = 0.f;
    for (int i = 8 * kq; i < 8 * kq + 8; ++i) {
#pragma unroll 2
        for (int d4 = 0; d4 < 128; d4 += 4) {
            const float* wp = w1 + (size_t)(i * 128 + d4) * 128 + c;
            const float w0 = wp[0], w1v = wp[128], w2v = wp[256], w3 = wp[384];
            const f32x4 p = *(const LAS f32x4*)(PE + i * 128 + d4);
            accp += p.x * w0 + p.y * w1v + p.z * w2v + p.w * w3;
#pragma unroll
            for (int r = 0; r < 8; ++r) { const f32x4 x = *(const LAS f32x4*)(XS + (16 * r + i) * 128 + d4); acc[r] += x.x * w0 + x.y * w1v + x.z * w2v + x.w * w3; }
        }
    }
#pragma unroll
    for (int r = 0; r < 8; ++r) RED[(kq * 9 + r) * 128 + c] = acc[r];
    RED[(kq * 9 + 8) * 128 + c] = accp;
    __syncthreads();
    for (int idx = tid; idx < 8 * 128; idx += NTHREADS) { const int r = idx >> 7, cc = idx & 127;
        float s = 0.f;
#pragma unroll
        for (int q = 0; q < 4; ++q) s += RED[(q * 9 + r) * 128 + cc] + RED[(q * 9 + 8) * 128 + cc];
        HID[r * 128 + cc] = gelu_tanh_f(s); }
    __syncthreads();
    {
        float o0 = 0.f, o1 = 0.f;
#pragma unroll 4
        for (int cc = 0; cc < 128; ++cc) { const float w = w2[cc * 128 + c]; o0 += HID[(2 * kq) * 128 + cc] * w; o1 += HID[(2 * kq + 1) * 128 + cc] * w; }
        const int na = n0 + 2 * kq, nb = na + 1;
        if (na >= NCMP) o0 = 0.f; if (nb >= NCMP) o1 = 0.f;
        if (kv == 0) { bf16* KC = (bf16*)(C.ws + WS_SMALL + SM_KC) + (size_t)b * NCMPP * 128; KC[na * 128 + c] = (bf16)f2bf(o0); KC[nb * 128 + c] = (bf16)f2bf(o1); }
        else { bf16* VCT = (bf16*)(C.ws + WS_SMALL + SM_VCT) + (size_t)b * 128 * NCMPP; VCT[c * NCMPP + na] = (bf16)f2bf(o0); VCT[c * NCMPP + nb] = (bf16)f2bf(o1); }
    }
}

__device__ __forceinline__ void lru_gate_job(Ctx& C, const int l, const int job) {
    const int wave = C.wave, lane = C.lane, cbase = wave * 64, ch = cbase + lane;
    const size_t rowb = (size_t)job * 32; const int tpos = (int)(rowb % T);
    const float* zf = (const float*)(C.ws + WS_ZF) + ZF_LX + ch;
    LAS float* XS = (LAS float*)C.lds + wave * 2048;
    const float* cw = inp<I_LCONVW>() + (size_t)l * 4 * 512 + ch; const float cb = inp<I_LCONVB>()[l * 512 + ch];
    const float w0 = cw[0], w1 = cw[512], w2 = cw[1024], w3 = cw[1536];
    float xc[32];
    float zm3 = tpos >= 3 ? zf[(rowb - 3) * ZFC] : 0.f, zm2 = tpos >= 2 ? zf[(rowb - 2) * ZFC] : 0.f, zm1 = tpos >= 1 ? zf[(rowb - 1) * ZFC] : 0.f;
#pragma unroll
    for (int tt = 0; tt < 32; ++tt) { const float z0 = zf[(rowb + tt) * ZFC]; xc[tt] = w0 * zm3 + w1 * zm2 + w2 * zm1 + w3 * z0 + cb; zm3 = zm2; zm2 = zm1; zm1 = z0; }
#pragma unroll
    for (int t4 = 0; t4 < 8; ++t4) *(LAS f32x4*)(XS + lane * 32 + 4 * t4) = (f32x4){xc[4 * t4], xc[4 * t4 + 1], xc[4 * t4 + 2], xc[4 * t4 + 3]};
    LDS_WAIT(); asm volatile("" ::: "memory");
    float aA[32], aX[32];
#pragma unroll
    for (int tt = 0; tt < 32; ++tt) { aA[tt] = 0.f; aX[tt] = 0.f; }
    const float* wa = inp<I_LWA>() + ((size_t)l * 8 + wave) * 4096 + lane; const float* wx = inp<I_LWX>() + ((size_t)l * 8 + wave) * 4096 + lane;
#pragma unroll 2
    for (int d = 0; d < 64; ++d) { const float va = wa[d * 64], vx = wx[d * 64];
#pragma unroll
        for (int t4 = 0; t4 < 8; ++t4) { const f32x4 x = *(const LAS f32x4*)(XS + d * 32 + 4 * t4);
            aA[4 * t4] += x.x * va; aA[4 * t4 + 1] += x.y * va; aA[4 * t4 + 2] += x.z * va; aA[4 * t4 + 3] += x.w * va;
            aX[4 * t4] += x.x * vx; aX[4 * t4 + 1] += x.y * vx; aX[4 * t4 + 2] += x.z * vx; aX[4 * t4 + 3] += x.w * vx; } }
    const float ba = inp<I_LBA>()[l * 512 + ch], bx = inp<I_LBX>()[l * 512 + ch], spl = softplus_f(-inp<I_LLAM>()[l * 512 + ch]);
    float* LA = (float*)(C.ws + WS_LA) + ch; float* LU = (float*)(C.ws + WS_LU) + ch;
#pragma unroll
    for (int tt = 0; tt < 32; ++tt) { const float r = sigmoid_f(aA[tt] + ba), ig = sigmoid_f(aX[tt] + bx), la = -8.0f * r * spl;
        LA[(rowb + tt) * 512] = expf(la); LU[(rowb + tt) * 512] = sqrtf(-expm1f(2.0f * la)) * (ig * xc[tt]); }
    LDS_WAIT();
}

__device__ __forceinline__ void vtrans_job(Ctx& C, const int job) {
    const size_t rowb = (size_t)job * 64; const int b = (int)(rowb / T), t0 = (int)(rowb % T);
    const bf16* zb = (const bf16*)(C.ws + WS_ZB);
    LAS bf16* TL = (LAS bf16*)C.lds;
    for (int idx = C.tid; idx < 64 * 96; idx += NTHREADS) { const int tt = idx / 96, c8 = (idx % 96) * 8;
        const int sc = c8 < 512 ? ZB_FV + c8 : (c8 < 640 ? ZB_NVS + (c8 - 512) : ZB_NVW + (c8 - 640));
        *(LAS v4u*)(TL + tt * 776 + c8) = *(const GAS v4u*)(zb + (rowb + tt) * ZBC + sc); }
    __syncthreads();
    for (int idx = C.tid; idx < 768 * 8; idx += NTHREADS) { const int c = idx % 768, tg = (idx / 768) * 8;
        unsigned short v[8];
#pragma unroll
        for (int i = 0; i < 8; ++i) v[i] = TL[(tg + i) * 776 + c];
        v4u w; w.x = v[0] | ((unsigned)v[1] << 16); w.y = v[2] | ((unsigned)v[3] << 16); w.z = v[4] | ((unsigned)v[5] << 16); w.w = v[6] | ((unsigned)v[7] << 16);
        bf16* dst = c < 512 ? (bf16*)(C.ws + WS_VFT) + ((size_t)(b * 4 + (c >> 7)) * 128 + (c & 127)) * T
                  : (c < 640 ? (bf16*)(C.ws + WS_VST) + ((size_t)b * 128 + (c - 512)) * T : (bf16*)(C.ws + WS_VWT) + ((size_t)b * 128 + (c - 640)) * T);
        *(GAS v4u*)(dst + t0 + tg) = w; }
}

__device__ __forceinline__ void fox_cumsum_job(Ctx& C, const int job) {
    const int b = job >> 2, h = job & 3;
    const float* zf = (const float*)(C.ws + WS_ZF) + ZF_FF + h;
    float* cf = (float*)(C.ws + WS_SMALL + SM_CFOX) + (size_t)job * T;
    LAS double* WS8 = (LAS double*)C.lds;
    double v[8], run = 0.0;
#pragma unroll
    for (int i = 0; i < 8; ++i) { const float x = zf[((size_t)b * T + C.tid * 8 + i) * ZFC]; const float ls = fminf(x, 0.f) - log1pf(expf(-fabsf(x))); run += (double)ls; v[i] = run; }
    double sc = run;
#pragma unroll
    for (int o = 1; o < 64; o <<= 1) { const double u = __shfl_up(sc, o); if (C.lane >= o) sc += u; }
    if (C.lane == 63) WS8[C.wave] = sc;
    __syncthreads();
    double off = sc - run;
    for (int w = 0; w < C.wave; ++w) off += WS8[w];
#pragma unroll
    for (int i = 0; i < 8; ++i) cf[C.tid * 8 + i] = (float)((off + v[i]) * 1.4426950408889634);
}

#define QUEUE_LOOP(qi, njobs, call) for (;;) { const int j = queue_pull(C, (qi)); if (j >= (njobs)) break; call; }
__device__ __forceinline__ void pre_phase(Ctx& C, const int l, const int qoff) {
    const int q0 = 16 * l + qoff;
    QUEUE_LOOP(q0 + 0, 128, nsa_compress_job(C, l, j));
    QUEUE_LOOP(q0 + 1, 512, gdn_pre_job(C, l, j));
    QUEUE_LOOP(q0 + 2, 256, lru_gate_job(C, l, j));
    QUEUE_LOOP(q0 + 3, 128, vtrans_job(C, j));
    QUEUE_LOOP(q0 + 4, 8, fox_cumsum_job(C, j));
}
__device__ __forceinline__ f32x16 mfma32(bf16x8 a, bf16x8 b, f32x16 c) { return __builtin_amdgcn_mfma_f32_32x32x16_bf16(a, b, c, 0, 0, 0); }
__device__ __forceinline__ bf16x8 pack8(float a0, float a1, float a2, float a3, float a4, float a5, float a6, float a7) {
    v4u w; w.x = pg8::cvt_pk_bf16(a0, a1); w.y = pg8::cvt_pk_bf16(a2, a3); w.z = pg8::cvt_pk_bf16(a4, a5); w.w = pg8::cvt_pk_bf16(a6, a7);
    return __builtin_bit_cast(bf16x8, w);
}
constexpr int AT_KT = 0, AT_VT = 32768, AT_CT = 65536, AT_BT = 66048, AT_SEL = 78720, AT_Q = 79360;
constexpr int AT_IMP = 0;
constexpr float SC_LOG2 = 0.1275174326f;
enum { MODE_FOX = 0, MODE_CMP = 1, MODE_SEL = 2, MODE_WIN = 3 };

struct TileSrc { const bf16* K; int ldk; const bf16* VT; int ldv; };
struct LaneOff { unsigned gk[2], gv[2]; unsigned krow, kc[8], vrow, vc[2][2]; };
__device__ __forceinline__ void lane_offsets(const TileSrc& s, const int wave, const int lane, LaneOff& o) {
#pragma unroll
    for (int i = 0; i < 2; ++i) { const int p = 2 * wave + i;
        { const int row = 4 * p + (lane >> 4), c = (lane & 15) ^ (row & 15); o.gk[i] = (unsigned)((row * s.ldk + c * 8) * 2); }
        { const int d = 8 * p + (lane >> 3), c = (lane & 7) ^ ((d >> 1) & 7); o.gv[i] = (unsigned)((d * s.ldv + c * 8) * 2); } }
    const int r32 = lane & 31, hi = lane >> 5, prow = (r32 & 19) | ((r32 & 4) << 1) | ((r32 & 8) >> 1);
    o.krow = (unsigned)(prow * 256);
#pragma unroll
    for (int c = 0; c < 8; ++c) o.kc[c] = (unsigned)(((2 * c + hi) ^ (prow & 15)) * 16);
    o.vrow = (unsigned)(r32 * 128);
#pragma unroll
    for (int kb = 0; kb < 2; ++kb)
#pragma unroll
        for (int cc = 0; cc < 2; ++cc) o.vc[kb][cc] = (unsigned)(((4 * kb + 2 * cc + hi) ^ ((r32 >> 1) & 7)) * 16);
}
template <int MODE>
__device__ __forceinline__ void dma_tile(LAS unsigned char* lds, const TileSrc& s, const LaneOff& o, const int k0, const int buf, const int wave, const int lane, const float* cfrow) {
    const char* kb = (const char*)s.K + (size_t)k0 * s.ldk * 2; const char* vb = (const char*)s.VT + (size_t)k0 * 2;
#pragma unroll
    for (int i = 0; i < 2; ++i) {
        __builtin_amdgcn_global_load_lds((const GAS unsigned*)(kb + o.gk[i]), (LAS unsigned*)(lds + AT_KT + buf * 16384 + (2 * wave + i) * 1024), 16, 0, 0);
        __builtin_amdgcn_global_load_lds((const GAS unsigned*)(vb + o.gv[i]), (LAS unsigned*)(lds + AT_VT + buf * 16384 + (2 * wave + i) * 1024), 16, 0, 0); }
    if (MODE == MODE_FOX && wave == 0) __builtin_amdgcn_global_load_lds((const GAS unsigned*)(cfrow + k0 + lane), (LAS unsigned*)(lds + AT_CT + buf * 256), 4, 0, 0);
}
template <bool QL>
__device__ __forceinline__ f32x16 score_block(const LAS unsigned char* KT, const LaneOff& o, const bf16x8 (&qf)[8], const LAS bf16* ql, const int kb, const int lane) {
    const int r32 = lane & 31, hi = lane >> 5;
    const LAS unsigned char* p = KT + kb * 8192 + o.krow;
    const LAS bf16* q = ql + r32 * 136 + 8 * hi;
    __builtin_amdgcn_sched_barrier(0);
    bf16x8 kf[8], qq[8];
#pragma unroll
    for (int c = 0; c < 8; ++c) { kf[c] = *(const LAS bf16x8*)(p + o.kc[c]); if (QL) qq[c] = *(const LAS bf16x8*)(q + 16 * c); }
    __builtin_amdgcn_sched_barrier(0);
    f32x16 sa, sb;
#pragma unroll
    for (int i = 0; i < 16; ++i) { sa[i] = 0.f; sb[i] = 0.f; }
#pragma unroll
    for (int c = 0; c < 8; c += 2) { sa = mfma32(kf[c], QL ? qq[c] : qf[c], sa); sb = mfma32(kf[c + 1], QL ? qq[c + 1] : qf[c + 1], sb); }
    __builtin_amdgcn_sched_barrier(0);
    return sa + sb;
}
__device__ __forceinline__ void pv_block(const LAS unsigned char* VT, const LaneOff& o, const f32x16& p, const int kb, f32x16 (&O)[4]) {
    bf16x8 vf[2][4];
#pragma unroll
    for (int cc = 0; cc < 2; ++cc)
#pragma unroll
        for (int db = 0; db < 4; ++db) vf[cc][db] = *(const LAS bf16x8*)(VT + db * 4096 + o.vrow + o.vc[kb][cc]);
    const bf16x8 pf0 = pack8(p[0], p[1], p[2], p[3], p[4], p[5], p[6], p[7]), pf1 = pack8(p[8], p[9], p[10], p[11], p[12], p[13], p[14], p[15]);
    __builtin_amdgcn_sched_barrier(0);
#pragma unroll
    for (int db = 0; db < 4; ++db) O[db] = mfma32(vf[0][db], pf0, O[db]);
#pragma unroll
    for (int db = 0; db < 4; ++db) O[db] = mfma32(vf[1][db], pf1, O[db]);
    __builtin_amdgcn_sched_barrier(0);
}

#define SOFTMAX_RESCALE(mx) do { mx = fmaxf(mx, __shfl_xor(mx, 32)); \
        if (__builtin_amdgcn_ballot_w64(mx > m) != 0ull) { const float alpha_ = __builtin_amdgcn_exp2f(m - mx); l *= alpha_; \
            _Pragma("unroll") for (int db_ = 0; db_ < 4; ++db_) O[db_] *= alpha_; } \
        m = mx; } while (0)
template <int MODE>
__device__ __forceinline__ void compute_tile(LAS unsigned char* lds, const int buf, const LaneOff& lo, const int j, const bf16x8 (&qf)[8], const LAS bf16* ql, f32x16 (&O)[4], float& m, float& l,
                                             const int tq, const int q0w, const float ctq2  , const int head, const bool selbit, const int lane) {
    const LAS unsigned char* KT = lds + AT_KT + buf * 16384; const LAS unsigned char* VT = lds + AT_VT + buf * 16384;
    const LAS float* CT = (const LAS float*)(lds + AT_CT + buf * 256); const LAS float* BT = (const LAS float*)(lds + AT_BT) + head * 792;
    const int hi = lane >> 5, k0 = 64 * j;
    if constexpr (MODE == MODE_FOX) {
#pragma unroll
        for (int kb = 0; kb < 2; ++kb) {
            f32x16 s = score_block<false>(KT, lo, qf, ql, kb, lane);
            const LAS float* ct = CT + 32 * kb + 8 * hi;
            float mx = m, rs = 0.f;
            if (k0 + 32 * kb + 31 <= q0w) {
#pragma unroll
                for (int r = 0; r < 16; ++r) { const float v = __builtin_fmaf(s[r], SC_LOG2, ctq2 - ct[16 * (r >> 3) + (r & 7)]); s[r] = v; mx = fmaxf(mx, v); }
                SOFTMAX_RESCALE(mx);
#pragma unroll
                for (int r = 0; r < 16; ++r) { const float p = __builtin_amdgcn_exp2f(s[r] - mx); s[r] = p; rs += p; }
            } else {
                const int lim = tq - k0 - 32 * kb - 8 * hi;
#pragma unroll
                for (int r = 0; r < 16; ++r) {
                    float v = __builtin_fmaf(s[r], SC_LOG2, ctq2 - ct[16 * (r >> 3) + (r & 7)]);
                    v = (16 * (r >> 3) + (r & 7) <= lim) ? v : -1e30f; s[r] = v; mx = fmaxf(mx, v);
                }
                SOFTMAX_RESCALE(mx);
#pragma unroll
                for (int r = 0; r < 16; ++r) { const float p = s[r] > -1e29f ? __builtin_amdgcn_exp2f(s[r] - mx) : 0.f; s[r] = p; rs += p; }
            }
            l += rs;
            pv_block(VT, lo, s, kb, O);
        }
    } else {
        const bool far = (MODE == MODE_SEL) && (q0w - (k0 + 63) >= 790);
        const float bfar = BT[790];
#pragma unroll
        for (int kb = 0; kb < 2; ++kb) {
            f32x16 s = score_block<true>(KT, lo, qf, ql, kb, lane);
            float rs = 0.f;
            if (far) {
                float smax = s[0];
#pragma unroll
                for (int r = 1; r < 16; ++r) smax = fmaxf(smax, s[r]);
                float mx = fmaxf(m, selbit ? __builtin_fmaf(smax, SC_LOG2, bfar) : -1e30f);
                SOFTMAX_RESCALE(mx);
                const float c0 = selbit ? bfar - mx : -1e30f;
#pragma unroll
                for (int r = 0; r < 16; ++r) { const float p = __builtin_amdgcn_exp2f(__builtin_fmaf(s[r], SC_LOG2, c0)); s[r] = p; rs += p; }
            } else {
                float mx = m;
#pragma unroll
                for (int r = 0; r < 16; ++r) {
                    const int dist = tq - (k0 + 32 * kb + 16 * (r >> 3) + 8 * hi + (r & 7));
                    const bool valid = (MODE == MODE_SEL) ? (selbit && dist >= 0) : (dist >= 0 && dist < WINDOW);
                    const int di = dist < 0 ? 0 : (dist > 790 ? 790 : dist);
                    float v = __builtin_fmaf(s[r], SC_LOG2, BT[di]);
                    v = valid ? v : -1e30f; s[r] = v; mx = fmaxf(mx, v);
                }
                SOFTMAX_RESCALE(mx);
#pragma unroll
                for (int r = 0; r < 16; ++r) { const float p = s[r] > -1e29f ? __builtin_amdgcn_exp2f(s[r] - mx) : 0.f; s[r] = p; rs += p; }
            }
            l += rs;
            pv_block(VT, lo, s, kb, O);
        }
    }
}

template <int MODE>
__device__ __forceinline__ void run_branch(Ctx& C, const TileSrc& src, const LaneOff& lo, unsigned long long tmask, const bf16x8 (&qf)[8], const LAS bf16* ql, f32x16 (&O)[4], float& m, float& l,
                                           const int tq, const int q0w, const float* cfrow, const float ctq2, const int head, const unsigned long long selq) {
    if (tmask == 0ull) return;
    int j = __builtin_ctzll(tmask); tmask &= tmask - 1;
    __syncthreads();
    dma_tile<MODE>(C.lds, src, lo, 64 * j, 0, C.wave, C.lane, cfrow);
    int buf = 0;
    for (;;) {
        const int jn = tmask ? __builtin_ctzll(tmask) : -1; tmask &= tmask - 1;
        asm volatile("s_waitcnt vmcnt(0)" ::: "memory");
        __syncthreads();
        if (jn >= 0) dma_tile<MODE>(C.lds, src, lo, 64 * jn, buf ^ 1, C.wave, C.lane, cfrow);
        bool active = true;
        if (MODE == MODE_FOX || MODE == MODE_SEL) active = (64 * j <= q0w + 31);
        if (MODE == MODE_WIN) active = (64 * j <= q0w + 31) && (64 * j + 63 >= q0w - (WINDOW - 1));
        if (active) compute_tile<MODE>(C.lds, buf, lo, j, qf, ql, O, m, l, tq, q0w, ctq2, head, (bool)((selq >> j) & 1ull), C.lane);
        if (jn < 0) break;
        j = jn; buf ^= 1;
    }
}
__device__ __forceinline__ void store_out(float* outp  , const f32x16 (&O)[4], const float sc, const int hi, const bool accumulate) {
#pragma unroll
    for (int db = 0; db < 4; ++db)
#pragma unroll
        for (int r4 = 0; r4 < 4; ++r4) { float* p = outp + 32 * db + 8 * r4 + 4 * hi;
            f32x4 v = {O[db][4 * r4] * sc, O[db][4 * r4 + 1] * sc, O[db][4 * r4 + 2] * sc, O[db][4 * r4 + 3] * sc};
            if (accumulate) v += *(const GAS f32x4*)p;
            *(GAS f32x4*)p = v; }
}
__device__ __forceinline__ void load_q(const bf16* qrow  , bf16x8 (&qf)[8], const int hi) {
#pragma unroll
    for (int c = 0; c < 8; ++c) qf[c] = *(const GAS bf16x8*)(qrow + 16 * c + 8 * hi);
}
#define ZERO_STATE(O, m, l) do { _Pragma("unroll") for (int _d = 0; _d < 4; ++_d) _Pragma("unroll") for (int _i = 0; _i < 16; ++_i) O[_d][_i] = 0.f; m = -1e30f; l = 0.f; } while (0)

__device__ __forceinline__ void fox_item(Ctx& C, const int b, const int h, const int qb) {
    const int lane = C.lane, hi = lane >> 5, q0w = 256 * qb + 32 * C.wave, tq = q0w + (lane & 31);
    const bf16* zb = (const bf16*)(C.ws + WS_ZB);
    const size_t row = (size_t)b * T + tq;
    bf16x8 qf[8]; load_q(zb + row * ZBC + ZB_FQ + h * 128, qf, hi);
    const float* cf = (const float*)(C.ws + WS_SMALL + SM_CFOX) + (size_t)(b * 4 + h) * T;
    const float ctq = cf[tq];
    TileSrc src{zb + (size_t)b * T * ZBC + ZB_FK + h * 128, ZBC, (const bf16*)(C.ws + WS_VFT) + (size_t)(b * 4 + h) * 128 * T, T};
    f32x16 O[4]; float m, l; ZERO_STATE(O, m, l);
    LaneOff lo; lane_offsets(src, C.wave, lane, lo);
    const int nt = 4 * qb + 4;
    run_branch<MODE_FOX>(C, src, lo, nt >= 64 ? ~0ull : ((1ull << nt) - 1ull), qf, (const LAS bf16*)C.lds, O, m, l, tq, q0w, cf, ctq, 0, 0ull);
    const float lt = l + __shfl_xor(l, 32);
    store_out((float*)(C.ws + WS_OFOX) + row * 512 + h * 128, O, lt > 0.f ? 1.0f / lt : 0.f, hi, false);
}

__device__ __forceinline__ void nsa_item(Ctx& C, const int b, const int ub) {
    const int lane = C.lane, r32 = lane & 31, hi = lane >> 5, wave = C.wave, h = wave & 3, qh = wave >> 2;
    const int t0 = 64 * ub, q0w = t0 + 32 * qh, tq = q0w + r32, cur = ub;
    const size_t row = (size_t)b * T + tq;
    const bf16* zb = (const bf16*)(C.ws + WS_ZB);
    const float* zf = (const float*)(C.ws + WS_ZF);
    LAS float* BT = (LAS float*)(C.lds + AT_BT); LAS float* IMP = (LAS float*)(C.lds + AT_IMP);
    LAS unsigned long long* SEL = (LAS unsigned long long*)(C.lds + AT_SEL);
    { const float* tb = (const float*)(C.ws + WS_MISC + 65536);
      for (int i = C.tid; i < NH * NBT; i += NTHREADS) BT[(i / NBT) * 792 + (i % NBT)] = tb[i]; }
    bf16x8 qf[8];
#pragma unroll
    for (int c = 0; c < 8; ++c) qf[c] = (bf16x8){0, 0, 0, 0, 0, 0, 0, 0};
    LAS bf16* QL = (LAS bf16*)(C.lds + AT_Q) + wave * (32 * 136);
#pragma unroll
    for (int i = 0; i < 8; ++i) { const int id = lane + 64 * i, rr = id >> 4, c16 = id & 15;
        *(LAS v4u*)(QL + rr * 136 + c16 * 8) = *(const GAS v4u*)(zb + ((size_t)b * T + q0w + rr) * ZBC + ZB_NQ + h * 128 + c16 * 8); }
    f32x16 O[4]; float m, l;
    {
        ZERO_STATE(O, m, l);
        float G[32];
#pragma unroll
        for (int i = 0; i < 32; ++i) G[i] = 0.f;
        float xprev = 0.f;
        const int nkeys = 4 * ub + 3, ntc = (nkeys + 63) >> 6;
        TileSrc src{(const bf16*)(C.ws + WS_SMALL + SM_KC) + (size_t)b * NCMPP * 128, 128, (const bf16*)(C.ws + WS_SMALL + SM_VCT) + (size_t)b * 128 * NCMPP, NCMPP};
        const LAS float* BTh = BT + h * 792;
        LaneOff lo; lane_offsets(src, wave, lane, lo);
        __syncthreads();
        dma_tile<MODE_CMP>(C.lds, src, lo, 0, 0, wave, lane, nullptr);
#pragma unroll
        for (int j = 0; j < 4; ++j) {
            if (j < ntc) {
                const LAS unsigned char* KT = C.lds + AT_KT + (j & 1) * 16384; const LAS unsigned char* VT = C.lds + AT_VT + (j & 1) * 16384;
                asm volatile("s_waitcnt vmcnt(0)" ::: "memory");
                __syncthreads();
                if (j + 1 < ntc) dma_tile<MODE_CMP>(C.lds, src, lo, 64 * (j + 1), (j + 1) & 1, wave, lane, nullptr);
                f32x16 s[2];
                s[0] = score_block<true>(KT, lo, qf, QL, 0, lane); s[1] = score_block<true>(KT, lo, qf, QL, 1, lane);
                float mx = m;
#pragma unroll
                for (int kb = 0; kb < 2; ++kb)
#pragma unroll
                    for (int r = 0; r < 16; ++r) {
                        const int n = 64 * j + 32 * kb + 16 * (r >> 3) + 8 * hi + (r & 7), dist = tq - 16 * n - 31;
                        const int di = dist < 0 ? 0 : (dist > 790 ? 790 : dist);
                        float v = s[kb][r] * SC_LOG2 + BTh[di];
                        v = dist >= 0 ? v : -1e30f; s[kb][r] = v; mx = fmaxf(mx, v);
                    }
                mx = fmaxf(mx, __shfl_xor(mx, 32));
                const float alpha = __builtin_amdgcn_exp2f(m - mx); m = mx;
                float rs = 0.f;
#pragma unroll
                for (int kb = 0; kb < 2; ++kb)
#pragma unroll
                    for (int r = 0; r < 16; ++r) { const float p = s[kb][r] > -1e29f ? __builtin_amdgcn_exp2f(s[kb][r] - mx) : 0.f; s[kb][r] = p; rs += p; }
                l = l * alpha + rs;
#pragma unroll
                for (int db = 0; db < 4; ++db) O[db] *= alpha;
#pragma unroll
                for (int gi = 0; gi < 8 * j; ++gi) G[gi] *= alpha;
                xprev *= alpha;
#pragma unroll
                for (int kb = 0; kb < 2; ++kb) {
                    const float x7 = __shfl_xor(s[kb][7], 32), x15 = __shfl_xor(s[kb][15], 32);
                    const float gs0 = (s[kb][0] + s[kb][1]) + (s[kb][2] + s[kb][3]), gs1 = (s[kb][4] + s[kb][5]) + (s[kb][6] + s[kb][7]);
                    const float gs2 = (s[kb][8] + s[kb][9]) + (s[kb][10] + s[kb][11]), gs3 = (s[kb][12] + s[kb][13]) + (s[kb][14] + s[kb][15]);
                    const int gb = 4 * (2 * j + kb);
                    G[gb + 0] = gs0 + (hi ? x7 : xprev);
                    G[gb + 1] = gs1 + s[kb][3];
                    G[gb + 2] = gs2 + (hi ? x15 : x7);
                    G[gb + 3] = gs3 + s[kb][11];
                    xprev = x15;
                }
                pv_block(VT, lo, s[0], 0, O); pv_block(VT, lo, s[1], 1, O);
            }
        }
        const float lt = l + __shfl_xor(l, 32), inv = lt > 0.f ? 1.0f / lt : 0.f;
        store_out((float*)(C.ws + WS_ONSA) + row * 512 + h * 128, O, inv * sigmoid_f(zf[row * ZFC + ZF_NG + h * 3 + 0]), hi, false);
        __syncthreads();
        LAS float* slab = IMP + (qh * 32 + r32) * 64 + 2 * hi;
#pragma unroll
        for (int hh = 0; hh < 4; ++hh) {
            if (h == hh) {
#pragma unroll
                for (int gi = 0; gi < 32; ++gi) { LAS float* p = slab + 8 * (gi >> 2) + 4 * ((gi & 3) >> 1) + (gi & 1); const float v = G[gi] * inv; *p = (hh == 0) ? v : (*p + v); }
            }
            __syncthreads();
        }
    }
    for (int qq = 0; qq < 8; ++qq) {
        const int qi = 8 * wave + qq, qh2 = qi >> 5, rr = qi & 31;
        float v = IMP[(qh2 * 32 + rr) * 64 + lane];
        if (lane == 0 || lane == cur || lane == cur - 1) v = 1.0e6f;
        if (lane > cur) v = -1.0f;
        int rank = 0;
        for (int i = 0; i < 64; ++i) { const float vi = __builtin_bit_cast(float, __builtin_amdgcn_readlane(__builtin_bit_cast(int, v), i)); rank += (vi > v || (vi == v && i < lane)) ? 1 : 0; }
        const unsigned long long mask = __ballot(rank < NSEL);
        if (lane == 0) SEL[qi] = mask;
    }
    __syncthreads();
    unsigned long long uni = SEL[lane];
#pragma unroll
    for (int o = 1; o < 64; o <<= 1) uni |= __shfl_xor(uni, o);
    const unsigned long long selq = SEL[32 * qh + r32];
    const unsigned long long upto = cur >= 63 ? ~0ull : ((2ull << cur) - 1ull);
    {
        ZERO_STATE(O, m, l);
        TileSrc src{zb + (size_t)b * T * ZBC + ZB_NKS, ZBC, (const bf16*)(C.ws + WS_VST) + (size_t)b * 128 * T, T};
        LaneOff lo; lane_offsets(src, wave, lane, lo);
        run_branch<MODE_SEL>(C, src, lo, uni & upto, qf, QL, O, m, l, tq, q0w, nullptr, 0.f, h, selq);
        const float lt = l + __shfl_xor(l, 32);
        store_out((float*)(C.ws + WS_ONSA) + row * 512 + h * 128, O, (lt > 0.f ? 1.0f / lt : 0.f) * sigmoid_f(zf[row * ZFC + ZF_NG + h * 3 + 1]), hi, true);
    }
    {
        ZERO_STATE(O, m, l);
        TileSrc src{zb + (size_t)b * T * ZBC + ZB_NKW, ZBC, (const bf16*)(C.ws + WS_VWT) + (size_t)b * 128 * T, T};
        const int jlo = cur >= 8 ? cur - 8 : 0;
        LaneOff lo; lane_offsets(src, wave, lane, lo);
        run_branch<MODE_WIN>(C, src, lo, upto & ~((1ull << jlo) - 1ull), qf, QL, O, m, l, tq, q0w, nullptr, 0.f, h, 0ull);
        const float lt = l + __shfl_xor(l, 32);
        store_out((float*)(C.ws + WS_ONSA) + row * 512 + h * 128, O, (lt > 0.f ? 1.0f / lt : 0.f) * sigmoid_f(zf[row * ZFC + ZF_NG + h * 3 + 2]), hi, true);
    }
}

struct GdnFrags { bf16x8 w[4], kd[2][2]; float u[4]; float egl; };
struct GdnOff { unsigned a, c, u; };
__device__ __forceinline__ void gdn_offsets(const int tr, const int tc, const int cb, const int lane, GdnOff& o) {
    const int fr = lane & 15, fq = lane >> 4;
    o.a = (unsigned)(((16 * tr + fr) * 128 + 8 * fq) * 2);
    o.c = (unsigned)(((32 * tr + fr) * 64 + 8 * fq) * 2);
    o.u = (unsigned)(((16 * tr + 4 * fq) * 128 + 32 * cb + 16 * tc + fr) * 4);
}
__device__ __forceinline__ void gdn_load(const unsigned char* gp  , const float* eglp, const GdnOff& o, GdnFrags& f) {
#pragma unroll
    for (int kk = 0; kk < 4; ++kk) f.w[kk] = *(const GAS bf16x8*)(gp + GP_W + o.a + 64 * kk);
#pragma unroll
    for (int kk = 0; kk < 2; ++kk)
#pragma unroll
        for (int t2 = 0; t2 < 2; ++t2) f.kd[t2][kk] = *(const GAS bf16x8*)(gp + GP_KDT + o.c + 2048 * t2 + 64 * kk);
#pragma unroll
    for (int r = 0; r < 4; ++r) f.u[r] = *(const GAS float*)(gp + GP_U + o.u + 512 * r);
    f.egl = *eglp;
}
#define LDS_BARRIER() do { asm volatile("s_waitcnt lgkmcnt(0)" ::: "memory"); __builtin_amdgcn_s_barrier(); asm volatile("" ::: "memory"); } while (0)
constexpr int GS_ST = 8704, GS_VN = 4608, GS_VN0 = 8 * GS_ST;
__device__ __forceinline__ void gdn_step(const GdnFrags& f, const int n, LAS unsigned char* lds, f32x4 (&S)[2], const int tr, const int tc, const int fr, const int fq) {
    const LAS bf16* STp = (const LAS bf16*)(lds + ((n + 7) & 7) * GS_ST);
    LAS bf16* STn = (LAS bf16*)(lds + (n & 7) * GS_ST);
    LAS bf16* VNT = (LAS bf16*)(lds + GS_VN0 + (n & 7) * GS_VN);
    f32x4 av = {0.f, 0.f, 0.f, 0.f};
#pragma unroll
    for (int kk = 0; kk < 4; ++kk) av = mfma16(f.w[kk], *(const LAS bf16x8*)(STp + (16 * tc + fr) * 136 + 32 * kk + 8 * fq), av);
    { v2u w; w.x = pk2(f.u[0] - av[0], f.u[1] - av[1]); w.y = pk2(f.u[2] - av[2], f.u[3] - av[3]); *(LAS v2u*)(VNT + (16 * tc + fr) * 72 + 16 * tr + 4 * fq) = w; }
    LDS_BARRIER();
    bf16x8 vf[2];
#pragma unroll
    for (int kk = 0; kk < 2; ++kk) vf[kk] = *(const LAS bf16x8*)(VNT + (16 * tc + fr) * 72 + 32 * kk + 8 * fq);
#pragma unroll
    for (int t2 = 0; t2 < 2; ++t2) { S[t2] *= f.egl;
#pragma unroll
        for (int kk = 0; kk < 2; ++kk) S[t2] = mfma16(f.kd[t2][kk], vf[kk], S[t2]);
        v2u w; w.x = pk2(S[t2][0], S[t2][1]); w.y = pk2(S[t2][2], S[t2][3]);
        *(LAS v2u*)(STn + (16 * tc + fr) * 136 + 16 * (2 * tr + t2) + 4 * fq) = w; }
    LDS_BARRIER();
}
__device__ __forceinline__ void gdn_flush(const LAS unsigned char* lds, unsigned char* sn  , unsigned char* vn, const int tid) {
#pragma unroll
    for (int i = 0; i < 8; ++i) { const int idx = tid + NTHREADS * i, slot = idx >> 9, rem = idx & 511, col = rem >> 4, c16 = rem & 15;
        *(GAS v4u*)(sn + (size_t)slot * GSN_STEP + (col * 128 + c16 * 8) * 2) = *(const LAS v4u*)(lds + slot * GS_ST + (col * 136 + c16 * 8) * 2); }
#pragma unroll
    for (int i = 0; i < 4; ++i) { const int idx = tid + NTHREADS * i, slot = idx >> 8, rem = idx & 255, col = rem >> 3, c8 = rem & 7;
        *(GAS v4u*)(vn + (size_t)slot * GVN_STEP + (col * 64 + c8 * 8) * 2) = *(const LAS v4u*)(lds + GS_VN0 + slot * GS_VN + (col * 72 + c8 * 8) * 2); }
    __syncthreads();
}
__device__ __forceinline__ void gdn_scan_item(Ctx& C, const int item) {
    const int cb = item & 3, bh = item >> 2;
    const int lane = C.lane, wave = C.wave, tr = wave >> 1, tc = wave & 1, fr = lane & 15, fq = lane >> 4;
    for (int i = C.tid; i < GS_ST / 4; i += NTHREADS) ((LAS unsigned*)(C.lds + 7 * GS_ST))[i] = 0u;
    const unsigned char* gp0 = C.ws + WS_GPRE + (size_t)bh * 64 * GPRE_UNIT;
    const float* egl0 = (const float*)(C.ws + WS_SMALL + SM_EGL) + bh * 64;
    unsigned char* sn0 = C.ws + WS_GSN + ((size_t)bh * 64 * 4 + cb) * 8192;
    unsigned char* vn0 = C.ws + WS_GVN + ((size_t)bh * 64 * 4 + cb) * 4096;
    f32x4 S[2]; S[0] = (f32x4){0.f, 0.f, 0.f, 0.f}; S[1] = S[0];
    GdnFrags f0, f1, f2, f3; GdnOff go; gdn_offsets(tr, tc, cb, lane, go);
    gdn_load(gp0, egl0, go, f0); gdn_load(gp0 + GPRE_UNIT, egl0 + 1, go, f1); gdn_load(gp0 + 2 * GPRE_UNIT, egl0 + 2, go, f2);
    __syncthreads();
    for (int n = 0; n < 64; n += 4) {
        gdn_load(gp0 + (size_t)(n + 3) * GPRE_UNIT, egl0 + n + 3, go, f3);
        gdn_step(f0, n, C.lds, S, tr, tc, fr, fq);
        if (n + 4 < 64) gdn_load(gp0 + (size_t)(n + 4) * GPRE_UNIT, egl0 + n + 4, go, f0);
        gdn_step(f1, n + 1, C.lds, S, tr, tc, fr, fq);
        if (n + 5 < 64) gdn_load(gp0 + (size_t)(n + 5) * GPRE_UNIT, egl0 + n + 5, go, f1);
        gdn_step(f2, n + 2, C.lds, S, tr, tc, fr, fq);
        if (n + 6 < 64) gdn_load(gp0 + (size_t)(n + 6) * GPRE_UNIT, egl0 + n + 6, go, f2);
        gdn_step(f3, n + 3, C.lds, S, tr, tc, fr, fq);
        if ((n & 7) == 4) gdn_flush(C.lds, sn0 + (size_t)(n - 4) * GSN_STEP, vn0 + (size_t)(n - 4) * GVN_STEP, C.tid);
    }
}

__device__ __forceinline__ void lru_scan_item(Ctx& C, const int item) {
    const int b = item >> 3, ch = (item & 7) * 64 + C.lane, wave = C.wave;
    const float* LA = (const float*)(C.ws + WS_LA) + ((size_t)b * T + 512 * wave) * 512 + ch;
    const float* LU = (const float*)(C.ws + WS_LU) + ((size_t)b * T + 512 * wave) * 512 + ch;
    float* LH = (float*)(C.ws + WS_LH) + ((size_t)b * T + 512 * wave) * 512 + ch;
    LAS float* HE = (LAS float*)C.lds; LAS float* PE = HE + 8 * 64;
    float hh = 0.f, pp = 1.f;
    for (int t = 0; t < 512; t += 8) {
        float a[8], u[8];
#pragma unroll
        for (int i = 0; i < 8; ++i) { a[i] = LA[(size_t)(t + i) * 512]; u[i] = LU[(size_t)(t + i) * 512]; }
#pragma unroll
        for (int i = 0; i < 8; ++i) { hh = a[i] * hh + u[i]; pp *= a[i]; }
    }
    HE[wave * 64 + C.lane] = hh; PE[wave * 64 + C.lane] = pp;
    __syncthreads();
    float H = 0.f;
    for (int s = 0; s < wave; ++s) H = PE[s * 64 + C.lane] * H + HE[s * 64 + C.lane];
    for (int t = 0; t < 512; t += 8) {
        float a[8], u[8];
#pragma unroll
        for (int i = 0; i < 8; ++i) { a[i] = LA[(size_t)(t + i) * 512]; u[i] = LU[(size_t)(t + i) * 512]; }
#pragma unroll
        for (int i = 0; i < 8; ++i) { H = a[i] * H + u[i]; LH[(size_t)(t + i) * 512] = H; }
    }
}

__device__ __forceinline__ void mix_phase(Ctx& C, const int l, const int qoff) {
    const int q0 = 16 * l + 8 + qoff;
    QUEUE_LOOP(q0 + 0, 32, gdn_scan_item(C, j));
    QUEUE_LOOP(q0 + 1, 16, lru_scan_item(C, j));
    QUEUE_LOOP(q0 + 2, 128, fox_item(C, (j & 7) >> 2, j & 3, 15 - (j >> 3)));
    QUEUE_LOOP(q0 + 3, 128, nsa_item(C, j & 1, 63 - (j >> 1)));
}
__device__ __forceinline__ void gdn_out_job(Ctx& C, const int l, const int job) {
    const int n = job & 63, bh = job >> 6, b = bh >> 2, h = bh & 3;
    const int lane = C.lane, wave = C.wave, tr = wave >> 1, chalf = wave & 1, fr = lane & 15, fq = lane >> 4;
    const unsigned char* gp = C.ws + WS_GPRE + (size_t)job * GPRE_UNIT;
    bf16x8 qt[4], qk[2];
#pragma unroll
    for (int kk = 0; kk < 4; ++kk) qt[kk] = *(const GAS bf16x8*)(gp + GP_QT + ((16 * tr + fr) * 128 + 32 * kk + 8 * fq) * 2);
#pragma unroll
    for (int kk = 0; kk < 2; ++kk) qk[kk] = *(const GAS bf16x8*)(gp + GP_QK + ((16 * tr + fr) * 64 + 32 * kk + 8 * fq) * 2);
    f32x4 acc[4];
#pragma unroll
    for (int i = 0; i < 4; ++i) {
        acc[i] = (f32x4){0.f, 0.f, 0.f, 0.f};
        const int ct = 4 * chalf + i, cb = ct >> 1, within = (ct & 1) * 16 + fr;
        if (n > 0) { const unsigned char* sn = C.ws + WS_GSN + ((size_t)(job - 1) * 4 + cb) * 8192 + (within * 128 + 8 * fq) * 2;
#pragma unroll
            for (int kk = 0; kk < 4; ++kk) acc[i] = mfma16(qt[kk], *(const GAS bf16x8*)(sn + 64 * kk), acc[i]); }
        const unsigned char* vn = C.ws + WS_GVN + ((size_t)job * 4 + cb) * 4096 + (within * 64 + 8 * fq) * 2;
#pragma unroll
        for (int kk = 0; kk < 2; ++kk) acc[i] = mfma16(qk[kk], *(const GAS bf16x8*)(vn + 64 * kk), acc[i]);
    }
    LAS float* PS = (LAS float*)C.lds;
    float ss[4];
#pragma unroll
    for (int r = 0; r < 4; ++r) { float s = acc[0][r] * acc[0][r] + acc[1][r] * acc[1][r] + acc[2][r] * acc[2][r] + acc[3][r] * acc[3][r];
        s += __shfl_xor(s, 1); s += __shfl_xor(s, 2); s += __shfl_xor(s, 4); s += __shfl_xor(s, 8); ss[r] = s; }
    if (fr == 0) {
#pragma unroll
        for (int r = 0; r < 4; ++r) PS[(16 * tr + 4 * fq + r) * 2 + chalf] = ss[r]; }
    __syncthreads();
    const float* gng = inp<I_GNORM>() + l * 128;
    const float* zf = (const float*)(C.ws + WS_ZF);
    bf16* Y = (bf16*)(C.ws + WS_XN);
#pragma unroll
    for (int r = 0; r < 4; ++r) {
        const int row = 16 * tr + 4 * fq + r; const size_t m = (size_t)b * T + 64 * n + row;
        const float rstd = 1.0f / sqrtf((PS[row * 2] + PS[row * 2 + 1]) * (1.f / 128.f) + EPS);
#pragma unroll
        for (int i = 0; i < 4; ++i) { const int col = 16 * (4 * chalf + i) + fr;
            const float gz = zf[m * ZFC + ZF_GZ + h * 128 + col];
            Y[m * D + 512 + h * 128 + col] = (bf16)f2bf(acc[i][r] * rstd * gng[col] * silu_ff(gz)); }
    }
}
__device__ __forceinline__ void post_phase(Ctx& C, const int l) {
    QUEUE_LOOP(16 * l + 12, 512, gdn_out_job(C, l, j));
    refresh_ids(C);
    const int lane = C.lane;
    bf16* Y = (bf16*)(C.ws + WS_XN);
    const float* zf = (const float*)(C.ws + WS_ZF);
    const float* ong = inp<I_ONG>() + (size_t)l * 3 * 512;
    for (int m = C.bid * NWAVES + C.wave; m < M; m += C.G * NWAVES) {
        const size_t r512 = (size_t)m * 512 + 8 * lane;
        f32x4 a0 = *(const GAS f32x4*)((const float*)(C.ws + WS_OFOX) + r512), a1 = *(const GAS f32x4*)((const float*)(C.ws + WS_OFOX) + r512 + 4);
        f32x4 c0 = *(const GAS f32x4*)((const float*)(C.ws + WS_LH) + r512), c1 = *(const GAS f32x4*)((const float*)(C.ws + WS_LH) + r512 + 4);
        f32x4 d0 = *(const GAS f32x4*)((const float*)(C.ws + WS_ONSA) + r512), d1 = *(const GAS f32x4*)((const float*)(C.ws + WS_ONSA) + r512 + 4);
        const f32x4 lg0 = *(const GAS f32x4*)(zf + (size_t)m * ZFC + ZF_LG + 8 * lane), lg1 = *(const GAS f32x4*)(zf + (size_t)m * ZFC + ZF_LG + 8 * lane + 4);
#pragma unroll
        for (int i = 0; i < 4; ++i) { c0[i] *= gelu_tanh_f(lg0[i]); c1[i] *= gelu_tanh_f(lg1[i]); }
#define SS8(x0, x1) ((x0.x * x0.x + x0.y * x0.y) + (x0.z * x0.z + x0.w * x0.w) + (x1.x * x1.x + x1.y * x1.y) + (x1.z * x1.z + x1.w * x1.w))
        const float ra = 1.0f / sqrtf(wave_sum(SS8(a0, a1)) * (1.f / 512.f) + EPS);
        const float rc = 1.0f / sqrtf(wave_sum(SS8(c0, c1)) * (1.f / 512.f) + EPS);
        const float rd = 1.0f / sqrtf(wave_sum(SS8(d0, d1)) * (1.f / 512.f) + EPS);
#undef SS8
        const f32x4 ga0 = *(const GAS f32x4*)(ong + 8 * lane), ga1 = *(const GAS f32x4*)(ong + 8 * lane + 4);
        const f32x4 gc0 = *(const GAS f32x4*)(ong + 512 + 8 * lane), gc1 = *(const GAS f32x4*)(ong + 512 + 8 * lane + 4);
        const f32x4 gd0 = *(const GAS f32x4*)(ong + 1024 + 8 * lane), gd1 = *(const GAS f32x4*)(ong + 1024 + 8 * lane + 4);
        bf16* yr = Y + (size_t)m * D + 8 * lane;
        v4u w;
        w.x = pk2(a0.x * ra * ga0.x, a0.y * ra * ga0.y); w.y = pk2(a0.z * ra * ga0.z, a0.w * ra * ga0.w); w.z = pk2(a1.x * ra * ga1.x, a1.y * ra * ga1.y); w.w = pk2(a1.z * ra * ga1.z, a1.w * ra * ga1.w);
        *(GAS v4u*)yr = w;
        w.x = pk2(c0.x * rc * gc0.x, c0.y * rc * gc0.y); w.y = pk2(c0.z * rc * gc0.z, c0.w * rc * gc0.w); w.z = pk2(c1.x * rc * gc1.x, c1.y * rc * gc1.y); w.w = pk2(c1.z * rc * gc1.z, c1.w * rc * gc1.w);
        *(GAS v4u*)(yr + 1024) = w;
        w.x = pk2(d0.x * rd * gd0.x, d0.y * rd * gd0.y); w.y = pk2(d0.z * rd * gd0.z, d0.w * rd * gd0.w); w.z = pk2(d1.x * rd * gd1.x, d1.y * rd * gd1.y); w.w = pk2(d1.z * rd * gd1.z, d1.w * rd * gd1.w);
        *(GAS v4u*)(yr + 1536) = w;
    }
}
#ifndef N_LAUNCHES
#define N_LAUNCHES 1
#endif
constexpr int PH_PER_LAYER = 12, NPHASES = 1 + DEPTH * PH_PER_LAYER;
struct Args { const float* in[N_IN]; float* out; unsigned char* ws; int ph_lo, ph_hi; };
static_assert(sizeof(Args) == (N_IN + 2) * 8 + 8, "Args has no padding");

#define IN_PH(k) (lo <= (k) && (k) < hi)
#define SEAM(k) do { if (IN_PH(k) && IN_PH((k) + 1)) xcd_barrier(bar); } while (0)
template <int l> __device__ __forceinline__ void layer_phases(Ctx& C, const XcdBarrier& bar, const int lo, const int hi) {
        const int pb = 1 + l * PH_PER_LAYER;
        unsigned char* wl = C.ws + WS_W + (size_t)l * W_LAYER;
        bf16* XN = (bf16*)(C.ws + WS_XN); bf16* ACT = (bf16*)(C.ws + WS_ACT);
        if (IN_PH(pb + 0)) {
            pg8::Gemm g{XN, (const bf16*)(wl + WO_GU1), M, 2 * FF, D}; pg8::StaticOrder S; S.init(M, 2 * FF, C.G, C.bid);
            pg8::EpiSwiGLU E{ACT, FF};
            pg8::gemm_phase<pg8::EpiSwiGLU, pg8::StaticOrder, true, true>(C.lds, g, S, E);
        }
        SEAM(pb + 0);
        if (IN_PH(pb + 1)) {
            pg8::Gemm g{ACT, (const bf16*)(wl + WO_DN1), M, D, FF}; pg8::StaticOrder S; S.init(M, D, C.G, C.bid);
            pg8::EpiResid E{hptr(), D, 0.5f};
            pg8::gemm_phase<pg8::EpiResid, pg8::StaticOrder, false, true>(C.lds, g, S, E);
        }
        SEAM(pb + 1);
        if (IN_PH(pb + 2)) norm_phase_bf16(C, inp<I_MIXG>() + l * D);
        SEAM(pb + 2);
        if (IN_PH(pb + 3)) {
            pg8::Gemm g{XN, (const bf16*)(wl + WO_WIN), M, ZC, D}; pg8::StaticOrder S; S.init(M, ZC, C.G, C.bid);
            pg8::EpiWin E{(bf16*)(C.ws + WS_ZB), ZBC, (float*)(C.ws + WS_ZF), ZFC, (const float*)(C.ws + WS_MISC) + l * ZC, ZBC / 256};
            pg8::gemm_phase<pg8::EpiWin, pg8::StaticOrder, true, true>(C.lds, g, S, E);
        }
        SEAM(pb + 3);
        if (IN_PH(pb + 4)) pre_phase(C, l, 0);
        SEAM(pb + 4);
        if (IN_PH(pb + 5)) mix_phase(C, l, 0);
        SEAM(pb + 5);
        if (IN_PH(pb + 6)) post_phase(C, l);
        SEAM(pb + 6);
#ifdef PROBE_ITEM
        if (IN_PH(pb + 5)) {
#if PROBE_ITEM == 0
            QUEUE_LOOP(16 * l + 40, 32, gdn_scan_item(C, j));
#elif PROBE_ITEM == 1
            QUEUE_LOOP(16 * l + 40, 128, fox_item(C, (j & 7) >> 2, j & 3, 15 - (j >> 3)));
#elif PROBE_ITEM == 2
            QUEUE_LOOP(16 * l + 40, 128, nsa_item(C, j & 1, 63 - (j >> 1)));
#elif PROBE_ITEM == 3
            QUEUE_LOOP(16 * l + 40, 16, lru_scan_item(C, j));
#endif
        }
        SEAM(pb + 5);
#endif
        if (IN_PH(pb + 7)) {
            pg8::Gemm g{XN, (const bf16*)(wl + WO_WOUT), M, D, D}; pg8::StaticOrder S; S.init(M, D, C.G, C.bid);
            pg8::EpiResid E{hptr(), D, 1.0f};
            pg8::gemm_phase<pg8::EpiResid, pg8::StaticOrder, false, true>(C.lds, g, S, E);
        }
        SEAM(pb + 7);
        if (IN_PH(pb + 8)) norm_phase_bf16(C, inp<I_F2G>() + l * D);
        SEAM(pb + 8);
        if (IN_PH(pb + 9)) {
            pg8::Gemm g{XN, (const bf16*)(wl + WO_GU2), M, 2 * FF, D}; pg8::StaticOrder S; S.init(M, 2 * FF, C.G, C.bid);
            pg8::EpiSwiGLU E{ACT, FF};
            pg8::gemm_phase<pg8::EpiSwiGLU, pg8::StaticOrder, true, true>(C.lds, g, S, E);
        }
        SEAM(pb + 9);
        if (IN_PH(pb + 10)) {
            pg8::Gemm g{ACT, (const bf16*)(wl + WO_DN2), M, D, FF}; pg8::StaticOrder S; S.init(M, D, C.G, C.bid);
            pg8::EpiResid E{hptr(), D, 0.5f};
            pg8::gemm_phase<pg8::EpiResid, pg8::StaticOrder, false, true>(C.lds, g, S, E);
        }
        SEAM(pb + 10);
        if (IN_PH(pb + 11)) {
            if (l + 1 < DEPTH) norm_phase_bf16(C, inp<I_F1G>() + (l + 1) * D);
            else { refresh_ids(C); float* const hp = hptr(); for (int m = C.bid * NWAVES + C.wave; m < M; m += C.G * NWAVES) rms_row_f32(hp + (size_t)m * D, inp<I_FING>(), hp + (size_t)m * D, C.lane); }
        }
        SEAM(pb + 11);
    }
__global__ void __launch_bounds__(NTHREADS, 2) fwd_kernel(Args args) {
    extern __shared__ __attribute__((aligned(16))) unsigned char lds_raw[];
    Ctx C;
    C.lds = (LAS unsigned char*)lds_raw;
    C.tid = threadIdx.x; C.lane = C.tid & 63; C.wave = __builtin_amdgcn_readfirstlane(C.tid >> 6);
    C.G = gridDim.x; C.bid = blockIdx.x;
    C.ws = args.ws;
    if (C.tid < 64) ((LAS unsigned*)(C.lds + LDS_CTL_OFF))[C.tid] = 0u;
    __syncthreads();
    XcdBarrier bar; bar.bar = (unsigned*)C.ws + CW_BAR; bar.x = 0; bar.st = nullptr;
    const int lo = args.ph_lo, hi = args.ph_hi;
    if (hi - lo > 1) bar = xcd_barrier_post((unsigned*)C.ws + CW_BAR, (volatile LAS unsigned*)(C.lds + LDS_CTL_OFF));

    if (IN_PH(0)) { prologue_phase(C); }
    SEAM(0);
    layer_phases<0>(C, bar, lo, hi);
    layer_phases<1>(C, bar, lo, hi);
    static_assert(DEPTH == 2, "two layers");
#undef IN_PH
#undef SEAM
}

extern "C" void kernel_launch(void* const* d_in, const int* in_sizes, int n_in, void* d_out, int out_size, void* d_ws, size_t ws_size, hipStream_t stream) {
    static int grid = 0;
    if (grid == 0) {
        if (n_in != N_IN || in_sizes[0] != M * D || out_size != M * D || ws_size < WS_END) { fprintf(stderr, "kernel_launch: unexpected shapes (n_in %d, in0 %d, out %d, ws %zu)\n", n_in, n_in > 0 ? in_sizes[0] : -1, out_size, ws_size); grid = -1; return; }
        int dev = 0, cus = 0, per_cu = 0;
        if (hipGetDevice(&dev) != hipSuccess || hipDeviceGetAttribute(&cus, hipDeviceAttributeMultiprocessorCount, dev) != hipSuccess) { grid = -1; return; }
        if (hipFuncSetAttribute((const void*)fwd_kernel, hipFuncAttributeMaxDynamicSharedMemorySize, LDS_BYTES) != hipSuccess) { fprintf(stderr, "kernel_launch: hipFuncSetAttribute failed\n"); grid = -1; return; }
        if (hipOccupancyMaxActiveBlocksPerMultiprocessor(&per_cu, (const void*)fwd_kernel, NTHREADS, LDS_BYTES) != hipSuccess || per_cu < 1) { fprintf(stderr, "kernel_launch: occupancy query reports %d\n", per_cu); }
        (void)hipGetLastError();
        grid = cus;
    }
    if (grid < 0) return;
    if (hipMemsetAsync((char*)d_ws + WS_CTL, 0, CTL_ZERO_BYTES, stream) != hipSuccess) return;
    Args a{};
    for (int i = 0; i < N_IN; ++i) a.in[i] = (const float*)d_in[i];
    a.out = (float*)d_out; a.ws = (unsigned char*)d_ws;
#if N_LAUNCHES == 1
    a.ph_lo = 0; a.ph_hi = NPHASES;
    hipLaunchKernelGGL(fwd_kernel, dim3(grid), dim3(NTHREADS), LDS_BYTES, stream, a);
#else
    for (int p = 0; p < NPHASES; ++p) { a.ph_lo = p; a.ph_hi = p + 1; hipLaunchKernelGGL(fwd_kernel, dim3(grid), dim3(NTHREADS), LDS_BYTES, stream, a); }
#endif
}
```

```cpp
#include <hip/hip_runtime.h>
#include <cstdio>
#include <cstdint>
#include <cmath>
namespace pg8 {
#define PG8_LAS __attribute__((address_space(3)))
typedef unsigned short bf16_t;
typedef short bf16x8 __attribute__((ext_vector_type(8)));
typedef float f32x4 __attribute__((ext_vector_type(4)));
typedef unsigned u32x4 __attribute__((ext_vector_type(4)));
constexpr int BM = 256, BK = 64, HALF = 128, HTB = HALF * BK * 2  , STAGE_BYTES = 8 * HTB, NXCD = 8, WGM = 8;

__host__ __device__ __forceinline__ int lds_byte(int r, int c) { const int st = (r >> 4) * 2 + (c >> 5), rr = r & 15, cc = c & 31, ob = rr * 64 + cc * 2; return st * 1024 + (ob ^ (((ob >> 9) & 1) << 5)); }
__host__ __device__ __forceinline__ void stage_rc(int b, int& R, int& C) { const int st = b / 1024, sb = b % 1024, swz = sb ^ (((sb >> 9) & 1) << 5); R = (st >> 1) * 16 + swz / 64; C = (st & 1) * 32 + (swz % 64) / 2; }
__host__ __device__ __forceinline__ int perm32(int rho) { const int n = rho >> 4, i = rho & 15; return 8 * (i >> 2) + 4 * n + (i & 3); }

struct Unit { int pm, pn; };
struct Gemm { const bf16_t* A; const bf16_t* Bt; int M, N, K; };

struct StaticOrder {
    int nM, nN, nwg, G, c;
    __host__ __device__ void init(int M, int N, int G_, int c_) { nM = M / BM; nN = N / BM; nwg = nM * nN; G = G_; c = c_; }
    __host__ __device__ bool next(int i, Unit& u) const {
        const long L = (long)i * G + c; if (L >= nwg) return false;
        int wgid = (int)L; { const int q = nwg / NXCD, r = nwg % NXCD, xcd = wgid % NXCD, off = wgid / NXCD; wgid = (xcd < r ? xcd * (q + 1) : r * (q + 1) + (xcd - r) * q) + off; }
        const int nig = WGM * nN, gid = wgid / nig, fm = gid * WGM, gsz = (nM - fm) < WGM ? (nM - fm) : WGM;
        u.pm = fm + ((wgid % nig) % gsz); u.pn = (wgid % nig) / gsz; return true;
    }
    __device__ __forceinline__ void a_ready(const Unit&) const {}
    __device__ __forceinline__ void done(const Unit&) const {}
};

__device__ __forceinline__ unsigned cvt_pk_bf16(float lo, float hi) { unsigned r; asm volatile("v_cvt_pk_bf16_f32 %0, %1, %2" : "=v"(r) : "v"(lo), "v"(hi)); return r; }
typedef unsigned u32x2v __attribute__((ext_vector_type(2)));
__device__ __forceinline__ float silu_f(float x) { return x * __builtin_amdgcn_rcpf(1.0f + __builtin_amdgcn_exp2f(-1.44269504f * x)); }

struct EpiSwiGLU {
    static constexpr bool PERM = true, AFTER_DRAIN = false;
    bf16_t* O; int ldc;
    __device__ __forceinline__ void operator()(const f32x4 (&acc)[2][2][4][2], const Unit& u, int wr, int wc, int fr, int fq) const {
        const int row0 = u.pm * BM + wr * 64 + fr, col0 = u.pn * HALF + wc * 32 + 8 * fq;
#pragma unroll
        for (int ai = 0; ai < 2; ++ai)
#pragma unroll
            for (int m = 0; m < 4; ++m) { bf16_t* rowp = O + (size_t)(row0 + ai * HALF + m * 16) * ldc + col0;
                const f32x4 g0 = acc[ai][0][m][0], g1 = acc[ai][0][m][1], u0 = acc[ai][1][m][0], u1 = acc[ai][1][m][1];
                u32x4 w;
                w.x = cvt_pk_bf16(silu_f(g0[0]) * u0[0], silu_f(g0[1]) * u0[1]); w.y = cvt_pk_bf16(silu_f(g0[2]) * u0[2], silu_f(g0[3]) * u0[3]);
                w.z = cvt_pk_bf16(silu_f(g1[0]) * u1[0], silu_f(g1[1]) * u1[1]); w.w = cvt_pk_bf16(silu_f(g1[2]) * u1[2], silu_f(g1[3]) * u1[3]);
                *(u32x4*)rowp = w; }
    }
};
struct EpiResid {
    static constexpr bool PERM = false, AFTER_DRAIN = false;
    float* C; int ldc; float scale;
    __device__ __forceinline__ void operator()(const f32x4 (&acc)[2][2][4][2], const Unit& u, int wr, int wc, int fr, int fq) const {
        const int row0 = u.pm * BM + wr * 64 + fr, col0 = u.pn * BM + wc * 32 + 4 * fq;
#pragma unroll
        for (int ai = 0; ai < 2; ++ai)
#pragma unroll
            for (int m = 0; m < 4; ++m) { float* rowp = C + (size_t)(row0 + ai * HALF + m * 16) * ldc + col0;
                f32x4 old[2][2];
#pragma unroll
                for (int bj = 0; bj < 2; ++bj)
#pragma unroll
                    for (int n = 0; n < 2; ++n) old[bj][n] = *(const f32x4*)(rowp + bj * HALF + n * 16);
#pragma unroll
                for (int bj = 0; bj < 2; ++bj)
#pragma unroll
                    for (int n = 0; n < 2; ++n) *(f32x4*)(rowp + bj * HALF + n * 16) = old[bj][n] + acc[ai][bj][m][n] * scale;
                asm volatile("" ::: "memory"); }
    }
};
struct EpiWin {
    static constexpr bool PERM = true, AFTER_DRAIN = false;
    bf16_t* ZB; int ldb; float* ZF; int ldf; const float* bias; int nb16;
    __device__ __forceinline__ void operator()(const f32x4 (&acc)[2][2][4][2], const Unit& u, int wr, int wc, int fr, int fq) const {
        const int row0 = u.pm * BM + wr * 64 + fr, col0 = u.pn * BM + wc * 32 + 8 * fq;
        if (u.pn < nb16) {
#pragma unroll
            for (int bj = 0; bj < 2; ++bj) { const f32x4 b0 = *(const f32x4*)(bias + col0 + bj * HALF), b1 = *(const f32x4*)(bias + col0 + bj * HALF + 4);
#pragma unroll
                for (int ai = 0; ai < 2; ++ai)
#pragma unroll
                    for (int m = 0; m < 4; ++m) { bf16_t* rowp = ZB + (size_t)(row0 + ai * HALF + m * 16) * ldb + col0 + bj * HALF;
                        const f32x4 v0 = acc[ai][bj][m][0] + b0, v1 = acc[ai][bj][m][1] + b1;
                        u32x4 w; w.x = cvt_pk_bf16(v0[0], v0[1]); w.y = cvt_pk_bf16(v0[2], v0[3]); w.z = cvt_pk_bf16(v1[0], v1[1]); w.w = cvt_pk_bf16(v1[2], v1[3]);
                        *(u32x4*)rowp = w; }
                asm volatile("" ::: "memory"); }
        } else {
            const int cf = col0 - nb16 * BM;
#pragma unroll
            for (int bj = 0; bj < 2; ++bj) { const f32x4 b0 = *(const f32x4*)(bias + col0 + bj * HALF), b1 = *(const f32x4*)(bias + col0 + bj * HALF + 4);
#pragma unroll
                for (int ai = 0; ai < 2; ++ai)
#pragma unroll
                    for (int m = 0; m < 4; ++m) { float* rowp = ZF + (size_t)(row0 + ai * HALF + m * 16) * ldf + cf + bj * HALF;
                        *(f32x4*)rowp = acc[ai][bj][m][0] + b0; *(f32x4*)(rowp + 4) = acc[ai][bj][m][1] + b1; }
                asm volatile("" ::: "memory"); }
        }
    }
};
template <class Epi, class Sched, bool ALIGN_EPI = false, bool SP2 = false>
__device__ __forceinline__ void gemm_phase(PG8_LAS unsigned char* lds, const Gemm g, const Sched& S, const Epi& E) {
    const int tid = threadIdx.x, wid = __builtin_amdgcn_readfirstlane(tid >> 6), lane = tid & 63, wr = wid >> 2, wc = wid & 3, fr = lane & 15, fq = lane >> 4;
    const int K = g.K, nt = K / BK;
    unsigned voffA[2], voffB[2];
#pragma unroll
    for (int i = 0; i < 2; ++i) { int R, C; stage_rc(tid * 16 + i * 8192, R, C); const int Rb = Epi::PERM ? ((R & ~31) + perm32(R & 31)) : R;
        voffA[i] = (unsigned)(R * K + C) * 2u; voffB[i] = (unsigned)(Rb * K + C) * 2u; }
    const size_t kstep = (size_t)(BK * 2);
    const size_t hstep = (size_t)HALF * K * 2;
    const size_t tstep = 2 * hstep;
    const unsigned ldsw = (unsigned)wid * 1024u;
    const int aoff = lds_byte(wr * 64 + fr, fq * 8), boff = lds_byte(wc * 32 + fr, fq * 8);
#define PG8_SA(b, h) (((b) * 2 + (h)) * HTB)
#define PG8_SB(b, h) ((4 + (b) * 2 + (h)) * HTB)
#define PG8_STAGE(bufoff, gbase, voff) do { _Pragma("unroll") for (int _i = 0; _i < 2; ++_i) \
        __builtin_amdgcn_global_load_lds((const unsigned*)((const char*)(gbase) + (voff)[_i]), (PG8_LAS unsigned*)(lds + (bufoff) + ldsw + _i * 8192), 16, 0, 0); } while (0)
#define PG8_LDA(dst, b, h) do { _Pragma("unroll") for (int m = 0; m < 4; ++m) _Pragma("unroll") for (int k = 0; k < 2; ++k) dst[m][k] = *(const PG8_LAS bf16x8*)(lds + PG8_SA(b, h) + aoff + m * 2048 + k * 1024); } while (0)
#define PG8_LDB(dst, b, h) do { _Pragma("unroll") for (int n = 0; n < 2; ++n) _Pragma("unroll") for (int k = 0; k < 2; ++k) dst[n][k] = *(const PG8_LAS bf16x8*)(lds + PG8_SB(b, h) + boff + n * 2048 + k * 1024); } while (0)
#define PG8_MMA(ai, bj, At, Bt) do { __builtin_amdgcn_s_setprio(1); _Pragma("unroll") for (int m = 0; m < 4; ++m) _Pragma("unroll") for (int n = 0; n < 2; ++n) _Pragma("unroll") for (int k = 0; k < 2; ++k) \
        acc[ai][bj][m][n] = __builtin_amdgcn_mfma_f32_16x16x32_bf16(Bt[n][k], At[m][k], acc[ai][bj][m][n], 0, 0, 0); __builtin_amdgcn_s_setprio(0); } while (0)
#define PG8_WAIT_V(n) asm volatile("s_waitcnt vmcnt(" #n ")" ::: "memory")
#define PG8_WAIT_L(n) asm volatile("s_waitcnt lgkmcnt(" #n ")" ::: "memory")
#define PG8_BAR __builtin_amdgcn_s_barrier()
#define PG8_SCHED __builtin_amdgcn_sched_barrier(0)
    Unit cur, nxt; int ui = 0;
    if (!S.next(0, cur)) return;
    f32x4 acc[2][2][4][2];
#pragma unroll
    for (int a = 0; a < 2; ++a)
#pragma unroll
        for (int b = 0; b < 2; ++b)
#pragma unroll
            for (int m = 0; m < 4; ++m)
#pragma unroll
                for (int n = 0; n < 2; ++n) acc[a][b][m][n] = (f32x4){0.f, 0.f, 0.f, 0.f};
    bf16x8 At[4][2], B0[2][2], B1[2][2];
    const char* cA = (const char*)g.A + (size_t)cur.pm * tstep; const char* cB = (const char*)g.Bt + (size_t)cur.pn * tstep;
    S.a_ready(cur);
    if constexpr (SP2) {
        PG8_STAGE(PG8_SB(0, 0), cB, voffB); PG8_STAGE(PG8_SB(0, 1), cB + hstep, voffB); PG8_STAGE(PG8_SA(0, 0), cA, voffA); PG8_STAGE(PG8_SA(0, 1), cA + hstep, voffA);
        if (wr == 1) PG8_BAR;
        PG8_WAIT_V(2); PG8_BAR;
        PG8_STAGE(PG8_SB(1, 0), cB + kstep, voffB); PG8_STAGE(PG8_SA(1, 0), cA + kstep, voffA); PG8_STAGE(PG8_SB(1, 1), cB + hstep + kstep, voffB);
        PG8_WAIT_V(6); PG8_BAR;
    } else {
        PG8_STAGE(PG8_SB(0, 0), cB, voffB); PG8_STAGE(PG8_SA(0, 0), cA, voffA); PG8_STAGE(PG8_SB(0, 1), cB + hstep, voffB); PG8_STAGE(PG8_SA(0, 1), cA + hstep, voffA);
        if (wr == 1) PG8_BAR;
        PG8_WAIT_V(4); PG8_BAR;
        PG8_STAGE(PG8_SB(1, 0), cB + kstep, voffB); PG8_STAGE(PG8_SA(1, 0), cA + kstep, voffA); PG8_STAGE(PG8_SB(1, 1), cB + hstep + kstep, voffB);
        PG8_WAIT_V(6); PG8_BAR;
    }
    for (;;) {
        const bool has_next = S.next(ui + 1, nxt);
        const char* nA = has_next ? (const char*)g.A + (size_t)nxt.pm * tstep : cA; const char* nB = has_next ? (const char*)g.Bt + (size_t)nxt.pn * tstep : cB;
        for (int t = 0; t < nt; t += 2) {
            const bool last = (t == nt - 2);
            const char* a1 = cA + (size_t)(t + 1) * kstep;
            const char* a2 = last ? nA : cA + (size_t)(t + 2) * kstep; const char* b2 = last ? nB : cB + (size_t)(t + 2) * kstep;
            const char* a3 = a2 + kstep; const char* b3 = b2 + kstep;
            if (last && has_next) S.a_ready(nxt);
            if constexpr (SP2) {
            PG8_LDB(B0, 0, 0); PG8_LDB(B1, 0, 1); PG8_SCHED; PG8_LDA(At, 0, 0); PG8_STAGE(PG8_SA(1, 1), a1 + hstep, voffA);
            PG8_WAIT_V(8); PG8_WAIT_L(0); PG8_BAR; PG8_MMA(0, 0, At, B0); PG8_MMA(0, 1, At, B1); PG8_BAR; PG8_SCHED;
            PG8_LDA(At, 0, 1); PG8_STAGE(PG8_SB(0, 0), b2, voffB); PG8_STAGE(PG8_SB(0, 1), b2 + hstep, voffB); PG8_STAGE(PG8_SA(0, 0), a2, voffA);
            PG8_WAIT_V(8); PG8_WAIT_L(0); PG8_BAR; PG8_MMA(1, 0, At, B0); PG8_MMA(1, 1, At, B1); PG8_BAR; PG8_SCHED;
            PG8_LDB(B0, 1, 0); PG8_LDB(B1, 1, 1); PG8_SCHED; PG8_LDA(At, 1, 0); PG8_STAGE(PG8_SA(0, 1), a2 + hstep, voffA);
            PG8_WAIT_V(8); PG8_WAIT_L(0); PG8_BAR; PG8_MMA(0, 0, At, B0); PG8_MMA(0, 1, At, B1); PG8_BAR; PG8_SCHED;
            PG8_LDA(At, 1, 1); PG8_STAGE(PG8_SB(1, 0), b3, voffB); PG8_STAGE(PG8_SB(1, 1), b3 + hstep, voffB); PG8_STAGE(PG8_SA(1, 0), a3, voffA);
            PG8_WAIT_V(8); PG8_WAIT_L(0); PG8_BAR; PG8_MMA(1, 0, At, B0); PG8_MMA(1, 1, At, B1); PG8_BAR; PG8_SCHED;
            } else {
            PG8_LDB(B0, 0, 0); PG8_SCHED; PG8_LDA(At, 0, 0); PG8_STAGE(PG8_SA(1, 1), a1 + hstep, voffA);
            PG8_WAIT_L(8); PG8_BAR; PG8_WAIT_L(0); PG8_MMA(0, 0, At, B0); PG8_BAR; PG8_SCHED;
            PG8_LDB(B1, 0, 1); PG8_STAGE(PG8_SB(0, 0), b2, voffB);
            PG8_BAR; PG8_WAIT_L(0); PG8_MMA(0, 1, At, B1); PG8_BAR;
            PG8_LDA(At, 0, 1); PG8_STAGE(PG8_SA(0, 0), a2, voffA);
            PG8_BAR; PG8_WAIT_L(0); PG8_MMA(1, 0, At, B0); PG8_BAR; PG8_SCHED;
            PG8_STAGE(PG8_SB(0, 1), b2 + hstep, voffB);
            PG8_WAIT_V(6); PG8_BAR; PG8_MMA(1, 1, At, B1); PG8_BAR;
            PG8_LDB(B0, 1, 0); PG8_SCHED; PG8_LDA(At, 1, 0); PG8_STAGE(PG8_SA(0, 1), a2 + hstep, voffA);
            PG8_WAIT_L(8); PG8_BAR; PG8_WAIT_L(0); PG8_MMA(0, 0, At, B0); PG8_BAR; PG8_SCHED;
            PG8_LDB(B1, 1, 1); PG8_STAGE(PG8_SB(1, 0), b3, voffB);
            PG8_BAR; PG8_WAIT_L(0); PG8_MMA(0, 1, At, B1); PG8_BAR;
            PG8_LDA(At, 1, 1); PG8_STAGE(PG8_SA(1, 0), a3, voffA);
            PG8_BAR; PG8_WAIT_L(0); PG8_MMA(1, 0, At, B0); PG8_BAR; PG8_SCHED;
            PG8_STAGE(PG8_SB(1, 1), b3 + hstep, voffB);
            PG8_WAIT_V(6); PG8_BAR; PG8_MMA(1, 1, At, B1); PG8_BAR;
            }
        }
        if constexpr (ALIGN_EPI) { if (wr == 0) PG8_BAR; }
        if constexpr (!Epi::AFTER_DRAIN) { E(acc, cur, wr, wc, fr, fq); S.done(cur); }
        if (!has_next) break;
#pragma unroll
        for (int a = 0; a < 2; ++a)
#pragma unroll
            for (int b = 0; b < 2; ++b)
#pragma unroll
                for (int m = 0; m < 4; ++m)
#pragma unroll
                    for (int n = 0; n < 2; ++n) acc[a][b][m][n] = (f32x4){0.f, 0.f, 0.f, 0.f};
        cur = nxt; cA = nA; cB = nB; ++ui;
        if constexpr (ALIGN_EPI) { if (wr == 1) PG8_BAR; }
    }
    PG8_WAIT_V(0);
    if constexpr (!ALIGN_EPI) { if (wr == 0) PG8_BAR; }
    PG8_BAR;
    if constexpr (Epi::AFTER_DRAIN) { E.fused(acc, cur, wr, wc, fr, fq, lds, wid, lane); S.done(cur); }
#undef PG8_SA
#undef PG8_SB
#undef PG8_STAGE
#undef PG8_LDA
#undef PG8_LDB
#undef PG8_MMA
#undef PG8_WAIT_V
#undef PG8_WAIT_L
#undef PG8_BAR
#undef PG8_SCHED
}
}
constexpr int BATCH = 2, T = 4096, D = 2048, FF = 5632, DEPTH = 2;
constexpr int M = BATCH * T;
constexpr int DIN = 5912, GW = 512, HD = 128, NH = 4;
constexpr int ZBC = 2560, ZFC = 3584, ZC = ZBC + ZFC;
constexpr int ZB_FQ = 0, ZB_FK = 512, ZB_FV = 1024, ZB_NQ = 1536, ZB_NKS = 2048, ZB_NVS = 2176, ZB_NKW = 2304, ZB_NVW = 2432;
constexpr int ZF_GQ = 0, ZF_GK = 512, ZF_GV = 1024, ZF_GZ = 1536, ZF_LX = 2048, ZF_LG = 2560, ZF_NKC = 3072, ZF_NVC = 3200, ZF_FF = 3328, ZF_GA = 3332, ZF_GB = 3336, ZF_NG = 3340;
constexpr float EPS = 1e-6f;
constexpr int NCMP = 255, NCMPP = 256, NSLC = 64, NSEL = 16, WINDOW = 512, NBT = 791;
constexpr float LOG2E = 1.4426950408889634f;

__host__ __device__ __forceinline__ int zsrc(int zc) {
    if (zc < 1536) return zc;
    if (zc < 2048) return 4620 + (zc - 1536);
    if (zc < 2176) return 5388 + (zc - 2048);
    if (zc < 2304) return 5516 + (zc - 2176);
    if (zc < 2432) return 5644 + (zc - 2304);
    if (zc < 2560) return 5772 + (zc - 2432);
    const int c = zc - 2560;
    if (c < 512) return 1540 + c;
    if (c < 1024) return 2052 + (c - 512);
    if (c < 1536) return 2564 + (c - 1024);
    if (c < 2048) return 3084 + (c - 1536);
    if (c < 2560) return 3596 + (c - 2048);
    if (c < 3072) return 4108 + (c - 2560);
    if (c < 3200) return 5132 + (c - 3072);
    if (c < 3328) return 5260 + (c - 3200);
    if (c < 3332) return 1536 + (c - 3328);
    if (c < 3340) return 3076 + (c - 3332);
    if (c < 3352) return 5900 + (c - 3340);
    return -1;
}

constexpr size_t MiB = 1u << 20;
constexpr size_t WS_CTL = 0, CTL_ZERO_BYTES = 1 * MiB;
constexpr size_t WS_MISC = 1 * MiB;
constexpr size_t WS_W = 2 * MiB, W_LAYER = 164 * MiB;
constexpr size_t WO_GU1 = 0, WO_DN1 = 44 * MiB, WO_WIN = 66 * MiB, WO_WOUT = 90 * MiB, WO_GU2 = 98 * MiB, WO_DN2 = 142 * MiB;
constexpr size_t WS_XN = 330 * MiB;
constexpr size_t WS_ZB = 362 * MiB, WS_ZF = 402 * MiB;
constexpr size_t WS_ACT = 362 * MiB;
constexpr size_t WS_VFT = 514 * MiB, WS_VST = 522 * MiB, WS_VWT = 524 * MiB;
constexpr size_t WS_GPRE = 526 * MiB, GPRE_UNIT = 90112;
constexpr size_t GP_W = 0, GP_QT = 16384, GP_KDT = 32768, GP_QK = 49152, GP_U = 57344;
constexpr size_t WS_OFOX = 570 * MiB, WS_OGDN = 586 * MiB, WS_LA = 602 * MiB, WS_LU = 618 * MiB, WS_ONSA = 634 * MiB;
constexpr size_t WS_SMALL = 650 * MiB;
constexpr size_t SM_CFOX = 0;
constexpr size_t SM_GG = 128 * 1024;
constexpr size_t SM_GBETA = 256 * 1024;
constexpr size_t SM_NG = 384 * 1024;
constexpr size_t SM_KC = 768 * 1024;
constexpr size_t SM_VCT = 896 * 1024;
constexpr size_t SM_EGL = 1024 * 1024;
constexpr size_t WS_LH = 652 * MiB;
constexpr size_t WS_GSN = WS_OGDN, GSN_STEP = 4 * 8192;
constexpr size_t WS_GVN = 668 * MiB, GVN_STEP = 4 * 4096;
constexpr size_t WS_W1T = 692 * MiB;
constexpr size_t WS_END = 676 * MiB;
constexpr size_t PW_FOX = 0, PW_SEL = 32 * MiB, PW_SLOT = 8 * MiB;
constexpr size_t PW_FOXML = 64 * MiB, PW_SELML = 65 * MiB, PW_MLSLOT = 256 * 1024;
constexpr int CW_BAR = 4096, CW_Q = 16384;

constexpr int LDS_BYTES = 160 * 1024;
constexpr int LDS_CTL_OFF = LDS_BYTES - 256;
constexpr int NWAVES = 8, NTHREADS = 512;

#define GAS __attribute__((address_space(1)))
#define LAS __attribute__((address_space(3)))
typedef unsigned short bf16;
typedef unsigned v4u __attribute__((ext_vector_type(4)));
typedef unsigned v2u __attribute__((ext_vector_type(2)));
typedef float f32x4 __attribute__((ext_vector_type(4)));
typedef float f32x16 __attribute__((ext_vector_type(16)));
typedef short bf16x8 __attribute__((ext_vector_type(8)));
#define LDS_WAIT() asm volatile("s_waitcnt lgkmcnt(0)" ::: "memory")
#define VM_WAIT() asm volatile("s_waitcnt vmcnt(0)" ::: "memory")
__device__ __forceinline__ unsigned f2bf(float f) { unsigned u = __builtin_bit_cast(unsigned, f); return (u + 0x7fffu + ((u >> 16) & 1u)) >> 16; }
__device__ __forceinline__ unsigned pk2(float lo, float hi) { return f2bf(lo) | (f2bf(hi) << 16); }
__device__ __forceinline__ float bf2f(unsigned short b) { return __builtin_bit_cast(float, (unsigned)b << 16); }
__device__ __forceinline__ float wave_sum(float v) {
#pragma unroll
    for (int o = 1; o < 64; o <<= 1) v += __shfl_xor(v, o);
    return v;
}
__device__ __forceinline__ float fast_exp(float x) { return __builtin_amdgcn_exp2f(x * LOG2E); }
__device__ __forceinline__ float sigmoid_f(float x) { return __builtin_amdgcn_rcpf(1.0f + fast_exp(-x)); }
__device__ __forceinline__ float silu_ff(float x) { return x * sigmoid_f(x); }
__device__ __forceinline__ float softplus_f(float x) { return x > 20.f ? x : log1pf(expf(x)); }
__device__ __forceinline__ float gelu_tanh_f(float x) { const float u = 0.7978845608028654f * (x + 0.044715f * x * x * x); return 0.5f * x * (1.0f + tanhf(u)); }

#define XB_TMO      128
#define XB_XCNT(j)  (256  + 64 * (j))
#define XB_XSUB(j)  (1280 + 64 * (j))
#define XB_XGEN(j)  (2304 + 64 * (j))
#define XB_TOP      3328
#define XB_TOPGEN   3392
#define XCD_BAR_WORDS 3456
#define XB_SPIN_CAP (1u << 18)

__device__ __forceinline__ unsigned xb_ld(unsigned* p)              { return __hip_atomic_load(p, __ATOMIC_RELAXED, __HIP_MEMORY_SCOPE_AGENT); }
__device__ __forceinline__ unsigned xb_add(unsigned* p, unsigned v) { return __hip_atomic_fetch_add(p, v, __ATOMIC_RELAXED, __HIP_MEMORY_SCOPE_AGENT); }
__device__ __forceinline__ unsigned xb_xcc_id() { return (unsigned)__builtin_amdgcn_s_getreg((3 << 11) | 20) & 0xFu; }
#define XB_SPIN(cond, bar) do { unsigned _sp = 0; while (cond) { __builtin_amdgcn_s_sleep(1); \
    if ((++_sp & 255u) == 0u) { if (xb_ld(&(bar)[XB_TMO])) break; if (_sp > XB_SPIN_CAP) { atomicAdd(&(bar)[XB_TMO], 1u); break; } } } } while (0)

struct XcdBarrier {
    unsigned* bar; unsigned x;
    volatile LAS unsigned* st;
};

__device__ __forceinline__ XcdBarrier xcd_barrier_post(unsigned* bar, volatile LAS unsigned* st) {
    XcdBarrier b; b.bar = bar; b.x = xb_xcc_id(); b.st = st;
    if (threadIdx.x == 0) (void)xb_add(&bar[XB_XCNT(b.x)], 1u);
    return b;
}
__device__ __forceinline__ void xcd_barrier_complete(unsigned* bar, unsigned x, unsigned& nloc, unsigned& nx) {
    const unsigned G = gridDim.x * gridDim.y * gridDim.z;
    unsigned sum, cnt, mine, sp = 0u;
    for (;;) {
        sum = 0u; cnt = 0u; mine = 0u;
#pragma unroll
        for (unsigned j = 0; j < 16; ++j) { const unsigned c = xb_ld(&bar[XB_XCNT(j)]); sum += c; cnt += (c > 0u) ? 1u : 0u; mine = (j == x) ? c : mine; }
        if (sum == G) break;
        __builtin_amdgcn_s_sleep(1);
        if ((++sp & 255u) == 0u) { if (xb_ld(&bar[XB_TMO])) break; if (sp > XB_SPIN_CAP) { atomicAdd(&bar[XB_TMO], 1u); break; } }
    }
    nloc = mine > 0u ? mine : 1u; nx = cnt > 0u ? cnt : 1u;
}

__device__ __forceinline__ void xcd_barrier(const XcdBarrier& b) {
    asm volatile("s_waitcnt vmcnt(0)" ::: "memory");
    __syncthreads();
    if (threadIdx.x == 0) {
        unsigned* bar = b.bar;
        __builtin_amdgcn_s_waitcnt(0);
        unsigned nloc = b.st[0], nx = b.st[1];
        if (nloc == 0u) { xcd_barrier_complete(bar, b.x, nloc, nx); b.st[0] = nloc; b.st[1] = nx; }
        const unsigned old = xb_add(&bar[XB_XSUB(b.x)], 1u);
        const unsigned gen = old / nloc;
        if (old + 1u == (gen + 1u) * nloc) {
            __builtin_amdgcn_fence(__ATOMIC_RELEASE, "agent");
            asm volatile("s_waitcnt vmcnt(0)" ::: "memory");
            const unsigned og = xb_add(&bar[XB_TOP], 1u);
            const unsigned tg = og / nx;
            if (og + 1u == (tg + 1u) * nx) xb_add(&bar[XB_TOPGEN], 1u);
            else XB_SPIN(xb_ld(&bar[XB_TOPGEN]) == tg, bar);
            __builtin_amdgcn_fence(__ATOMIC_ACQUIRE, "agent");
            xb_add(&bar[XB_XGEN(b.x)], 1u);
            asm volatile("s_waitcnt vmcnt(0)" ::: "memory");
        } else {
            XB_SPIN(xb_ld(&bar[XB_XGEN(b.x)]) == gen, bar);
            __builtin_amdgcn_fence(__ATOMIC_ACQUIRE, "agent");
            asm volatile("s_waitcnt vmcnt(0)" ::: "memory");
        }
    }
    __syncthreads();
}
struct Ctx {
    LAS unsigned char* lds;
    unsigned char* ws;
    int tid, lane, wave, G, bid;
};
enum { I_X = 0, I_F1G, I_F1WG, I_F1WU, I_F1WD, I_MIXG, I_WIN, I_BIN, I_GCONV, I_GALOG, I_GDT, I_GNORM, I_LCONVW, I_LCONVB, I_LWA, I_LBA, I_LWX, I_LBX, I_LLAM,
       I_PEK, I_W1K, I_W2K, I_PEV, I_W1V, I_W2V, I_RELB, I_ONG, I_WOUT, I_F2G, I_F2WG, I_F2WU, I_F2WD, I_FING, N_IN };
__device__ __forceinline__ float* hptr() {
    float* p; asm volatile("s_load_dwordx2 %0, %1, %2\n\ts_waitcnt lgkmcnt(0)" : "=s"(p) : "s"(__builtin_amdgcn_kernarg_segment_ptr()), "n"(N_IN * 8));
    return p;
}
template <int I> __device__ __forceinline__ const float* inp() {
    const float* p; asm volatile("s_load_dwordx2 %0, %1, %2\n\ts_waitcnt lgkmcnt(0)" : "=s"(p) : "s"(__builtin_amdgcn_kernarg_segment_ptr()), "n"(I * 8));
    return p;
}

__device__ __forceinline__ void refresh_ids(Ctx& C) {
    int l; asm volatile("v_mbcnt_lo_u32_b32 %0, -1, 0\n\tv_mbcnt_hi_u32_b32 %0, -1, %0" : "=v"(l));
    C.lane = l; C.tid = C.wave * 64 + l;
}
__device__ __forceinline__ int queue_pull(Ctx& C, int qi) {
    refresh_ids(C);
    volatile LAS int* slot = (volatile LAS int*)(C.lds + LDS_CTL_OFF + 16);
    __syncthreads();
    if (C.tid == 0) *slot = (int)__hip_atomic_fetch_add((unsigned*)C.ws + CW_Q + 64 * qi, 1u, __ATOMIC_RELAXED, __HIP_MEMORY_SCOPE_AGENT);
    __syncthreads();
    return *slot;
}

__device__ __forceinline__ void transpose_item(const float* colp, int ldn, bf16* WT, int K, int n0, int k0, LAS float* scr, int lane) {
#pragma unroll 8
    for (int i = 0; i < 32; ++i) { const int kk = 2 * i + (lane >> 5); scr[kk * 33 + (lane & 31)] = colp ? colp[(size_t)(k0 + kk) * ldn] : 0.f; }
    LDS_WAIT(); asm volatile("" ::: "memory");
    const int c = lane & 7;
#pragma unroll
    for (int j = 0; j < 4; ++j) { const int n = (lane >> 3) + 8 * j; const LAS float* s = scr + (8 * c) * 33 + n;
        v4u o; o.x = pk2(s[0 * 33], s[1 * 33]); o.y = pk2(s[2 * 33], s[3 * 33]); o.z = pk2(s[4 * 33], s[5 * 33]); o.w = pk2(s[6 * 33], s[7 * 33]);
        *(GAS v4u*)(WT + (size_t)(n0 + n) * K + k0 + 8 * c) = o; }
    LDS_WAIT(); asm volatile("" ::: "memory");
}
__device__ __forceinline__ void rms_row_bf16(const float* xrow, const float* g, bf16* orow, float* hcopy, int lane) {
    const GAS f32x4* xr = (const GAS f32x4*)xrow + lane;
    f32x4 v[8]; float s = 0.f;
#pragma unroll
    for (int j = 0; j < 8; ++j) { v[j] = xr[64 * j]; s += (v[j].x * v[j].x + v[j].y * v[j].y) + (v[j].z * v[j].z + v[j].w * v[j].w); }
    const float rstd = 1.0f / sqrtf(wave_sum(s) * (1.f / D) + EPS);
    if (hcopy) { GAS f32x4* hc = (GAS f32x4*)hcopy + lane;
#pragma unroll
        for (int j = 0; j < 8; ++j) hc[64 * j] = v[j]; }
    GAS v2u* o8 = (GAS v2u*)orow + lane;
#pragma unroll
    for (int j = 0; j < 8; ++j) { const f32x4 gg = ((const GAS f32x4*)g)[lane + 64 * j]; v2u w; w.x = pk2(v[j].x * rstd * gg.x, v[j].y * rstd * gg.y); w.y = pk2(v[j].z * rstd * gg.z, v[j].w * rstd * gg.w); o8[64 * j] = w; }
}
__device__ __forceinline__ void rms_row_f32(const float* xrow, const float* g, float* orow, int lane) {
    const GAS f32x4* xr = (const GAS f32x4*)xrow + lane;
    f32x4 v[8]; float s = 0.f;
#pragma unroll
    for (int j = 0; j < 8; ++j) { v[j] = xr[64 * j]; s += (v[j].x * v[j].x + v[j].y * v[j].y) + (v[j].z * v[j].z + v[j].w * v[j].w); }
    const float rstd = 1.0f / sqrtf(wave_sum(s) * (1.f / D) + EPS);
    GAS f32x4* o = (GAS f32x4*)orow + lane;
#pragma unroll
    for (int j = 0; j < 8; ++j) { const f32x4 gg = ((const GAS f32x4*)g)[lane + 64 * j]; o[64 * j] = v[j] * rstd * gg; }
}
__device__ __forceinline__ void norm_phase_bf16(Ctx& C, const float* g) {
    refresh_ids(C);
    bf16* XN = (bf16*)(C.ws + WS_XN);
    float* const hp = hptr();
    for (int m = C.bid * NWAVES + C.wave; m < M; m += C.G * NWAVES) rms_row_bf16(hp + (size_t)m * D, g, XN + (size_t)m * D, nullptr, C.lane);
}

__device__ __forceinline__ int t5_bucket(int n) {
    if (n < 16) return n;
    int b = 16;
    b += (n >= 21); b += (n >= 27); b += (n >= 35); b += (n >= 46); b += (n >= 59); b += (n >= 77); b += (n >= 99); b += (n >= 128);
    b += (n >= 166); b += (n >= 216); b += (n >= 280); b += (n >= 363); b += (n >= 470); b += (n >= 609); b += (n >= 790);
    return b;
}

__device__ __forceinline__ void prologue_phase(Ctx& C) {
    refresh_ids(C);
    LAS float* scr = (LAS float*)(C.lds + C.wave * 16384);
    const int gw = C.bid * NWAVES + C.wave, NGW = C.G * NWAVES;
    constexpr int I_GU = 32 * 352, I_DN = 88 * 64, I_WI = 32 * 192, I_WO = 32 * 64;
    constexpr int PER_LAYER = 2 * I_GU + 2 * I_DN + I_WI + I_WO;
    for (int it = gw; it < DEPTH * PER_LAYER; it += NGW) {
        const int l = it / PER_LAYER; int r = it % PER_LAYER;
        unsigned char* wl = C.ws + WS_W + (size_t)l * W_LAYER;
        int ffn = -1;
        if (r < I_GU) ffn = 0; else { r -= I_GU;
        if (r < I_DN) ffn = 2; else { r -= I_DN;
        if (r < I_WI) ffn = 4; else { r -= I_WI;
        if (r < I_WO) ffn = 5; else { r -= I_WO;
        if (r < I_GU) ffn = 1; else { r -= I_GU; ffn = 3; } } } } }
        if (ffn <= 1) {
            const int nb = r % 352, kb = r / 352, n0 = nb * 32, j = n0 / 256, rr = n0 % 256;
            const float* wg = (ffn == 0 ? inp<I_F1WG>() : inp<I_F2WG>()) + (size_t)l * D * FF; const float* wu = (ffn == 0 ? inp<I_F1WU>() : inp<I_F2WU>()) + (size_t)l * D * FF;
            const float* colp = (rr < 128 ? wg + 128 * j + rr : wu + 128 * j + rr - 128) + (C.lane & 31);
            transpose_item(colp, FF, (bf16*)(wl + (ffn == 0 ? WO_GU1 : WO_GU2)), D, n0, kb * 64, scr, C.lane);
        } else if (ffn <= 3) {
            const int nb = r % 64, kb = r / 64;
            const float* w = (ffn == 2 ? inp<I_F1WD>() : inp<I_F2WD>()) + (size_t)l * FF * D;
            transpose_item(w + nb * 32 + (C.lane & 31), D, (bf16*)(wl + (ffn == 2 ? WO_DN1 : WO_DN2)), FF, nb * 32, kb * 64, scr, C.lane);
        } else if (ffn == 4) {
            const int nb = r % 192, kb = r / 192;
            const int sc = zsrc(nb * 32 + (C.lane & 31));
            const float* w = inp<I_WIN>() + (size_t)l * D * DIN;
            transpose_item(sc >= 0 ? w + sc : nullptr, DIN, (bf16*)(wl + WO_WIN), D, nb * 32, kb * 64, scr, C.lane);
        } else {
            const int nb = r % 64, kb = r / 64;
            const float* w = inp<I_WOUT>() + (size_t)l * D * D;
            transpose_item(w + nb * 32 + (C.lane & 31), D, (bf16*)(wl + WO_WOUT), D, nb * 32, kb * 64, scr, C.lane);
        }
    }
    for (int it = gw; it < DEPTH * 2 * 256; it += NGW) {
        const int lk = it >> 8, r = it & 255, nb = r & 3, kb = r >> 2, l = lk >> 1;
        const float* w = ((lk & 1) ? inp<I_W1V>() : inp<I_W1K>()) + (size_t)l * 4096 * 128;
        transpose_item(w + nb * 32 + (C.lane & 31), 128, (bf16*)(C.ws + WS_W1T) + (size_t)lk * 128 * 4096, 4096, nb * 32, kb * 64, scr, C.lane);
    }
    float* bz = (float*)(C.ws + WS_MISC);
    for (int i = C.bid * NTHREADS + C.tid; i < DEPTH * ZC; i += C.G * NTHREADS) { const int l = i / ZC, zc = i % ZC, sc = zsrc(zc); bz[i] = sc >= 0 ? inp<I_BIN>()[l * DIN + sc] : 0.f; }
    float* tb = (float*)(C.ws + WS_MISC + 65536);
    for (int i = C.bid * NTHREADS + C.tid; i < NH * NBT; i += C.G * NTHREADS) { const int hh = i / NBT, d = i % NBT; tb[i] = inp<I_RELB>()[t5_bucket(d) * NH + hh] * LOG2E; }
    bf16* XN = (bf16*)(C.ws + WS_XN);
    float* const hp = hptr();
    for (int m = gw; m < M; m += NGW) rms_row_bf16(inp<I_X>() + (size_t)m * D, inp<I_F1G>(), XN + (size_t)m * D, hp + (size_t)m * D, C.lane);
}
typedef float f32x4v __attribute__((ext_vector_type(4)));
__device__ __forceinline__ f32x4 mfma16(bf16x8 a, bf16x8 b, f32x4 c) { return __builtin_amdgcn_mfma_f32_16x16x32_bf16(a, b, c, 0, 0, 0); }

__device__ __forceinline__ void gdn_pre_job(Ctx& C, const int l, const int job) {
    const int ch = job & 63, h = (job >> 6) & 3, b = job >> 8, t0 = ch * 64;
    const size_t row0 = (size_t)b * T + t0;
    const float* zf = (const float*)(C.ws + WS_ZF);
    unsigned char* gp = C.ws + WS_GPRE + (size_t)job * GPRE_UNIT;
    LAS float* XQ = (LAS float*)C.lds;
    LAS float* XK = XQ + 64 * 132;
    LAS float* XV = XK + 64 * 132;
    LAS bf16* KN = (LAS bf16*)(XV + 64 * 132);
    LAS bf16* KBt = KN + 64 * 136;
    LAS bf16* QN = KBt + 64 * 136;
    LAS float* SMg = (LAS float*)(QN + 64 * 136);
    LAS float* AM = XQ;
    const int tid = C.tid, lane = C.lane, wave = C.wave;
    const float* cw = inp<I_GCONV>() + (size_t)l * 4 * 1536;
    if (tid < 480) {
        const int c4 = tid % 96, chk = tid / 96, r0 = 13 * chk, col = c4 * 4, which = col >> 7, d = col & 127, cc = which * 512 + h * 128 + d;
        f32x4 wv[4], zr[16];
#pragma unroll
        for (int j = 0; j < 4; ++j) wv[j] = *(const GAS f32x4*)(cw + j * 1536 + cc);
#pragma unroll
        for (int i = 0; i < 16; ++i) { const int tq = t0 + r0 - 3 + i;
            zr[i] = (tq >= 0 && r0 - 3 + i < 64) ? *(const GAS f32x4*)(zf + ((size_t)b * T + tq) * ZFC + cc) : (f32x4){0.f, 0.f, 0.f, 0.f}; }
        LAS float* dstb = (which == 0 ? XQ : which == 1 ? XK : XV) + d;
#pragma unroll
        for (int i = 0; i < 13; ++i) { const int tt = r0 + i;
            if (tt < 64) { const f32x4 acc = zr[i] * wv[0] + zr[i + 1] * wv[1] + zr[i + 2] * wv[2] + zr[i + 3] * wv[3];
                f32x4 o; o.x = silu_ff(acc.x); o.y = silu_ff(acc.y); o.z = silu_ff(acc.z); o.w = silu_ff(acc.w);
                *(LAS f32x4*)(dstb + tt * 132) = o; } }
    }
    if (wave == 0) {
        const float ga = zf[(row0 + lane) * ZFC + ZF_GA + h], gb = zf[(row0 + lane) * ZFC + ZF_GB + h];
        const float g = -expf(inp<I_GALOG>()[l * 4 + h]) * softplus_f(ga + inp<I_GDT>()[l * 4 + h]);
        float gc = g;
#pragma unroll
        for (int o = 1; o < 64; o <<= 1) { const float v = __shfl_up(gc, o); if (lane >= o) gc += v; }
        const float gl = __shfl(gc, 63);
        SMg[lane] = gc; SMg[64 + lane] = sigmoid_f(gb); SMg[128 + lane] = expf(gc); SMg[192 + lane] = expf(gl - gc);
        if (lane == 0) ((float*)(C.ws + WS_SMALL + SM_EGL))[job] = expf(gl);
    }
    __syncthreads();
    for (int r = wave * 8; r < wave * 8 + 8; ++r) {
        const float q0 = XQ[r * 132 + lane], q1 = XQ[r * 132 + 64 + lane], k0 = XK[r * 132 + lane], k1 = XK[r * 132 + 64 + lane];
        const float sq = wave_sum(q0 * q0 + q1 * q1), sk = wave_sum(k0 * k0 + k1 * k1);
        if (lane == 0) { SMg[256 + r] = 1.0f / sqrtf(sq + EPS); SMg[320 + r] = 1.0f / sqrtf(sk + EPS); }
    }
    __syncthreads();
    const float qscale = 0.08838834764831845f;
    for (int idx = tid; idx < 1024; idx += NTHREADS) {
        const int tt = idx >> 4, d0 = (idx & 15) * 8;
        const float rq = SMg[256 + tt] * qscale, rk = SMg[320 + tt], be = SMg[64 + tt], eg = SMg[128 + tt];
        const f32x4 qa = *(LAS f32x4*)(XQ + tt * 132 + d0), qb = *(LAS f32x4*)(XQ + tt * 132 + d0 + 4), ka = *(LAS f32x4*)(XK + tt * 132 + d0), kb = *(LAS f32x4*)(XK + tt * 132 + d0 + 4);
        v4u w;
        w.x = pk2(ka.x * rk, ka.y * rk); w.y = pk2(ka.z * rk, ka.w * rk); w.z = pk2(kb.x * rk, kb.y * rk); w.w = pk2(kb.z * rk, kb.w * rk);
        *(LAS v4u*)(KN + tt * 136 + d0) = w;
        const float rkb = rk * be;
        w.x = pk2(ka.x * rkb, ka.y * rkb); w.y = pk2(ka.z * rkb, ka.w * rkb); w.z = pk2(kb.x * rkb, kb.y * rkb); w.w = pk2(kb.z * rkb, kb.w * rkb);
        *(LAS v4u*)(KBt + tt * 136 + d0) = w;
        w.x = pk2(qa.x * rq, qa.y * rq); w.y = pk2(qa.z * rq, qa.w * rq); w.z = pk2(qb.x * rq, qb.y * rq); w.w = pk2(qb.z * rq, qb.w * rq);
        *(LAS v4u*)(QN + tt * 136 + d0) = w;
        const float rqe = rq * eg;
        w.x = pk2(qa.x * rqe, qa.y * rqe); w.y = pk2(qa.z * rqe, qa.w * rqe); w.z = pk2(qb.x * rqe, qb.y * rqe); w.w = pk2(qb.z * rqe, qb.w * rqe);
        *(GAS v4u*)(gp + GP_QT + (size_t)(tt * 128 + d0) * 2) = w;
    }
    for (int idx = tid; idx < 1024; idx += NTHREADS) {
        const int d = idx & 127, tg = (idx >> 7) * 8;
        float v[8];
#pragma unroll
        for (int i = 0; i < 8; ++i) v[i] = XK[(tg + i) * 132 + d] * SMg[320 + tg + i] * SMg[192 + tg + i];
        v4u w; w.x = pk2(v[0], v[1]); w.y = pk2(v[2], v[3]); w.z = pk2(v[4], v[5]); w.w = pk2(v[6], v[7]);
        *(GAS v4u*)(gp + GP_KDT + (size_t)(d * 64 + tg) * 2) = w;
    }
    __syncthreads();
    for (int jj = wave; jj < 26; jj += NWAVES) {
        bf16* qkout = (bf16*)(gp + GP_QK);
        const int fr = lane & 15, fq = lane >> 4;
        if (jj >= 20) {
            const int z = jj - 20, ti = z < 3 ? 0 : (z < 5 ? 1 : 2), tj = z < 3 ? z + 1 : (z < 5 ? z - 1 : 3);
#pragma unroll
            for (int r = 0; r < 4; ++r) qkout[(16 * ti + 4 * fq + r) * 64 + 16 * tj + fr] = 0;
            continue;
        }
        const int which = jj / 10, tix = jj % 10;
        const int ti = tix < 1 ? 0 : (tix < 3 ? 1 : (tix < 6 ? 2 : 3)), tj = tix - (ti * (ti + 1)) / 2;
        const LAS bf16* Ap = (which == 0 ? KBt : QN) + (16 * ti + fr) * 136 + 8 * fq;
        const LAS bf16* Bp = KN + (16 * tj + fr) * 136 + 8 * fq;
        f32x4 acc = {0.f, 0.f, 0.f, 0.f};
#pragma unroll
        for (int kk = 0; kk < 4; ++kk) acc = mfma16(*(const LAS bf16x8*)(Ap + 32 * kk), *(const LAS bf16x8*)(Bp + 32 * kk), acc);
        const int j = 16 * tj + fr; const float gcj = SMg[j];
#pragma unroll
        for (int r = 0; r < 4; ++r) { const int i = 16 * ti + 4 * fq + r; const float dec = expf(SMg[i] - gcj);
            if (which == 0) AM[i * 68 + j] = (i > j) ? acc[r] * dec : 0.f;
            else qkout[i * 64 + j] = (bf16)f2bf((i >= j) ? acc[r] * dec : 0.f); }
    }
    __syncthreads();
    if (wave < 4) {
        const int c = wave * 64 + lane, d = c & 127; const bool isW = c >= 128;
        int vzero; asm volatile("v_mov_b32 %0, 0" : "=v"(vzero));
        const LAS float* AMv = AM + vzero; const LAS float* SMv = SMg + vzero;
        float X[64];
#pragma unroll
        for (int i = 0; i < 64; ++i) X[i] = isW ? XK[i * 132 + d] * SMv[320 + i] * SMv[64 + i] * SMv[128 + i] : XV[i * 132 + d] * SMv[64 + i];
#pragma unroll
        for (int i = 1; i < 64; ++i) {
            float s = X[i];
#pragma unroll
            for (int j4 = 0; j4 < (i + 3) / 4; ++j4) { const f32x4 a = *(const LAS f32x4*)(AMv + i * 68 + 4 * j4);
                if (4 * j4 + 0 < i) s -= a.x * X[4 * j4 + 0];
                if (4 * j4 + 1 < i) s -= a.y * X[4 * j4 + 1];
                if (4 * j4 + 2 < i) s -= a.z * X[4 * j4 + 2];
                if (4 * j4 + 3 < i) s -= a.w * X[4 * j4 + 3]; }
            X[i] = s;
        }
        if (isW) { bf16* Wo = (bf16*)(gp + GP_W);
#pragma unroll
            for (int i = 0; i < 64; ++i) Wo[i * 128 + d] = (bf16)f2bf(X[i]); }
        else { float* Uo = (float*)(gp + GP_U);
#pragma unroll
            for (int i = 0; i < 64; ++i) Uo[i * 128 + d] = X[i]; }
    }
}

__device__ __forceinline__ void nsa_compress_job(Ctx& C, const int l, const int job) {
    const int rg = job & 15, b = (job >> 4) & 1, kv = job >> 5, n0 = rg * 16, lk = l * 2 + kv;
    const float* zf = (const float*)(C.ws + WS_ZF) + (kv ? ZF_NVC : ZF_NKC);
    const bf16* w1t = (const bf16*)(C.ws + WS_W1T) + (size_t)lk * 128 * 4096;
    const float* w2 = (kv ? inp<I_W2V>() : inp<I_W2K>()) + (size_t)l * 128 * 128;
    const float* pe = (kv ? inp<I_PEV>() : inp<I_PEK>()) + (size_t)l * 4096;
    LAS bf16* XS = (LAS bf16*)C.lds;
    LAS float* RED = (LAS float*)(C.lds + 75776);
    LAS float* HID = (LAS float*)(C.lds + 75776 + 65536);
    LAS bf16* PEs = (LAS bf16*)(C.lds + 75776 + 65536 + 8192);
    const int tid = C.tid, lane = C.lane, wave = C.wave, fr = lane & 15, fq = lane >> 4;
    {
        f32x4 v[17];
#pragma unroll
        for (int i = 0; i < 17; ++i) { const int idx = tid + NTHREADS * i, tk = idx >> 5, d4 = (idx & 31) * 4, t = 16 * n0 + tk;
            v[i] = (t < T) ? *(const GAS f32x4*)(zf + ((size_t)b * T + t) * ZFC + d4) : (f32x4){0.f, 0.f, 0.f, 0.f}; }
#pragma unroll
        for (int i = 0; i < 17; ++i) { const int idx = tid + NTHREADS * i, tk = idx >> 5, d4 = (idx & 31) * 4;
            v2u w; w.x = pk2(v[i].x, v[i].y); w.y = pk2(v[i].z, v[i].w); *(LAS v2u*)(XS + tk * 136 + d4) = w; }
#pragma unroll
        for (int i = 0; i < 2; ++i) { const int idx = tid + NTHREADS * i; const f32x4 q = *(const GAS f32x4*)(pe + idx * 4);
            v2u w; w.x = pk2(q.x, q.y); w.y = pk2(q.z, q.w); *(LAS v2u*)(PEs + idx * 4) = w; }
    }
    __syncthreads();
    f32x4 acc[8];
#pragma unroll
    for (int nt = 0; nt < 8; ++nt) acc[nt] = (f32x4){0.f, 0.f, 0.f, 0.f};
#pragma unroll 2
    for (int s = 0; s < 16; ++s) { const int ks = 16 * wave + s, i = ks >> 2, d0 = (ks & 3) * 32;
        const bf16x8 a = *(const LAS bf16x8*)(XS + (16 * fr + i) * 136 + d0 + 8 * fq);
        const bf16x8 ap = *(const LAS bf16x8*)(PEs + i * 128 + d0 + 8 * fq);
        bf16x8 bfr[8];
#pragma unroll
        for (int nt = 0; nt < 8; ++nt) bfr[nt] = *(const GAS bf16x8*)(w1t + (size_t)(16 * nt + fr) * 4096 + 32 * ks + 8 * fq);
#pragma unroll
        for (int nt = 0; nt < 8; ++nt) { acc[nt] = mfma16(a, bfr[nt], acc[nt]); acc[nt] = mfma16(ap, bfr[nt], acc[nt]); } }
#pragma unroll
    for (int nt = 0; nt < 8; ++nt)
#pragma unroll
        for (int r = 0; r < 4; ++r) RED[(wave * 16 + 4 * fq + r) * 128 + 16 * nt + fr] = acc[nt][r];
    __syncthreads();
    for (int idx = tid; idx < 16 * 128; idx += NTHREADS) { float s = 0.f;
#pragma unroll
        for (int w = 0; w < 8; ++w) s += RED[w * 2048 + idx];
        HID[idx] = gelu_tanh_f(s); }
    __syncthreads();
    {
        const int c = tid & 127, r0 = (tid >> 7) * 4; float o[4] = {0.f, 0.f, 0.f, 0.f};
#pragma unroll 4
        for (int cc = 0; cc < 128; ++cc) { const float w = w2[cc * 128 + c];
#pragma unroll
            for (int r = 0; r < 4; ++r) o[r] += HID[(r0 + r) * 128 + cc] * w; }
#pragma unroll
        for (int r = 0; r < 4; ++r) { const int n = n0 + r0 + r; const float v = n < NCMP ? o[r] : 0.f;
            if (kv == 0) ((bf16*)(C.ws + WS_SMALL + SM_KC) + (size_t)b * NCMPP * 128)[n * 128 + c] = (bf16)f2bf(v);
            else ((bf16*)(C.ws + WS_SMALL + SM_VCT) + (size_t)b * 128 * NCMPP)[c * NCMPP + n] = (bf16)f2bf(v); }
    }
}

__device__ __forceinline__ void lru_gate_job(Ctx& C, const int l, const int job) {
    const int wave = C.wave, lane = C.lane, cbase = wave * 64, ch = cbase + lane;
    const size_t rowb = (size_t)job * 32; const int tpos = (int)(rowb % T);
    const float* zf = (const float*)(C.ws + WS_ZF) + ZF_LX + ch;
    LAS float* XS = (LAS float*)C.lds + wave * 2048;
    const float* cw = inp<I_LCONVW>() + (size_t)l * 4 * 512 + ch; const float cb = inp<I_LCONVB>()[l * 512 + ch];
    const float w0 = cw[0], w1 = cw[512], w2 = cw[1024], w3 = cw[1536];
    float xc[32];
    float zm3 = tpos >= 3 ? zf[(rowb - 3) * ZFC] : 0.f, zm2 = tpos >= 2 ? zf[(rowb - 2) * ZFC] : 0.f, zm1 = tpos >= 1 ? zf[(rowb - 1) * ZFC] : 0.f;
#pragma unroll
    for (int tt = 0; tt < 32; ++tt) { const float z0 = zf[(rowb + tt) * ZFC]; xc[tt] = w0 * zm3 + w1 * zm2 + w2 * zm1 + w3 * z0 + cb; zm3 = zm2; zm2 = zm1; zm1 = z0; }
#pragma unroll
    for (int t4 = 0; t4 < 8; ++t4) *(LAS f32x4*)(XS + lane * 32 + 4 * t4) = (f32x4){xc[4 * t4], xc[4 * t4 + 1], xc[4 * t4 + 2], xc[4 * t4 + 3]};
    LDS_WAIT(); asm volatile("" ::: "memory");
    float aA[32], aX[32];
#pragma unroll
    for (int tt = 0; tt < 32; ++tt) { aA[tt] = 0.f; aX[tt] = 0.f; }
    const float* wa = inp<I_LWA>() + ((size_t)l * 8 + wave) * 4096 + lane; const float* wx = inp<I_LWX>() + ((size_t)l * 8 + wave) * 4096 + lane;
#pragma unroll 8
    for (int d = 0; d < 64; ++d) { const float va = wa[d * 64], vx = wx[d * 64];
#pragma unroll
        for (int t4 = 0; t4 < 8; ++t4) { const f32x4 x = *(const LAS f32x4*)(XS + d * 32 + 4 * t4);
            aA[4 * t4] += x.x * va; aA[4 * t4 + 1] += x.y * va; aA[4 * t4 + 2] += x.z * va; aA[4 * t4 + 3] += x.w * va;
            aX[4 * t4] += x.x * vx; aX[4 * t4 + 1] += x.y * vx; aX[4 * t4 + 2] += x.z * vx; aX[4 * t4 + 3] += x.w * vx; } }
    const float ba = inp<I_LBA>()[l * 512 + ch], bx = inp<I_LBX>()[l * 512 + ch], spl = softplus_f(-inp<I_LLAM>()[l * 512 + ch]);
    float* LA = (float*)(C.ws + WS_LA) + ch; float* LU = (float*)(C.ws + WS_LU) + ch;
#pragma unroll
    for (int tt = 0; tt < 32; ++tt) { const float r = sigmoid_f(aA[tt] + ba), ig = sigmoid_f(aX[tt] + bx), la = -8.0f * r * spl;
        LA[(rowb + tt) * 512] = expf(la); LU[(rowb + tt) * 512] = sqrtf(-expm1f(2.0f * la)) * (ig * xc[tt]); }
    LDS_WAIT();
}

__device__ __forceinline__ void vtrans_job(Ctx& C, const int job) {
    const size_t rowb = (size_t)job * 64; const int b = (int)(rowb / T), t0 = (int)(rowb % T);
    const bf16* zb = (const bf16*)(C.ws + WS_ZB);
    LAS bf16* TL = (LAS bf16*)C.lds;
    {   v4u tmp[12];
#pragma unroll
        for (int i = 0; i < 12; ++i) { const int idx = C.tid + NTHREADS * i, tt = idx / 96, c8 = (idx % 96) * 8;
            const int sc = c8 < 512 ? ZB_FV + c8 : (c8 < 640 ? ZB_NVS + (c8 - 512) : ZB_NVW + (c8 - 640));
            tmp[i] = *(const GAS v4u*)(zb + (rowb + tt) * ZBC + sc); }
#pragma unroll
        for (int i = 0; i < 12; ++i) { const int idx = C.tid + NTHREADS * i, tt = idx / 96, c8 = (idx % 96) * 8; *(LAS v4u*)(TL + tt * 776 + c8) = tmp[i]; }
    }
    __syncthreads();
    for (int idx = C.tid; idx < 768 * 8; idx += NTHREADS) { const int c = idx % 768, tg = (idx / 768) * 8;
        unsigned short v[8];
#pragma unroll
        for (int i = 0; i < 8; ++i) v[i] = TL[(tg + i) * 776 + c];
        v4u w; w.x = v[0] | ((unsigned)v[1] << 16); w.y = v[2] | ((unsigned)v[3] << 16); w.z = v[4] | ((unsigned)v[5] << 16); w.w = v[6] | ((unsigned)v[7] << 16);
        bf16* dst = c < 512 ? (bf16*)(C.ws + WS_VFT) + ((size_t)(b * 4 + (c >> 7)) * 128 + (c & 127)) * T
                  : (c < 640 ? (bf16*)(C.ws + WS_VST) + ((size_t)b * 128 + (c - 512)) * T : (bf16*)(C.ws + WS_VWT) + ((size_t)b * 128 + (c - 640)) * T);
        *(GAS v4u*)(dst + t0 + tg) = w; }
}

__device__ __forceinline__ void fox_cumsum_job(Ctx& C, const int job) {
    const int b = job >> 2, h = job & 3;
    const float* zf = (const float*)(C.ws + WS_ZF) + ZF_FF + h;
    float* cf = (float*)(C.ws + WS_SMALL + SM_CFOX) + (size_t)job * T;
    LAS double* WS8 = (LAS double*)C.lds;
    double v[8], run = 0.0;
#pragma unroll
    for (int i = 0; i < 8; ++i) { const float x = zf[((size_t)b * T + C.tid * 8 + i) * ZFC]; const float ls = fminf(x, 0.f) - log1pf(expf(-fabsf(x))); run += (double)ls; v[i] = run; }
    double sc = run;
#pragma unroll
    for (int o = 1; o < 64; o <<= 1) { const double u = __shfl_up(sc, o); if (C.lane >= o) sc += u; }
    if (C.lane == 63) WS8[C.wave] = sc;
    __syncthreads();
    double off = sc - run;
    for (int w = 0; w < C.wave; ++w) off += WS8[w];
#pragma unroll
    for (int i = 0; i < 8; ++i) cf[C.tid * 8 + i] = (float)((off + v[i]) * 1.4426950408889634);
}

#define QUEUE_LOOP(qi, njobs, call) for (;;) { const int j = queue_pull(C, (qi)); if (j >= (njobs)) break; call; }
__device__ __forceinline__ void pre_phase(Ctx& C, const int l, const int qoff) {
    const int q0 = 16 * l + qoff;
    QUEUE_LOOP(q0 + 0, 64, nsa_compress_job(C, l, j));
    QUEUE_LOOP(q0 + 1, 512, gdn_pre_job(C, l, j));
    QUEUE_LOOP(q0 + 2, 256, lru_gate_job(C, l, j));
    QUEUE_LOOP(q0 + 3, 128, vtrans_job(C, j));
    QUEUE_LOOP(q0 + 4, 8, fox_cumsum_job(C, j));
}
__device__ __forceinline__ f32x16 mfma32(bf16x8 a, bf16x8 b, f32x16 c) { return __builtin_amdgcn_mfma_f32_32x32x16_bf16(a, b, c, 0, 0, 0); }
__device__ __forceinline__ bf16x8 pack8(float a0, float a1, float a2, float a3, float a4, float a5, float a6, float a7) {
    v4u w; w.x = pg8::cvt_pk_bf16(a0, a1); w.y = pg8::cvt_pk_bf16(a2, a3); w.z = pg8::cvt_pk_bf16(a4, a5); w.w = pg8::cvt_pk_bf16(a6, a7);
    return __builtin_bit_cast(bf16x8, w);
}
constexpr int AT_KT = 0, AT_VT = 32768, AT_CT = 65536, AT_BT = 66048, AT_SEL = 78720, AT_Q = 79360;
constexpr int AT_IMP = 0;
constexpr float SC_LOG2 = 0.1275174326f;
enum { MODE_FOX = 0, MODE_CMP = 1, MODE_SEL = 2, MODE_WIN = 3 };

struct TileSrc { const bf16* K; int ldk; const bf16* VT; int ldv; };
struct LaneOff { unsigned gk[2], gv[2]; unsigned krow, kc[8], vrow, vc[2][2]; };
__device__ __forceinline__ void lane_offsets(const TileSrc& s, const int wave, const int lane, LaneOff& o) {
#pragma unroll
    for (int i = 0; i < 2; ++i) { const int p = 2 * wave + i;
        { const int row = 4 * p + (lane >> 4), c = (lane & 15) ^ (row & 15); o.gk[i] = (unsigned)((row * s.ldk + c * 8) * 2); }
        { const int d = 8 * p + (lane >> 3), c = (lane & 7) ^ ((d >> 1) & 7); o.gv[i] = (unsigned)((d * s.ldv + c * 8) * 2); } }
    const int r32 = lane & 31, hi = lane >> 5, prow = (r32 & 19) | ((r32 & 4) << 1) | ((r32 & 8) >> 1);
    o.krow = (unsigned)(prow * 256);
#pragma unroll
    for (int c = 0; c < 8; ++c) o.kc[c] = (unsigned)(((2 * c + hi) ^ (prow & 15)) * 16);
    o.vrow = (unsigned)(r32 * 128);
#pragma unroll
    for (int kb = 0; kb < 2; ++kb)
#pragma unroll
        for (int cc = 0; cc < 2; ++cc) o.vc[kb][cc] = (unsigned)(((4 * kb + 2 * cc + hi) ^ ((r32 >> 1) & 7)) * 16);
}
template <int MODE>
__device__ __forceinline__ void dma_tile(LAS unsigned char* lds, const TileSrc& s, const LaneOff& o, const int k0, const int buf, const int wave, const int lane, const float* cfrow) {
    const char* kb = (const char*)s.K + (size_t)k0 * s.ldk * 2; const char* vb = (const char*)s.VT + (size_t)k0 * 2;
#pragma unroll
    for (int i = 0; i < 2; ++i) {
        __builtin_amdgcn_global_load_lds((const GAS unsigned*)(kb + o.gk[i]), (LAS unsigned*)(lds + AT_KT + buf * 16384 + (2 * wave + i) * 1024), 16, 0, 0);
        __builtin_amdgcn_global_load_lds((const GAS unsigned*)(vb + o.gv[i]), (LAS unsigned*)(lds + AT_VT + buf * 16384 + (2 * wave + i) * 1024), 16, 0, 0); }
    if (MODE == MODE_FOX && wave == 0) __builtin_amdgcn_global_load_lds((const GAS unsigned*)(cfrow + k0 + lane), (LAS unsigned*)(lds + AT_CT + buf * 256), 4, 0, 0);
}
template <bool QL>
__device__ __forceinline__ f32x16 score_block(const LAS unsigned char* KT, const LaneOff& o, const bf16x8 (&qf)[8], const LAS bf16* ql, const int kb, const int lane) {
    const int r32 = lane & 31, hi = lane >> 5;
    const LAS unsigned char* p = KT + kb * 8192 + o.krow;
    const LAS bf16* q = ql + r32 * 136 + 8 * hi;
    __builtin_amdgcn_sched_barrier(0);
    bf16x8 kf[8], qq[8];
#pragma unroll
    for (int c = 0; c < 8; ++c) { kf[c] = *(const LAS bf16x8*)(p + o.kc[c]); if (QL) qq[c] = *(const LAS bf16x8*)(q + 16 * c); }
    __builtin_amdgcn_sched_barrier(0);
    f32x16 sa, sb;
#pragma unroll
    for (int i = 0; i < 16; ++i) { sa[i] = 0.f; sb[i] = 0.f; }
#pragma unroll
    for (int c = 0; c < 8; c += 2) { sa = mfma32(kf[c], QL ? qq[c] : qf[c], sa); sb = mfma32(kf[c + 1], QL ? qq[c + 1] : qf[c + 1], sb); }
    __builtin_amdgcn_sched_barrier(0);
    return sa + sb;
}
__device__ __forceinline__ void pv_block(const LAS unsigned char* VT, const LaneOff& o, const f32x16& p, const int kb, f32x16 (&O)[4]) {
    bf16x8 vf[2][4];
#pragma unroll
    for (int cc = 0; cc < 2; ++cc)
#pragma unroll
        for (int db = 0; db < 4; ++db) vf[cc][db] = *(const LAS bf16x8*)(VT + db * 4096 + o.vrow + o.vc[kb][cc]);
    const bf16x8 pf0 = pack8(p[0], p[1], p[2], p[3], p[4], p[5], p[6], p[7]), pf1 = pack8(p[8], p[9], p[10], p[11], p[12], p[13], p[14], p[15]);
    __builtin_amdgcn_sched_barrier(0);
#pragma unroll
    for (int db = 0; db < 4; ++db) O[db] = mfma32(vf[0][db], pf0, O[db]);
#pragma unroll
    for (int db = 0; db < 4; ++db) O[db] = mfma32(vf[1][db], pf1, O[db]);
    __builtin_amdgcn_sched_barrier(0);
}

#define SOFTMAX_RESCALE(mx) do { mx = fmaxf(mx, __shfl_xor(mx, 32)); \
        if (__builtin_amdgcn_ballot_w64(mx > m) != 0ull) { const float alpha_ = __builtin_amdgcn_exp2f(m - mx); l *= alpha_; \
            _Pragma("unroll") for (int db_ = 0; db_ < 4; ++db_) O[db_] *= alpha_; } \
        m = mx; } while (0)
template <int MODE>
__device__ __forceinline__ void compute_tile(LAS unsigned char* lds, const int buf, const LaneOff& lo, const int j, const bf16x8 (&qf)[8], const LAS bf16* ql, f32x16 (&O)[4], float& m, float& l,
                                             const int tq, const int q0w, const float ctq2  , const int head, const bool selbit, const int lane) {
    const LAS unsigned char* KT = lds + AT_KT + buf * 16384; const LAS unsigned char* VT = lds + AT_VT + buf * 16384;
    const LAS float* CT = (const LAS float*)(lds + AT_CT + buf * 256); const LAS float* BT = (const LAS float*)(lds + AT_BT) + head * 792;
    const int hi = lane >> 5, k0 = 64 * j;
    if constexpr (MODE == MODE_FOX) {
#pragma unroll
        for (int kb = 0; kb < 2; ++kb) {
            f32x16 s = score_block<false>(KT, lo, qf, ql, kb, lane);
            const LAS float* ct = CT + 32 * kb + 8 * hi;
            float mx = m, rs = 0.f;
            if (k0 + 32 * kb + 31 <= q0w) {
#pragma unroll
                for (int r = 0; r < 16; ++r) { const float v = __builtin_fmaf(s[r], SC_LOG2, ctq2 - ct[16 * (r >> 3) + (r & 7)]); s[r] = v; mx = fmaxf(mx, v); }
                SOFTMAX_RESCALE(mx);
#pragma unroll
                for (int r = 0; r < 16; ++r) { const float p = __builtin_amdgcn_exp2f(s[r] - mx); s[r] = p; rs += p; }
            } else {
                const int lim = tq - k0 - 32 * kb - 8 * hi;
#pragma unroll
                for (int r = 0; r < 16; ++r) {
                    float v = __builtin_fmaf(s[r], SC_LOG2, ctq2 - ct[16 * (r >> 3) + (r & 7)]);
                    v = (16 * (r >> 3) + (r & 7) <= lim) ? v : -1e30f; s[r] = v; mx = fmaxf(mx, v);
                }
                SOFTMAX_RESCALE(mx);
#pragma unroll
                for (int r = 0; r < 16; ++r) { const float p = s[r] > -1e29f ? __builtin_amdgcn_exp2f(s[r] - mx) : 0.f; s[r] = p; rs += p; }
            }
            l += rs;
            pv_block(VT, lo, s, kb, O);
        }
    } else {
        const bool far = (MODE == MODE_SEL) && (q0w - (k0 + 63) >= 790);
        const float bfar = BT[790];
#pragma unroll
        for (int kb = 0; kb < 2; ++kb) {
            f32x16 s = score_block<true>(KT, lo, qf, ql, kb, lane);
            float rs = 0.f;
            if (far) {
                float smax = s[0];
#pragma unroll
                for (int r = 1; r < 16; ++r) smax = fmaxf(smax, s[r]);
                float mx = fmaxf(m, selbit ? __builtin_fmaf(smax, SC_LOG2, bfar) : -1e30f);
                SOFTMAX_RESCALE(mx);
                const float c0 = selbit ? bfar - mx : -1e30f;
#pragma unroll
                for (int r = 0; r < 16; ++r) { const float p = __builtin_amdgcn_exp2f(__builtin_fmaf(s[r], SC_LOG2, c0)); s[r] = p; rs += p; }
            } else {
                float mx = m;
#pragma unroll
                for (int r = 0; r < 16; ++r) {
                    const int dist = tq - (k0 + 32 * kb + 16 * (r >> 3) + 8 * hi + (r & 7));
                    const bool valid = (MODE == MODE_SEL) ? (selbit && dist >= 0) : (dist >= 0 && dist < WINDOW);
                    const int di = dist < 0 ? 0 : (dist > 790 ? 790 : dist);
                    float v = __builtin_fmaf(s[r], SC_LOG2, BT[di]);
                    v = valid ? v : -1e30f; s[r] = v; mx = fmaxf(mx, v);
                }
                SOFTMAX_RESCALE(mx);
#pragma unroll
                for (int r = 0; r < 16; ++r) { const float p = s[r] > -1e29f ? __builtin_amdgcn_exp2f(s[r] - mx) : 0.f; s[r] = p; rs += p; }
            }
            l += rs;
            pv_block(VT, lo, s, kb, O);
        }
    }
}

template <int MODE, int VAR = 0>
__device__ __forceinline__ void run_branch(Ctx& C, const TileSrc& src, const LaneOff& lo, unsigned long long tmask, const bf16x8 (&qf)[8], const LAS bf16* ql, f32x16 (&O)[4], float& m, float& l,
                                           const int tq, const int q0w, const float* cfrow, const float ctq2, const int head, const unsigned long long selq) {
    if (tmask == 0ull) return;
    int j = __builtin_ctzll(tmask); tmask &= tmask - 1;
    __syncthreads();
    if (VAR != 2) dma_tile<MODE>(C.lds, src, lo, 64 * j, 0, C.wave, C.lane, cfrow);
    int buf = 0;
    for (;;) {
        const int jn = tmask ? __builtin_ctzll(tmask) : -1; tmask &= tmask - 1;
        asm volatile("s_waitcnt vmcnt(0)" ::: "memory");
        __syncthreads();
        if (jn >= 0 && VAR != 2) dma_tile<MODE>(C.lds, src, lo, 64 * jn, buf ^ 1, C.wave, C.lane, cfrow);
        bool active = true;
        if (MODE == MODE_FOX || MODE == MODE_SEL) active = (64 * j <= q0w + 31);
        if (MODE == MODE_WIN) active = (64 * j <= q0w + 31) && (64 * j + 63 >= q0w - (WINDOW - 1));
        if (active && VAR != 1) compute_tile<MODE>(C.lds, buf, lo, j, qf, ql, O, m, l, tq, q0w, ctq2, head, (bool)((selq >> j) & 1ull), C.lane);
        if (jn < 0) break;
        j = jn; buf ^= 1;
    }
}
__device__ __forceinline__ void store_out(float* outp  , const f32x16 (&O)[4], const float sc, const int hi, const bool accumulate) {
#pragma unroll
    for (int db = 0; db < 4; ++db)
#pragma unroll
        for (int r4 = 0; r4 < 4; ++r4) { float* p = outp + 32 * db + 8 * r4 + 4 * hi;
            f32x4 v = {O[db][4 * r4] * sc, O[db][4 * r4 + 1] * sc, O[db][4 * r4 + 2] * sc, O[db][4 * r4 + 3] * sc};
            if (accumulate) v += *(const GAS f32x4*)p;
            *(GAS f32x4*)p = v; }
}
__device__ __forceinline__ void store_partial(bf16* partp  , float* mlp  , const f32x16 (&O)[4], const float m, const float l, const int hi) {
#pragma unroll
    for (int db = 0; db < 4; ++db)
#pragma unroll
        for (int r4 = 0; r4 < 4; ++r4) { v2u w; w.x = pg8::cvt_pk_bf16(O[db][4 * r4], O[db][4 * r4 + 1]); w.y = pg8::cvt_pk_bf16(O[db][4 * r4 + 2], O[db][4 * r4 + 3]);
            *(GAS v2u*)(partp + 32 * db + 8 * r4 + 4 * hi) = w; }
    const float lt = l + __shfl_xor(l, 32);
    if (hi == 0) { typedef float f32x2 __attribute__((ext_vector_type(2))); *(GAS f32x2*)mlp = (f32x2){m, lt}; }
}
__device__ __forceinline__ void load_q(const bf16* qrow  , bf16x8 (&qf)[8], const int hi) {
#pragma unroll
    for (int c = 0; c < 8; ++c) qf[c] = *(const GAS bf16x8*)(qrow + 16 * c + 8 * hi);
}
#define ZERO_STATE(O, m, l) do { _Pragma("unroll") for (int _d = 0; _d < 4; ++_d) _Pragma("unroll") for (int _i = 0; _i < 16; ++_i) O[_d][_i] = 0.f; m = -1e30f; l = 0.f; } while (0)

__device__ __forceinline__ void fox_item(Ctx& C, const int l, const int b, const int h, const int qb, const int part) {
    const int lane = C.lane, hi = lane >> 5, q0w = 256 * qb + 32 * C.wave, tq = q0w + (lane & 31);
    const bf16* zb = (const bf16*)(C.ws + WS_ZB);
    const size_t row = (size_t)b * T + tq;
    bf16x8 qf[8]; load_q(zb + row * ZBC + ZB_FQ + h * 128, qf, hi);
    const float* cf = (const float*)(C.ws + WS_SMALL + SM_CFOX) + (size_t)(b * 4 + h) * T;
    const float ctq = cf[tq];
    TileSrc src{zb + (size_t)b * T * ZBC + ZB_FK + h * 128, ZBC, (const bf16*)(C.ws + WS_VFT) + (size_t)(b * 4 + h) * 128 * T, T};
    f32x16 O[4]; float m, lsum; ZERO_STATE(O, m, lsum);
    LaneOff lo; lane_offsets(src, C.wave, lane, lo);
    const int nt = 4 * qb + 4, t_lo = 16 * part, t_hi = (t_lo + 16 < nt) ? t_lo + 16 : nt, cnt = t_hi - t_lo;
    run_branch<MODE_FOX>(C, src, lo, ((cnt >= 64) ? ~0ull : ((1ull << cnt) - 1ull)) << t_lo, qf, (const LAS bf16*)C.lds, O, m, lsum, tq, q0w, cf, ctq, 0, 0ull);
    unsigned char* pw = C.ws + WS_W + (size_t)l * W_LAYER;
    store_partial((bf16*)(pw + PW_FOX + (size_t)part * PW_SLOT) + row * 512 + h * 128, (float*)(pw + PW_FOXML + (size_t)part * PW_MLSLOT) + (row * 4 + h) * 2, O, m, lsum, hi);
}

template <int KIND>
__device__ __forceinline__ void nsa_item(Ctx& C, const int l, const int b, const int ub, const int part) {
    constexpr int VAR = 0;
    const int lane = C.lane, r32 = lane & 31, hi = lane >> 5, wave = C.wave, h = wave & 3, qh = wave >> 2;
    const int t0 = 64 * ub, q0w = t0 + 32 * qh, tq = q0w + r32, cur = ub;
    const size_t row = (size_t)b * T + tq;
    const bf16* zb = (const bf16*)(C.ws + WS_ZB);
    const float* zf = (const float*)(C.ws + WS_ZF);
    LAS float* BT = (LAS float*)(C.lds + AT_BT); LAS float* IMP = (LAS float*)(C.lds + AT_IMP);
    LAS unsigned long long* SEL = (LAS unsigned long long*)(C.lds + AT_SEL);
    { const float* tb = (const float*)(C.ws + WS_MISC + 65536);
      for (int i = C.tid; i < NH * NBT; i += NTHREADS) BT[(i / NBT) * 792 + (i % NBT)] = tb[i]; }
    bf16x8 qf[8];
#pragma unroll
    for (int c = 0; c < 8; ++c) qf[c] = (bf16x8){0, 0, 0, 0, 0, 0, 0, 0};
    LAS bf16* QL = (LAS bf16*)(C.lds + AT_Q) + wave * (32 * 136);
#pragma unroll
    for (int i = 0; i < 8; ++i) { const int id = lane + 64 * i, rr = id >> 4, c16 = id & 15;
        *(LAS v4u*)(QL + rr * 136 + c16 * 8) = *(const GAS v4u*)(zb + ((size_t)b * T + q0w + rr) * ZBC + ZB_NQ + h * 128 + c16 * 8); }
    f32x16 O[4]; float m, lsum;
    unsigned char* pw = C.ws + WS_W + (size_t)l * W_LAYER;
    if (KIND == 0) {
        ZERO_STATE(O, m, lsum);
        float G[32];
#pragma unroll
        for (int i = 0; i < 32; ++i) G[i] = 0.f;
        float xprev = 0.f;
        const int nkeys = 4 * ub + 3, ntc = (nkeys + 63) >> 6;
        TileSrc src{(const bf16*)(C.ws + WS_SMALL + SM_KC) + (size_t)b * NCMPP * 128, 128, (const bf16*)(C.ws + WS_SMALL + SM_VCT) + (size_t)b * 128 * NCMPP, NCMPP};
        const LAS float* BTh = BT + h * 792;
        LaneOff lo; lane_offsets(src, wave, lane, lo);
        __syncthreads();
        dma_tile<MODE_CMP>(C.lds, src, lo, 0, 0, wave, lane, nullptr);
#pragma unroll
        for (int j = 0; j < 4; ++j) {
            if (j < ntc) {
                const LAS unsigned char* KT = C.lds + AT_KT + (j & 1) * 16384; const LAS unsigned char* VT = C.lds + AT_VT + (j & 1) * 16384;
                asm volatile("s_waitcnt vmcnt(0)" ::: "memory");
                __syncthreads();
                if (j + 1 < ntc) dma_tile<MODE_CMP>(C.lds, src, lo, 64 * (j + 1), (j + 1) & 1, wave, lane, nullptr);
                f32x16 s[2];
                s[0] = score_block<true>(KT, lo, qf, QL, 0, lane); s[1] = score_block<true>(KT, lo, qf, QL, 1, lane);
                float mx = m;
#pragma unroll
                for (int kb = 0; kb < 2; ++kb)
#pragma unroll
                    for (int r = 0; r < 16; ++r) {
                        const int n = 64 * j + 32 * kb + 16 * (r >> 3) + 8 * hi + (r & 7), dist = tq - 16 * n - 31;
                        const int di = dist < 0 ? 0 : (dist > 790 ? 790 : dist);
                        float v = s[kb][r] * SC_LOG2 + BTh[di];
                        v = dist >= 0 ? v : -1e30f; s[kb][r] = v; mx = fmaxf(mx, v);
                    }
                mx = fmaxf(mx, __shfl_xor(mx, 32));
                const float alpha = __builtin_amdgcn_exp2f(m - mx); m = mx;
                float rs = 0.f;
#pragma unroll
                for (int kb = 0; kb < 2; ++kb)
#pragma unroll
                    for (int r = 0; r < 16; ++r) { const float p = s[kb][r] > -1e29f ? __builtin_amdgcn_exp2f(s[kb][r] - mx) : 0.f; s[kb][r] = p; rs += p; }
                lsum = lsum * alpha + rs;
#pragma unroll
                for (int db = 0; db < 4; ++db) O[db] *= alpha;
#pragma unroll
                for (int gi = 0; gi < 8 * j; ++gi) G[gi] *= alpha;
                xprev *= alpha;
#pragma unroll
                for (int kb = 0; kb < 2; ++kb) {
                    const float x7 = __shfl_xor(s[kb][7], 32), x15 = __shfl_xor(s[kb][15], 32);
                    const float gs0 = (s[kb][0] + s[kb][1]) + (s[kb][2] + s[kb][3]), gs1 = (s[kb][4] + s[kb][5]) + (s[kb][6] + s[kb][7]);
                    const float gs2 = (s[kb][8] + s[kb][9]) + (s[kb][10] + s[kb][11]), gs3 = (s[kb][12] + s[kb][13]) + (s[kb][14] + s[kb][15]);
                    const int gb = 4 * (2 * j + kb);
                    G[gb + 0] = gs0 + (hi ? x7 : xprev);
                    G[gb + 1] = gs1 + s[kb][3];
                    G[gb + 2] = gs2 + (hi ? x15 : x7);
                    G[gb + 3] = gs3 + s[kb][11];
                    xprev = x15;
                }
                if (part == 0) { pv_block(VT, lo, s[0], 0, O); pv_block(VT, lo, s[1], 1, O); }
            }
        }
        const float lt = lsum + __shfl_xor(lsum, 32), inv = lt > 0.f ? 1.0f / lt : 0.f;
        if (part == 0) store_out((float*)(C.ws + WS_ONSA) + row * 512 + h * 128, O, inv * sigmoid_f(zf[row * ZFC + ZF_NG + h * 3 + 0]), hi, false);
        __syncthreads();
        LAS float* slab = IMP + (qh * 32 + r32) * 64 + 2 * hi;
#pragma unroll
        for (int hh = 0; hh < 4; ++hh) {
            if (h == hh) {
#pragma unroll
                for (int gi = 0; gi < 32; ++gi) { LAS float* p = slab + 8 * (gi >> 2) + 4 * ((gi & 3) >> 1) + (gi & 1); const float v = G[gi] * inv; *p = (hh == 0) ? v : (*p + v); }
            }
            __syncthreads();
        }
    }
    if (KIND == 0) for (int qq = 0; qq < 8; ++qq) {
        const int qi = 8 * wave + qq, qh2 = qi >> 5, rr = qi & 31;
        float v = IMP[(qh2 * 32 + rr) * 64 + lane];
        if (lane == 0 || lane == cur || lane == cur - 1) v = 1.0e6f;
        if (lane > cur) v = -1.0f;
        int rank = 0;
        for (int i = 0; i < 64; ++i) { const float vi = __builtin_bit_cast(float, __builtin_amdgcn_readlane(__builtin_bit_cast(int, v), i)); rank += (vi > v || (vi == v && i < lane)) ? 1 : 0; }
        const unsigned long long mask = __ballot(rank < NSEL);
        if (lane == 0) SEL[qi] = mask;
    }
    const unsigned long long upto = cur >= 63 ? ~0ull : ((2ull << cur) - 1ull);
    if (KIND == 0) {
        __syncthreads();
        unsigned long long uni = SEL[lane];
#pragma unroll
        for (int o = 1; o < 64; o <<= 1) uni |= __shfl_xor(uni, o);
        const unsigned long long selq = SEL[32 * qh + r32];
        ZERO_STATE(O, m, lsum);
        TileSrc src{zb + (size_t)b * T * ZBC + ZB_NKS, ZBC, (const bf16*)(C.ws + WS_VST) + (size_t)b * 128 * T, T};
        LaneOff lo; lane_offsets(src, wave, lane, lo);
        run_branch<MODE_SEL, VAR>(C, src, lo, uni & upto & (0xFFFFull << (16 * part)), qf, QL, O, m, lsum, tq, q0w, nullptr, 0.f, h, selq);
        store_partial((bf16*)(pw + PW_SEL + (size_t)part * PW_SLOT) + row * 512 + h * 128, (float*)(pw + PW_SELML + (size_t)part * PW_MLSLOT) + (row * 4 + h) * 2, O, m, lsum, hi);
    }
    if (KIND == 1) {
        ZERO_STATE(O, m, lsum);
        TileSrc src{zb + (size_t)b * T * ZBC + ZB_NKW, ZBC, (const bf16*)(C.ws + WS_VWT) + (size_t)b * 128 * T, T};
        const int jlo = cur >= 8 ? cur - 8 : 0;
        LaneOff lo; lane_offsets(src, wave, lane, lo);
        run_branch<MODE_WIN, VAR>(C, src, lo, upto & ~((1ull << jlo) - 1ull), qf, QL, O, m, lsum, tq, q0w, nullptr, 0.f, h, 0ull);
        const float lt = lsum + __shfl_xor(lsum, 32);
        store_out((float*)(C.ws + WS_OFOX) + row * 512 + h * 128, O, (lt > 0.f ? 1.0f / lt : 0.f) * sigmoid_f(zf[row * ZFC + ZF_NG + h * 3 + 2]), hi, false);
    }
}

struct GdnFrags { bf16x8 w[4], kd[2][2]; float u[4]; float egl; };
struct GdnOff { unsigned a, c, u; };
__device__ __forceinline__ void gdn_offsets(const int tr, const int tc, const int cb, const int lane, GdnOff& o) {
    const int fr = lane & 15, fq = lane >> 4;
    o.a = (unsigned)(((16 * tr + fr) * 128 + 8 * fq) * 2);
    o.c = (unsigned)(((32 * tr + fr) * 64 + 8 * fq) * 2);
    o.u = (unsigned)(((16 * tr + 4 * fq) * 128 + 32 * cb + 16 * tc + fr) * 4);
}
__device__ __forceinline__ void gdn_load(const __amdgpu_buffer_rsrc_t rs, const unsigned soff, const float* eglp, const GdnOff& o, GdnFrags& f) {
#pragma unroll
    for (int kk = 0; kk < 4; ++kk) f.w[kk] = __builtin_bit_cast(bf16x8, __builtin_amdgcn_raw_buffer_load_b128(rs, o.a + 64 * kk, soff + (unsigned)GP_W, 0));
#pragma unroll
    for (int kk = 0; kk < 2; ++kk)
#pragma unroll
        for (int t2 = 0; t2 < 2; ++t2) f.kd[t2][kk] = __builtin_bit_cast(bf16x8, __builtin_amdgcn_raw_buffer_load_b128(rs, o.c + 2048 * t2 + 64 * kk, soff + (unsigned)GP_KDT, 0));
#pragma unroll
    for (int r = 0; r < 4; ++r) f.u[r] = __builtin_bit_cast(float, __builtin_amdgcn_raw_buffer_load_b32(rs, o.u + 512 * r, soff + (unsigned)GP_U, 0));
    f.egl = *eglp;
}
#define LDS_BARRIER() do { asm volatile("s_waitcnt lgkmcnt(0)" ::: "memory"); __builtin_amdgcn_s_barrier(); asm volatile("" ::: "memory"); } while (0)
constexpr int GS_ST = 8704, GS_VN = 4608, GS_VN0 = 8 * GS_ST;
__device__ __forceinline__ void gdn_step(const GdnFrags& f, const int n, LAS unsigned char* lds, f32x4 (&S)[2], const int tr, const int tc, const int fr, const int fq) {
    const LAS bf16* STp = (const LAS bf16*)(lds + ((n + 7) & 7) * GS_ST);
    LAS bf16* STn = (LAS bf16*)(lds + (n & 7) * GS_ST);
    LAS bf16* VNT = (LAS bf16*)(lds + GS_VN0 + (n & 7) * GS_VN);
    f32x4 av = {0.f, 0.f, 0.f, 0.f};
#pragma unroll
    for (int kk = 0; kk < 4; ++kk) av = mfma16(f.w[kk], *(const LAS bf16x8*)(STp + (16 * tc + fr) * 136 + 32 * kk + 8 * fq), av);
    { v2u w; w.x = pk2(f.u[0] - av[0], f.u[1] - av[1]); w.y = pk2(f.u[2] - av[2], f.u[3] - av[3]); *(LAS v2u*)(VNT + (16 * tc + fr) * 72 + 16 * tr + 4 * fq) = w; }
    LDS_BARRIER();
    bf16x8 vf[2];
#pragma unroll
    for (int kk = 0; kk < 2; ++kk) vf[kk] = *(const LAS bf16x8*)(VNT + (16 * tc + fr) * 72 + 32 * kk + 8 * fq);
#pragma unroll
    for (int t2 = 0; t2 < 2; ++t2) { S[t2] *= f.egl;
#pragma unroll
        for (int kk = 0; kk < 2; ++kk) S[t2] = mfma16(f.kd[t2][kk], vf[kk], S[t2]);
        v2u w; w.x = pk2(S[t2][0], S[t2][1]); w.y = pk2(S[t2][2], S[t2][3]);
        *(LAS v2u*)(STn + (16 * tc + fr) * 136 + 16 * (2 * tr + t2) + 4 * fq) = w; }
    LDS_BARRIER();
}
__device__ __forceinline__ void gdn_flush(const LAS unsigned char* lds, unsigned char* sn  , unsigned char* vn, const int tid) {
#pragma unroll
    for (int i = 0; i < 8; ++i) { const int idx = tid + NTHREADS * i, slot = idx >> 9, rem = idx & 511, col = rem >> 4, c16 = rem & 15;
        *(GAS v4u*)(sn + (size_t)slot * GSN_STEP + (col * 128 + c16 * 8) * 2) = *(const LAS v4u*)(lds + slot * GS_ST + (col * 136 + c16 * 8) * 2); }
#pragma unroll
    for (int i = 0; i < 4; ++i) { const int idx = tid + NTHREADS * i, slot = idx >> 8, rem = idx & 255, col = rem >> 3, c8 = rem & 7;
        *(GAS v4u*)(vn + (size_t)slot * GVN_STEP + (col * 64 + c8 * 8) * 2) = *(const LAS v4u*)(lds + GS_VN0 + slot * GS_VN + (col * 72 + c8 * 8) * 2); }
    __syncthreads();
}
template <int VAR = 0>
__device__ __forceinline__ void gdn_scan_item(Ctx& C, const int item) {
    const int cb = item & 3, bh = item >> 2;
    const int lane = C.lane, wave = C.wave, tr = wave >> 1, tc = wave & 1, fr = lane & 15, fq = lane >> 4;
    for (int i = C.tid; i < GS_ST / 4; i += NTHREADS) ((LAS unsigned*)(C.lds + 7 * GS_ST))[i] = 0u;
    const unsigned char* gp0 = C.ws + WS_GPRE + (size_t)bh * 64 * GPRE_UNIT;
    const float* egl0 = (const float*)(C.ws + WS_SMALL + SM_EGL) + bh * 64;
    unsigned char* sn0 = C.ws + WS_GSN + ((size_t)bh * 64 * 4 + cb) * 8192;
    unsigned char* vn0 = C.ws + WS_GVN + ((size_t)bh * 64 * 4 + cb) * 4096;
    f32x4 S[2]; S[0] = (f32x4){0.f, 0.f, 0.f, 0.f}; S[1] = S[0];
    GdnFrags f0, f1, f2, f3; GdnOff go; gdn_offsets(tr, tc, cb, lane, go);
    const __amdgpu_buffer_rsrc_t rs = __builtin_amdgcn_make_buffer_rsrc((void*)gp0, 0, 64 * (int)GPRE_UNIT, 0x00020000);
    gdn_load(rs, 0u, egl0, go, f0); gdn_load(rs, (unsigned)GPRE_UNIT, egl0 + 1, go, f1); gdn_load(rs, 2u * (unsigned)GPRE_UNIT, egl0 + 2, go, f2);
    if (VAR == 1) gdn_load(rs, 3u * (unsigned)GPRE_UNIT, egl0 + 3, go, f3);
    __syncthreads();
    for (int n = 0; n < 64; n += 8) {
#define GDN_LD(k, f) do { if (VAR == 1) break; const int _c = (k) < 64 ? (k) : 63; gdn_load(rs, (unsigned)_c * (unsigned)GPRE_UNIT, egl0 + _c, go, f); } while (0)
        GDN_LD(n + 3, f3); gdn_step(f0, n, C.lds, S, tr, tc, fr, fq); __builtin_amdgcn_sched_barrier(0);
        GDN_LD(n + 4, f0); gdn_step(f1, n + 1, C.lds, S, tr, tc, fr, fq); __builtin_amdgcn_sched_barrier(0);
        GDN_LD(n + 5, f1); gdn_step(f2, n + 2, C.lds, S, tr, tc, fr, fq); __builtin_amdgcn_sched_barrier(0);
        GDN_LD(n + 6, f2); gdn_step(f3, n + 3, C.lds, S, tr, tc, fr, fq); __builtin_amdgcn_sched_barrier(0);
        GDN_LD(n + 7, f3); gdn_step(f0, n + 4, C.lds, S, tr, tc, fr, fq); __builtin_amdgcn_sched_barrier(0);
        GDN_LD(n + 8, f0); gdn_step(f1, n + 5, C.lds, S, tr, tc, fr, fq); __builtin_amdgcn_sched_barrier(0);
        GDN_LD(n + 9, f1); gdn_step(f2, n + 6, C.lds, S, tr, tc, fr, fq); __builtin_amdgcn_sched_barrier(0);
        GDN_LD(n + 10, f2); gdn_step(f3, n + 7, C.lds, S, tr, tc, fr, fq); __builtin_amdgcn_sched_barrier(0);
#undef GDN_LD
        gdn_flush(C.lds, sn0 + (size_t)n * GSN_STEP, vn0 + (size_t)n * GVN_STEP, C.tid);
    }
}

__device__ __forceinline__ void lru_scan_item(Ctx& C, const int item) {
    const int b = item >> 3, ch = (item & 7) * 64 + C.lane, wave = C.wave;
    const float* LA = (const float*)(C.ws + WS_LA) + ((size_t)b * T + 512 * wave) * 512 + ch;
    const float* LU = (const float*)(C.ws + WS_LU) + ((size_t)b * T + 512 * wave) * 512 + ch;
    float* LH = (float*)(C.ws + WS_LH) + ((size_t)b * T + 512 * wave) * 512 + ch;
    LAS float* HE = (LAS float*)C.lds; LAS float* PE = HE + 8 * 64;
    float hh = 0.f, pp = 1.f;
    for (int t = 0; t < 512; t += 8) {
        float a[8], u[8];
#pragma unroll
        for (int i = 0; i < 8; ++i) { a[i] = LA[(size_t)(t + i) * 512]; u[i] = LU[(size_t)(t + i) * 512]; }
#pragma unroll
        for (int i = 0; i < 8; ++i) { hh = a[i] * hh + u[i]; pp *= a[i]; }
    }
    HE[wave * 64 + C.lane] = hh; PE[wave * 64 + C.lane] = pp;
    __syncthreads();
    float H = 0.f;
    for (int s = 0; s < wave; ++s) H = PE[s * 64 + C.lane] * H + HE[s * 64 + C.lane];
    for (int t = 0; t < 512; t += 8) {
        float a[8], u[8];
#pragma unroll
        for (int i = 0; i < 8; ++i) { a[i] = LA[(size_t)(t + i) * 512]; u[i] = LU[(size_t)(t + i) * 512]; }
#pragma unroll
        for (int i = 0; i < 8; ++i) { H = a[i] * H + u[i]; LH[(size_t)(t + i) * 512] = H; }
    }
}

__device__ __forceinline__ void nsa_sel_dispatch(Ctx& C, const int l, const int j) {
    const int bb = j & 1, k = j >> 1;
    const int pp = k < 64 ? 0 : (k < 112 ? 1 : (k < 144 ? 2 : 3));
    const int ub = 63 - (k - (pp == 0 ? 0 : (pp == 1 ? 64 : (pp == 2 ? 112 : 144))));
    nsa_item<0>(C, l, bb, ub, pp);
}
__device__ __forceinline__ void fox_dispatch(Ctx& C, const int l, const int j) {
    const int bh = j & 7, k = j >> 3;
    const int pp = k < 16 ? 0 : (k < 28 ? 1 : (k < 36 ? 2 : 3));
    const int qb = 15 - (k - (pp == 0 ? 0 : (pp == 1 ? 16 : (pp == 2 ? 28 : 36))));
    fox_item(C, l, bh >> 2, bh & 3, qb, pp);
}
__device__ __forceinline__ void mix_phase(Ctx& C, const int l, const int qoff) {
    const int q0 = 16 * l + 8 + qoff;
    if (C.bid < 32) { refresh_ids(C); __syncthreads(); gdn_scan_item<0>(C, (C.bid & 7) * 4 + (C.bid >> 3)); }
    QUEUE_LOOP(q0 + 1, 16, lru_scan_item(C, j));
    QUEUE_LOOP(q0 + 2, 320, nsa_sel_dispatch(C, l, j));
    QUEUE_LOOP(q0 + 3, 320, fox_dispatch(C, l, j));
    QUEUE_LOOP(q0 + 4, 128, nsa_item<1>(C, l, j & 1, 63 - (j >> 1), 0));
}
__device__ __forceinline__ void gdn_out_job(Ctx& C, const int l, const int job) {
    const int n = job & 63, bh = job >> 6, b = bh >> 2, h = bh & 3;
    const int lane = C.lane, wave = C.wave, tr = wave >> 1, chalf = wave & 1, fr = lane & 15, fq = lane >> 4;
    const unsigned char* gp = C.ws + WS_GPRE + (size_t)job * GPRE_UNIT;
    bf16x8 qt[4], qk[2];
#pragma unroll
    for (int kk = 0; kk < 4; ++kk) qt[kk] = *(const GAS bf16x8*)(gp + GP_QT + ((16 * tr + fr) * 128 + 32 * kk + 8 * fq) * 2);
#pragma unroll
    for (int kk = 0; kk < 2; ++kk) qk[kk] = *(const GAS bf16x8*)(gp + GP_QK + ((16 * tr + fr) * 64 + 32 * kk + 8 * fq) * 2);
    f32x4 acc[4];
#pragma unroll
    for (int i = 0; i < 4; ++i) {
        acc[i] = (f32x4){0.f, 0.f, 0.f, 0.f};
        const int ct = 4 * chalf + i, cb = ct >> 1, within = (ct & 1) * 16 + fr;
        if (n > 0) { const unsigned char* sn = C.ws + WS_GSN + ((size_t)(job - 1) * 4 + cb) * 8192 + (within * 128 + 8 * fq) * 2;
#pragma unroll
            for (int kk = 0; kk < 4; ++kk) acc[i] = mfma16(qt[kk], *(const GAS bf16x8*)(sn + 64 * kk), acc[i]); }
        const unsigned char* vn = C.ws + WS_GVN + ((size_t)job * 4 + cb) * 4096 + (within * 64 + 8 * fq) * 2;
#pragma unroll
        for (int kk = 0; kk < 2; ++kk) acc[i] = mfma16(qk[kk], *(const GAS bf16x8*)(vn + 64 * kk), acc[i]);
    }
    LAS float* PS = (LAS float*)C.lds;
    float ss[4];
#pragma unroll
    for (int r = 0; r < 4; ++r) { float s = acc[0][r] * acc[0][r] + acc[1][r] * acc[1][r] + acc[2][r] * acc[2][r] + acc[3][r] * acc[3][r];
        s += __shfl_xor(s, 1); s += __shfl_xor(s, 2); s += __shfl_xor(s, 4); s += __shfl_xor(s, 8); ss[r] = s; }
    if (fr == 0) {
#pragma unroll
        for (int r = 0; r < 4; ++r) PS[(16 * tr + 4 * fq + r) * 2 + chalf] = ss[r]; }
    __syncthreads();
    const float* gng = inp<I_GNORM>() + l * 128;
    const float* zf = (const float*)(C.ws + WS_ZF);
    bf16* Y = (bf16*)(C.ws + WS_XN);
#pragma unroll
    for (int r = 0; r < 4; ++r) {
        const int row = 16 * tr + 4 * fq + r; const size_t m = (size_t)b * T + 64 * n + row;
        const float rstd = 1.0f / sqrtf((PS[row * 2] + PS[row * 2 + 1]) * (1.f / 128.f) + EPS);
#pragma unroll
        for (int i = 0; i < 4; ++i) { const int col = 16 * (4 * chalf + i) + fr;
            const float gz = zf[m * ZFC + ZF_GZ + h * 128 + col];
            Y[m * D + 512 + h * 128 + col] = (bf16)f2bf(acc[i][r] * rstd * gng[col] * silu_ff(gz)); }
    }
}
__device__ __forceinline__ void post_phase(Ctx& C, const int l) {
    QUEUE_LOOP(16 * l + 14, 512, gdn_out_job(C, l, j));
    refresh_ids(C);
    const int lane = C.lane;
    bf16* Y = (bf16*)(C.ws + WS_XN);
    const float* zf = (const float*)(C.ws + WS_ZF);
    const float* ong = inp<I_ONG>() + (size_t)l * 3 * 512;
    for (int m = C.bid * NWAVES + C.wave; m < M; m += C.G * NWAVES) {
        const size_t r512 = (size_t)m * 512 + 8 * lane;
        const unsigned char* pw = C.ws + WS_W + (size_t)l * W_LAYER;
        const int tpos = m & (T - 1), hd = lane >> 4;
        f32x4 a0, a1, s0, s1;
        {
            const int np = (tpos >> 10) + 1;
            float mp[4], lp[4], mx = -1e30f;
#pragma unroll
            for (int p = 0; p < 4; ++p) { mp[p] = -1e30f; lp[p] = 0.f;
                if (p < np) { typedef float f32x2 __attribute__((ext_vector_type(2))); const f32x2 v = *(const GAS f32x2*)((const float*)(pw + PW_FOXML + (size_t)p * PW_MLSLOT) + ((size_t)m * 4 + hd) * 2); mp[p] = v.x; lp[p] = v.y; }
                mx = fmaxf(mx, mp[p]); }
            float den = 0.f; a0 = (f32x4){0.f, 0.f, 0.f, 0.f}; a1 = a0;
#pragma unroll
            for (int p = 0; p < 4; ++p) if (p < np) { const float w = __builtin_amdgcn_exp2f(mp[p] - mx); den += w * lp[p];
                const v4u u = *(const GAS v4u*)((const bf16*)(pw + PW_FOX + (size_t)p * PW_SLOT) + r512);
                a0 += w * (f32x4){bf2f(u.x & 0xffff), bf2f(u.x >> 16), bf2f(u.y & 0xffff), bf2f(u.y >> 16)};
                a1 += w * (f32x4){bf2f(u.z & 0xffff), bf2f(u.z >> 16), bf2f(u.w & 0xffff), bf2f(u.w >> 16)}; }
            const float inv = den > 0.f ? 1.0f / den : 0.f; a0 *= inv; a1 *= inv;
        }
        {
            const int np = (tpos >> 10) + 1;
            float mp[4], lp[4], mx = -1e30f;
#pragma unroll
            for (int p = 0; p < 4; ++p) { mp[p] = -1e30f; lp[p] = 0.f;
                if (p < np) { typedef float f32x2 __attribute__((ext_vector_type(2))); const f32x2 v = *(const GAS f32x2*)((const float*)(pw + PW_SELML + (size_t)p * PW_MLSLOT) + ((size_t)m * 4 + hd) * 2); mp[p] = v.x; lp[p] = v.y; }
                mx = fmaxf(mx, mp[p]); }
            float den = 0.f; s0 = (f32x4){0.f, 0.f, 0.f, 0.f}; s1 = s0;
#pragma unroll
            for (int p = 0; p < 4; ++p) if (p < np) { const float w = __builtin_amdgcn_exp2f(mp[p] - mx); den += w * lp[p];
                const v4u u = *(const GAS v4u*)((const bf16*)(pw + PW_SEL + (size_t)p * PW_SLOT) + r512);
                s0 += w * (f32x4){bf2f(u.x & 0xffff), bf2f(u.x >> 16), bf2f(u.y & 0xffff), bf2f(u.y >> 16)};
                s1 += w * (f32x4){bf2f(u.z & 0xffff), bf2f(u.z >> 16), bf2f(u.w & 0xffff), bf2f(u.w >> 16)}; }
            const float inv = (den > 0.f ? 1.0f / den : 0.f) * sigmoid_f(zf[(size_t)m * ZFC + ZF_NG + hd * 3 + 1]); s0 *= inv; s1 *= inv;
        }
        f32x4 c0 = *(const GAS f32x4*)((const float*)(C.ws + WS_LH) + r512), c1 = *(const GAS f32x4*)((const float*)(C.ws + WS_LH) + r512 + 4);
        f32x4 d0 = *(const GAS f32x4*)((const float*)(C.ws + WS_ONSA) + r512) + *(const GAS f32x4*)((const float*)(C.ws + WS_OFOX) + r512) + s0;
        f32x4 d1 = *(const GAS f32x4*)((const float*)(C.ws + WS_ONSA) + r512 + 4) + *(const GAS f32x4*)((const float*)(C.ws + WS_OFOX) + r512 + 4) + s1;
        const f32x4 lg0 = *(const GAS f32x4*)(zf + (size_t)m * ZFC + ZF_LG + 8 * lane), lg1 = *(const GAS f32x4*)(zf + (size_t)m * ZFC + ZF_LG + 8 * lane + 4);
#pragma unroll
        for (int i = 0; i < 4; ++i) { c0[i] *= gelu_tanh_f(lg0[i]); c1[i] *= gelu_tanh_f(lg1[i]); }
#define SS8(x0, x1) ((x0.x * x0.x + x0.y * x0.y) + (x0.z * x0.z + x0.w * x0.w) + (x1.x * x1.x + x1.y * x1.y) + (x1.z * x1.z + x1.w * x1.w))
        const float ra = 1.0f / sqrtf(wave_sum(SS8(a0, a1)) * (1.f / 512.f) + EPS);
        const float rc = 1.0f / sqrtf(wave_sum(SS8(c0, c1)) * (1.f / 512.f) + EPS);
        const float rd = 1.0f / sqrtf(wave_sum(SS8(d0, d1)) * (1.f / 512.f) + EPS);
#undef SS8
        const f32x4 ga0 = *(const GAS f32x4*)(ong + 8 * lane), ga1 = *(const GAS f32x4*)(ong + 8 * lane + 4);
        const f32x4 gc0 = *(const GAS f32x4*)(ong + 512 + 8 * lane), gc1 = *(const GAS f32x4*)(ong + 512 + 8 * lane + 4);
        const f32x4 gd0 = *(const GAS f32x4*)(ong + 1024 + 8 * lane), gd1 = *(const GAS f32x4*)(ong + 1024 + 8 * lane + 4);
        bf16* yr = Y + (size_t)m * D + 8 * lane;
        v4u w;
        w.x = pk2(a0.x * ra * ga0.x, a0.y * ra * ga0.y); w.y = pk2(a0.z * ra * ga0.z, a0.w * ra * ga0.w); w.z = pk2(a1.x * ra * ga1.x, a1.y * ra * ga1.y); w.w = pk2(a1.z * ra * ga1.z, a1.w * ra * ga1.w);
        *(GAS v4u*)yr = w;
        w.x = pk2(c0.x * rc * gc0.x, c0.y * rc * gc0.y); w.y = pk2(c0.z * rc * gc0.z, c0.w * rc * gc0.w); w.z = pk2(c1.x * rc * gc1.x, c1.y * rc * gc1.y); w.w = pk2(c1.z * rc * gc1.z, c1.w * rc * gc1.w);
        *(GAS v4u*)(yr + 1024) = w;
        w.x = pk2(d0.x * rd * gd0.x, d0.y * rd * gd0.y); w.y = pk2(d0.z * rd * gd0.z, d0.w * rd * gd0.w); w.z = pk2(d1.x * rd * gd1.x, d1.y * rd * gd1.y); w.w = pk2(d1.z * rd * gd1.z, d1.w * rd * gd1.w);
        *(GAS v4u*)(yr + 1536) = w;
    }
}
#ifndef N_LAUNCHES
#define N_LAUNCHES 1
#endif
constexpr int PH_PER_LAYER = 12, NPHASES = 1 + DEPTH * PH_PER_LAYER;
struct Args { const float* in[N_IN]; float* out; unsigned char* ws; int ph_lo, ph_hi; };
static_assert(sizeof(Args) == (N_IN + 2) * 8 + 8, "Args has no padding");

#define IN_PH(k) (lo <= (k) && (k) < hi)
#define SEAM(k) do { if (IN_PH(k) && IN_PH((k) + 1)) xcd_barrier(bar); } while (0)
template <int l> __device__ __forceinline__ void layer_phases(Ctx& C, const XcdBarrier& bar, const int lo, const int hi) {
        const int pb = 1 + l * PH_PER_LAYER;
        unsigned char* wl = C.ws + WS_W + (size_t)l * W_LAYER;
        bf16* XN = (bf16*)(C.ws + WS_XN); bf16* ACT = (bf16*)(C.ws + WS_ACT);
        if (IN_PH(pb + 0)) {
            pg8::Gemm g{XN, (const bf16*)(wl + WO_GU1), M, 2 * FF, D}; pg8::StaticOrder S; S.init(M, 2 * FF, C.G, C.bid);
            pg8::EpiSwiGLU E{ACT, FF};
            pg8::gemm_phase<pg8::EpiSwiGLU, pg8::StaticOrder, true, true>(C.lds, g, S, E);
        }
        SEAM(pb + 0);
        if (IN_PH(pb + 1)) {
            pg8::Gemm g{ACT, (const bf16*)(wl + WO_DN1), M, D, FF}; pg8::StaticOrder S; S.init(M, D, C.G, C.bid);
            pg8::EpiResid E{hptr(), D, 0.5f};
            pg8::gemm_phase<pg8::EpiResid, pg8::StaticOrder, false, true>(C.lds, g, S, E);
        }
        SEAM(pb + 1);
        if (IN_PH(pb + 2)) norm_phase_bf16(C, inp<I_MIXG>() + l * D);
        SEAM(pb + 2);
        if (IN_PH(pb + 3)) {
            pg8::Gemm g{XN, (const bf16*)(wl + WO_WIN), M, ZC, D}; pg8::StaticOrder S; S.init(M, ZC, C.G, C.bid);
            pg8::EpiWin E{(bf16*)(C.ws + WS_ZB), ZBC, (float*)(C.ws + WS_ZF), ZFC, (const float*)(C.ws + WS_MISC) + l * ZC, ZBC / 256};
            pg8::gemm_phase<pg8::EpiWin, pg8::StaticOrder, true, true>(C.lds, g, S, E);
        }
        SEAM(pb + 3);
        if (IN_PH(pb + 4)) pre_phase(C, l, 0);
        SEAM(pb + 4);
        if (IN_PH(pb + 5)) mix_phase(C, l, 0);
        SEAM(pb + 5);
        if (IN_PH(pb + 6)) post_phase(C, l);
        SEAM(pb + 6);
#ifdef PROBE_ITEM
        if (IN_PH(pb + 5)) {
#if PROBE_ITEM == 0
            if (C.bid < 32) { refresh_ids(C); __syncthreads(); gdn_scan_item<PROBE_VAR>(C, (C.bid & 7) * 4 + (C.bid >> 3)); }
#elif PROBE_ITEM == 10
            QUEUE_LOOP(16 * l + 40, 64, nsa_compress_job(C, l, j));
#elif PROBE_ITEM == 11
            QUEUE_LOOP(16 * l + 40, 512, gdn_pre_job(C, l, j));
#elif PROBE_ITEM == 12
            QUEUE_LOOP(16 * l + 40, 256, lru_gate_job(C, l, j));
#elif PROBE_ITEM == 13
            QUEUE_LOOP(16 * l + 40, 128, vtrans_job(C, j));
#elif PROBE_ITEM == 9
            mix_phase(C, l, 32);
#elif PROBE_ITEM == 8
            pre_phase(C, l, 32);
#elif PROBE_ITEM == 3
            QUEUE_LOOP(16 * l + 40, 16, lru_scan_item(C, j));
#endif
        }
        SEAM(pb + 5);
#endif
        if (IN_PH(pb + 7)) {
            pg8::Gemm g{XN, (const bf16*)(wl + WO_WOUT), M, D, D}; pg8::StaticOrder S; S.init(M, D, C.G, C.bid);
            pg8::EpiResid E{hptr(), D, 1.0f};
            pg8::gemm_phase<pg8::EpiResid, pg8::StaticOrder, false, true>(C.lds, g, S, E);
        }
        SEAM(pb + 7);
        if (IN_PH(pb + 8)) norm_phase_bf16(C, inp<I_F2G>() + l * D);
        SEAM(pb + 8);
        if (IN_PH(pb + 9)) {
            pg8::Gemm g{XN, (const bf16*)(wl + WO_GU2), M, 2 * FF, D}; pg8::StaticOrder S; S.init(M, 2 * FF, C.G, C.bid);
            pg8::EpiSwiGLU E{ACT, FF};
            pg8::gemm_phase<pg8::EpiSwiGLU, pg8::StaticOrder, true, true>(C.lds, g, S, E);
        }
        SEAM(pb + 9);
        if (IN_PH(pb + 10)) {
            pg8::Gemm g{ACT, (const bf16*)(wl + WO_DN2), M, D, FF}; pg8::StaticOrder S; S.init(M, D, C.G, C.bid);
            pg8::EpiResid E{hptr(), D, 0.5f};
            pg8::gemm_phase<pg8::EpiResid, pg8::StaticOrder, false, true>(C.lds, g, S, E);
        }
        SEAM(pb + 10);
        if (IN_PH(pb + 11)) {
            if (l + 1 < DEPTH) norm_phase_bf16(C, inp<I_F1G>() + (l + 1) * D);
            else { refresh_ids(C); float* const hp = hptr(); for (int m = C.bid * NWAVES + C.wave; m < M; m += C.G * NWAVES) rms_row_f32(hp + (size_t)m * D, inp<I_FING>(), hp + (size_t)m * D, C.lane); }
        }
        SEAM(pb + 11);
    }
__global__ void __launch_bounds__(NTHREADS, 2) fwd_kernel(Args args) {
    extern __shared__ __attribute__((aligned(16))) unsigned char lds_raw[];
    Ctx C;
    C.lds = (LAS unsigned char*)lds_raw;
    C.tid = threadIdx.x; C.lane = C.tid & 63; C.wave = __builtin_amdgcn_readfirstlane(C.tid >> 6);
    C.G = gridDim.x; C.bid = blockIdx.x;
    C.ws = args.ws;
    if (C.tid < 64) ((LAS unsigned*)(C.lds + LDS_CTL_OFF))[C.tid] = 0u;
    __syncthreads();
    XcdBarrier bar; bar.bar = (unsigned*)C.ws + CW_BAR; bar.x = 0; bar.st = nullptr;
    const int lo = args.ph_lo, hi = args.ph_hi;
    if (hi - lo > 1) bar = xcd_barrier_post((unsigned*)C.ws + CW_BAR, (volatile LAS unsigned*)(C.lds + LDS_CTL_OFF));

    if (IN_PH(0)) { prologue_phase(C); }
    SEAM(0);
    layer_phases<0>(C, bar, lo, hi);
    layer_phases<1>(C, bar, lo, hi);
    static_assert(DEPTH == 2, "two layers");
#undef IN_PH
#undef SEAM
}

extern "C" void kernel_launch(void* const* d_in, const int* in_sizes, int n_in, void* d_out, int out_size, void* d_ws, size_t ws_size, hipStream_t stream) {
    static int grid = 0;
    if (grid == 0) {
        if (n_in != N_IN || in_sizes[0] != M * D || out_size != M * D || ws_size < WS_W1T + 4 * MiB) { fprintf(stderr, "kernel_launch: unexpected shapes (n_in %d, in0 %d, out %d, ws %zu)\n", n_in, n_in > 0 ? in_sizes[0] : -1, out_size, ws_size); grid = -1; return; }
        int dev = 0, cus = 0, per_cu = 0;
        if (hipGetDevice(&dev) != hipSuccess || hipDeviceGetAttribute(&cus, hipDeviceAttributeMultiprocessorCount, dev) != hipSuccess) { grid = -1; return; }
        if (hipFuncSetAttribute((const void*)fwd_kernel, hipFuncAttributeMaxDynamicSharedMemorySize, LDS_BYTES) != hipSuccess) { fprintf(stderr, "kernel_launch: hipFuncSetAttribute failed\n"); grid = -1; return; }
        if (hipOccupancyMaxActiveBlocksPerMultiprocessor(&per_cu, (const void*)fwd_kernel, NTHREADS, LDS_BYTES) != hipSuccess || per_cu < 1) { fprintf(stderr, "kernel_launch: occupancy query reports %d\n", per_cu); }
        (void)hipGetLastError();
        grid = cus;
    }
    if (grid < 0) return;
    if (hipMemsetAsync((char*)d_ws + WS_CTL, 0, CTL_ZERO_BYTES, stream) != hipSuccess) return;
    Args a{};
    for (int i = 0; i < N_IN; ++i) a.in[i] = (const float*)d_in[i];
    a.out = (float*)d_out; a.ws = (unsigned char*)d_ws;
#if N_LAUNCHES == 1
    a.ph_lo = 0; a.ph_hi = NPHASES;
    hipLaunchKernelGGL(fwd_kernel, dim3(grid), dim3(NTHREADS), LDS_BYTES, stream, a);
#else
    for (int p = 0; p < NPHASES; ++p) { a.ph_lo = p; a.ph_hi = p + 1; hipLaunchKernelGGL(fwd_kernel, dim3(grid), dim3(NTHREADS), LDS_BYTES, stream, a); }
#endif
}
```

```cpp
#include <hip/hip_runtime.h>
#include <cstdio>
#include <cstdint>
#include <cmath>
namespace pg8 {
#define PG8_LAS __attribute__((address_space(3)))
typedef unsigned short bf16_t;
typedef short bf16x8 __attribute__((ext_vector_type(8)));
typedef float f32x4 __attribute__((ext_vector_type(4)));
typedef unsigned u32x4 __attribute__((ext_vector_type(4)));
constexpr int BM = 256, BK = 64, HALF = 128, HTB = HALF * BK * 2  , STAGE_BYTES = 8 * HTB, NXCD = 8, WGM = 8;

__host__ __device__ __forceinline__ int lds_byte(int r, int c) { const int st = (r >> 4) * 2 + (c >> 5), rr = r & 15, cc = c & 31, ob = rr * 64 + cc * 2; return st * 1024 + (ob ^ (((ob >> 9) & 1) << 5)); }
__host__ __device__ __forceinline__ void stage_rc(int b, int& R, int& C) { const int st = b / 1024, sb = b % 1024, swz = sb ^ (((sb >> 9) & 1) << 5); R = (st >> 1) * 16 + swz / 64; C = (st & 1) * 32 + (swz % 64) / 2; }
__host__ __device__ __forceinline__ int perm32(int rho) { const int n = rho >> 4, i = rho & 15; return 8 * (i >> 2) + 4 * n + (i & 3); }

struct Unit { int pm, pn; };
struct Gemm { const bf16_t* A; const bf16_t* Bt; int M, N, K; };

struct StaticOrder {
    int nM, nN, nwg, G, c;
    __host__ __device__ void init(int M, int N, int G_, int c_) { nM = M / BM; nN = N / BM; nwg = nM * nN; G = G_; c = c_; }
    __host__ __device__ bool next(int i, Unit& u) const {
        const long L = (long)i * G + c; if (L >= nwg) return false;
        int wgid = (int)L; { const int q = nwg / NXCD, r = nwg % NXCD, xcd = wgid % NXCD, off = wgid / NXCD; wgid = (xcd < r ? xcd * (q + 1) : r * (q + 1) + (xcd - r) * q) + off; }
        const int nig = WGM * nN, gid = wgid / nig, fm = gid * WGM, gsz = (nM - fm) < WGM ? (nM - fm) : WGM;
        u.pm = fm + ((wgid % nig) % gsz); u.pn = (wgid % nig) / gsz; return true;
    }
    __device__ __forceinline__ void a_ready(const Unit&) const {}
    __device__ __forceinline__ void done(const Unit&) const {}
};

__device__ __forceinline__ unsigned cvt_pk_bf16(float lo, float hi) { unsigned r; asm volatile("v_cvt_pk_bf16_f32 %0, %1, %2" : "=v"(r) : "v"(lo), "v"(hi)); return r; }
typedef unsigned u32x2v __attribute__((ext_vector_type(2)));
__device__ __forceinline__ float silu_f(float x) { return x * __builtin_amdgcn_rcpf(1.0f + __builtin_amdgcn_exp2f(-1.44269504f * x)); }

struct EpiSwiGLU {
    static constexpr bool PERM = true, AFTER_DRAIN = false;
    bf16_t* O; int ldc;
    __device__ __forceinline__ void operator()(const f32x4 (&acc)[2][2][4][2], const Unit& u, int wr, int wc, int fr, int fq) const {
        const int row0 = u.pm * BM + wr * 64 + fr, col0 = u.pn * HALF + wc * 32 + 8 * fq;
#pragma unroll
        for (int ai = 0; ai < 2; ++ai)
#pragma unroll
            for (int m = 0; m < 4; ++m) { bf16_t* rowp = O + (size_t)(row0 + ai * HALF + m * 16) * ldc + col0;
                const f32x4 g0 = acc[ai][0][m][0], g1 = acc[ai][0][m][1], u0 = acc[ai][1][m][0], u1 = acc[ai][1][m][1];
                u32x4 w;
                w.x = cvt_pk_bf16(silu_f(g0[0]) * u0[0], silu_f(g0[1]) * u0[1]); w.y = cvt_pk_bf16(silu_f(g0[2]) * u0[2], silu_f(g0[3]) * u0[3]);
                w.z = cvt_pk_bf16(silu_f(g1[0]) * u1[0], silu_f(g1[1]) * u1[1]); w.w = cvt_pk_bf16(silu_f(g1[2]) * u1[2], silu_f(g1[3]) * u1[3]);
                *(u32x4*)rowp = w; }
    }
};
struct EpiResid {
    static constexpr bool PERM = false, AFTER_DRAIN = false;
    float* C; int ldc; float scale;
    __device__ __forceinline__ void operator()(const f32x4 (&acc)[2][2][4][2], const Unit& u, int wr, int wc, int fr, int fq) const {
        const int row0 = u.pm * BM + wr * 64 + fr, col0 = u.pn * BM + wc * 32 + 4 * fq;
#pragma unroll
        for (int ai = 0; ai < 2; ++ai)
#pragma unroll
            for (int m = 0; m < 4; ++m) { float* rowp = C + (size_t)(row0 + ai * HALF + m * 16) * ldc + col0;
                f32x4 old[2][2];
#pragma unroll
                for (int bj = 0; bj < 2; ++bj)
#pragma unroll
                    for (int n = 0; n < 2; ++n) old[bj][n] = *(const f32x4*)(rowp + bj * HALF + n * 16);
#pragma unroll
                for (int bj = 0; bj < 2; ++bj)
#pragma unroll
                    for (int n = 0; n < 2; ++n) *(f32x4*)(rowp + bj * HALF + n * 16) = old[bj][n] + acc[ai][bj][m][n] * scale;
                asm volatile("" ::: "memory"); }
    }
};
struct EpiWin {
    static constexpr bool PERM = true, AFTER_DRAIN = false;
    bf16_t* ZB; int ldb; float* ZF; int ldf; const float* bias; int nb16;
    __device__ __forceinline__ void operator()(const f32x4 (&acc)[2][2][4][2], const Unit& u, int wr, int wc, int fr, int fq) const {
        const int row0 = u.pm * BM + wr * 64 + fr, col0 = u.pn * BM + wc * 32 + 8 * fq;
        if (u.pn < nb16) {
#pragma unroll
            for (int bj = 0; bj < 2; ++bj) { const f32x4 b0 = *(const f32x4*)(bias + col0 + bj * HALF), b1 = *(const f32x4*)(bias + col0 + bj * HALF + 4);
#pragma unroll
                for (int ai = 0; ai < 2; ++ai)
#pragma unroll
                    for (int m = 0; m < 4; ++m) { bf16_t* rowp = ZB + (size_t)(row0 + ai * HALF + m * 16) * ldb + col0 + bj * HALF;
                        const f32x4 v0 = acc[ai][bj][m][0] + b0, v1 = acc[ai][bj][m][1] + b1;
                        u32x4 w; w.x = cvt_pk_bf16(v0[0], v0[1]); w.y = cvt_pk_bf16(v0[2], v0[3]); w.z = cvt_pk_bf16(v1[0], v1[1]); w.w = cvt_pk_bf16(v1[2], v1[3]);
                        *(u32x4*)rowp = w; }
                asm volatile("" ::: "memory"); }
        } else {
            const int cf = col0 - nb16 * BM;
#pragma unroll
            for (int bj = 0; bj < 2; ++bj) { const f32x4 b0 = *(const f32x4*)(bias + col0 + bj * HALF), b1 = *(const f32x4*)(bias + col0 + bj * HALF + 4);
#pragma unroll
                for (int ai = 0; ai < 2; ++ai)
#pragma unroll
                    for (int m = 0; m < 4; ++m) { float* rowp = ZF + (size_t)(row0 + ai * HALF + m * 16) * ldf + cf + bj * HALF;
                        *(f32x4*)rowp = acc[ai][bj][m][0] + b0; *(f32x4*)(rowp + 4) = acc[ai][bj][m][1] + b1; }
                asm volatile("" ::: "memory"); }
        }
    }
};
template <class Epi, class Sched, bool ALIGN_EPI = false, bool SP2 = false>
__device__ __forceinline__ void gemm_phase(PG8_LAS unsigned char* lds, const Gemm g, const Sched& S, const Epi& E) {
    const int tid = threadIdx.x, wid = __builtin_amdgcn_readfirstlane(tid >> 6), lane = tid & 63, wr = wid >> 2, wc = wid & 3, fr = lane & 15, fq = lane >> 4;
    const int K = g.K, nt = K / BK;
    unsigned voffA[2], voffB[2];
#pragma unroll
    for (int i = 0; i < 2; ++i) { int R, C; stage_rc(tid * 16 + i * 8192, R, C); const int Rb = Epi::PERM ? ((R & ~31) + perm32(R & 31)) : R;
        voffA[i] = (unsigned)(R * K + C) * 2u; voffB[i] = (unsigned)(Rb * K + C) * 2u; }
    const size_t kstep = (size_t)(BK * 2);
    const size_t hstep = (size_t)HALF * K * 2;
    const size_t tstep = 2 * hstep;
    const unsigned ldsw = (unsigned)wid * 1024u;
    const int aoff = lds_byte(wr * 64 + fr, fq * 8), boff = lds_byte(wc * 32 + fr, fq * 8);
#define PG8_SA(b, h) (((b) * 2 + (h)) * HTB)
#define PG8_SB(b, h) ((4 + (b) * 2 + (h)) * HTB)
#define PG8_STAGE(bufoff, gbase, voff) do { _Pragma("unroll") for (int _i = 0; _i < 2; ++_i) \
        __builtin_amdgcn_global_load_lds((const unsigned*)((const char*)(gbase) + (voff)[_i]), (PG8_LAS unsigned*)(lds + (bufoff) + ldsw + _i * 8192), 16, 0, 0); } while (0)
#define PG8_LDA(dst, b, h) do { _Pragma("unroll") for (int m = 0; m < 4; ++m) _Pragma("unroll") for (int k = 0; k < 2; ++k) dst[m][k] = *(const PG8_LAS bf16x8*)(lds + PG8_SA(b, h) + aoff + m * 2048 + k * 1024); } while (0)
#define PG8_LDB(dst, b, h) do { _Pragma("unroll") for (int n = 0; n < 2; ++n) _Pragma("unroll") for (int k = 0; k < 2; ++k) dst[n][k] = *(const PG8_LAS bf16x8*)(lds + PG8_SB(b, h) + boff + n * 2048 + k * 1024); } while (0)
#define PG8_MMA(ai, bj, At, Bt) do { __builtin_amdgcn_s_setprio(1); _Pragma("unroll") for (int m = 0; m < 4; ++m) _Pragma("unroll") for (int n = 0; n < 2; ++n) _Pragma("unroll") for (int k = 0; k < 2; ++k) \
        acc[ai][bj][m][n] = __builtin_amdgcn_mfma_f32_16x16x32_bf16(Bt[n][k], At[m][k], acc[ai][bj][m][n], 0, 0, 0); __builtin_amdgcn_s_setprio(0); } while (0)
#define PG8_WAIT_V(n) asm volatile("s_waitcnt vmcnt(" #n ")" ::: "memory")
#define PG8_WAIT_L(n) asm volatile("s_waitcnt lgkmcnt(" #n ")" ::: "memory")
#define PG8_BAR __builtin_amdgcn_s_barrier()
#define PG8_SCHED __builtin_amdgcn_sched_barrier(0)
    Unit cur, nxt; int ui = 0;
    if (!S.next(0, cur)) return;
    f32x4 acc[2][2][4][2];
#pragma unroll
    for (int a = 0; a < 2; ++a)
#pragma unroll
        for (int b = 0; b < 2; ++b)
#pragma unroll
            for (int m = 0; m < 4; ++m)
#pragma unroll
                for (int n = 0; n < 2; ++n) acc[a][b][m][n] = (f32x4){0.f, 0.f, 0.f, 0.f};
    bf16x8 At[4][2], B0[2][2], B1[2][2];
    const char* cA = (const char*)g.A + (size_t)cur.pm * tstep; const char* cB = (const char*)g.Bt + (size_t)cur.pn * tstep;
    S.a_ready(cur);
    if constexpr (SP2) {
        PG8_STAGE(PG8_SB(0, 0), cB, voffB); PG8_STAGE(PG8_SB(0, 1), cB + hstep, voffB); PG8_STAGE(PG8_SA(0, 0), cA, voffA); PG8_STAGE(PG8_SA(0, 1), cA + hstep, voffA);
        if (wr == 1) PG8_BAR;
        PG8_WAIT_V(2); PG8_BAR;
        PG8_STAGE(PG8_SB(1, 0), cB + kstep, voffB); PG8_STAGE(PG8_SA(1, 0), cA + kstep, voffA); PG8_STAGE(PG8_SB(1, 1), cB + hstep + kstep, voffB);
        PG8_WAIT_V(6); PG8_BAR;
    } else {
        PG8_STAGE(PG8_SB(0, 0), cB, voffB); PG8_STAGE(PG8_SA(0, 0), cA, voffA); PG8_STAGE(PG8_SB(0, 1), cB + hstep, voffB); PG8_STAGE(PG8_SA(0, 1), cA + hstep, voffA);
        if (wr == 1) PG8_BAR;
        PG8_WAIT_V(4); PG8_BAR;
        PG8_STAGE(PG8_SB(1, 0), cB + kstep, voffB); PG8_STAGE(PG8_SA(1, 0), cA + kstep, voffA); PG8_STAGE(PG8_SB(1, 1), cB + hstep + kstep, voffB);
        PG8_WAIT_V(6); PG8_BAR;
    }
    for (;;) {
        const bool has_next = S.next(ui + 1, nxt);
        const char* nA = has_next ? (const char*)g.A + (size_t)nxt.pm * tstep : cA; const char* nB = has_next ? (const char*)g.Bt + (size_t)nxt.pn * tstep : cB;
        for (int t = 0; t < nt; t += 2) {
            const bool last = (t == nt - 2);
            const char* a1 = cA + (size_t)(t + 1) * kstep;
            const char* a2 = last ? nA : cA + (size_t)(t + 2) * kstep; const char* b2 = last ? nB : cB + (size_t)(t + 2) * kstep;
            const char* a3 = a2 + kstep; const char* b3 = b2 + kstep;
            if (last && has_next) S.a_ready(nxt);
            if constexpr (SP2) {
            PG8_LDB(B0, 0, 0); PG8_LDB(B1, 0, 1); PG8_SCHED; PG8_LDA(At, 0, 0); PG8_STAGE(PG8_SA(1, 1), a1 + hstep, voffA);
            PG8_WAIT_V(8); PG8_WAIT_L(0); PG8_BAR; PG8_MMA(0, 0, At, B0); PG8_MMA(0, 1, At, B1); PG8_BAR; PG8_SCHED;
            PG8_LDA(At, 0, 1); PG8_STAGE(PG8_SB(0, 0), b2, voffB); PG8_STAGE(PG8_SB(0, 1), b2 + hstep, voffB); PG8_STAGE(PG8_SA(0, 0), a2, voffA);
            PG8_WAIT_V(8); PG8_WAIT_L(0); PG8_BAR; PG8_MMA(1, 0, At, B0); PG8_MMA(1, 1, At, B1); PG8_BAR; PG8_SCHED;
            PG8_LDB(B0, 1, 0); PG8_LDB(B1, 1, 1); PG8_SCHED; PG8_LDA(At, 1, 0); PG8_STAGE(PG8_SA(0, 1), a2 + hstep, voffA);
            PG8_WAIT_V(8); PG8_WAIT_L(0); PG8_BAR; PG8_MMA(0, 0, At, B0); PG8_MMA(0, 1, At, B1); PG8_BAR; PG8_SCHED;
            PG8_LDA(At, 1, 1); PG8_STAGE(PG8_SB(1, 0), b3, voffB); PG8_STAGE(PG8_SB(1, 1), b3 + hstep, voffB); PG8_STAGE(PG8_SA(1, 0), a3, voffA);
            PG8_WAIT_V(8); PG8_WAIT_L(0); PG8_BAR; PG8_MMA(1, 0, At, B0); PG8_MMA(1, 1, At, B1); PG8_BAR; PG8_SCHED;
            } else {
            PG8_LDB(B0, 0, 0); PG8_SCHED; PG8_LDA(At, 0, 0); PG8_STAGE(PG8_SA(1, 1), a1 + hstep, voffA);
            PG8_WAIT_L(8); PG8_BAR; PG8_WAIT_L(0); PG8_MMA(0, 0, At, B0); PG8_BAR; PG8_SCHED;
            PG8_LDB(B1, 0, 1); PG8_STAGE(PG8_SB(0, 0), b2, voffB);
            PG8_BAR; PG8_WAIT_L(0); PG8_MMA(0, 1, At, B1); PG8_BAR;
            PG8_LDA(At, 0, 1); PG8_STAGE(PG8_SA(0, 0), a2, voffA);
            PG8_BAR; PG8_WAIT_L(0); PG8_MMA(1, 0, At, B0); PG8_BAR; PG8_SCHED;
            PG8_STAGE(PG8_SB(0, 1), b2 + hstep, voffB);
            PG8_WAIT_V(6); PG8_BAR; PG8_MMA(1, 1, At, B1); PG8_BAR;
            PG8_LDB(B0, 1, 0); PG8_SCHED; PG8_LDA(At, 1, 0); PG8_STAGE(PG8_SA(0, 1), a2 + hstep, voffA);
            PG8_WAIT_L(8); PG8_BAR; PG8_WAIT_L(0); PG8_MMA(0, 0, At, B0); PG8_BAR; PG8_SCHED;
            PG8_LDB(B1, 1, 1); PG8_STAGE(PG8_SB(1, 0), b3, voffB);
            PG8_BAR; PG8_WAIT_L(0); PG8_MMA(0, 1, At, B1); PG8_BAR;
            PG8_LDA(At, 1, 1); PG8_STAGE(PG8_SA(1, 0), a3, voffA);
            PG8_BAR; PG8_WAIT_L(0); PG8_MMA(1, 0, At, B0); PG8_BAR; PG8_SCHED;
            PG8_STAGE(PG8_SB(1, 1), b3 + hstep, voffB);
            PG8_WAIT_V(6); PG8_BAR; PG8_MMA(1, 1, At, B1); PG8_BAR;
            }
        }
        if constexpr (ALIGN_EPI) { if (wr == 0) PG8_BAR; }
        if constexpr (!Epi::AFTER_DRAIN) { E(acc, cur, wr, wc, fr, fq); S.done(cur); }
        if (!has_next) break;
#pragma unroll
        for (int a = 0; a < 2; ++a)
#pragma unroll
            for (int b = 0; b < 2; ++b)
#pragma unroll
                for (int m = 0; m < 4; ++m)
#pragma unroll
                    for (int n = 0; n < 2; ++n) acc[a][b][m][n] = (f32x4){0.f, 0.f, 0.f, 0.f};
        cur = nxt; cA = nA; cB = nB; ++ui;
        if constexpr (ALIGN_EPI) { if (wr == 1) PG8_BAR; }
    }
    PG8_WAIT_V(0);
    if constexpr (!ALIGN_EPI) { if (wr == 0) PG8_BAR; }
    PG8_BAR;
    if constexpr (Epi::AFTER_DRAIN) { E.fused(acc, cur, wr, wc, fr, fq, lds, wid, lane); S.done(cur); }
#undef PG8_SA
#undef PG8_SB
#undef PG8_STAGE
#undef PG8_LDA
#undef PG8_LDB
#undef PG8_MMA
#undef PG8_WAIT_V
#undef PG8_WAIT_L
#undef PG8_BAR
#undef PG8_SCHED
}
}
constexpr int BATCH = 2, T = 4096, D = 2048, FF = 5632, DEPTH = 2;
constexpr int M = BATCH * T;
constexpr int DIN = 5912, GW = 512, HD = 128, NH = 4;
constexpr int ZBC = 2560, ZFC = 3584, ZC = ZBC + ZFC;
constexpr int ZB_FQ = 0, ZB_FK = 512, ZB_FV = 1024, ZB_NQ = 1536, ZB_NKS = 2048, ZB_NVS = 2176, ZB_NKW = 2304, ZB_NVW = 2432;
constexpr int ZF_GQ = 0, ZF_GK = 512, ZF_GV = 1024, ZF_GZ = 1536, ZF_LX = 2048, ZF_LG = 2560, ZF_NKC = 3072, ZF_NVC = 3200, ZF_FF = 3328, ZF_GA = 3332, ZF_GB = 3336, ZF_NG = 3340;
constexpr float EPS = 1e-6f;
constexpr int NCMP = 255, NCMPP = 256, NSLC = 64, NSEL = 16, WINDOW = 512, NBT = 791;
constexpr float LOG2E = 1.4426950408889634f;

__host__ __device__ __forceinline__ int zsrc(int zc) {
    if (zc < 1536) return zc;
    if (zc < 2048) return 4620 + (zc - 1536);
    if (zc < 2176) return 5388 + (zc - 2048);
    if (zc < 2304) return 5516 + (zc - 2176);
    if (zc < 2432) return 5644 + (zc - 2304);
    if (zc < 2560) return 5772 + (zc - 2432);
    const int c = zc - 2560;
    if (c < 512) return 1540 + c;
    if (c < 1024) return 2052 + (c - 512);
    if (c < 1536) return 2564 + (c - 1024);
    if (c < 2048) return 3084 + (c - 1536);
    if (c < 2560) return 3596 + (c - 2048);
    if (c < 3072) return 4108 + (c - 2560);
    if (c < 3200) return 5132 + (c - 3072);
    if (c < 3328) return 5260 + (c - 3200);
    if (c < 3332) return 1536 + (c - 3328);
    if (c < 3340) return 3076 + (c - 3332);
    if (c < 3352) return 5900 + (c - 3340);
    return -1;
}

constexpr size_t MiB = 1u << 20;
constexpr size_t WS_CTL = 0, CTL_ZERO_BYTES = 1 * MiB;
constexpr size_t WS_MISC = 1 * MiB;
constexpr size_t WS_W = 2 * MiB, W_LAYER = 164 * MiB;
constexpr size_t WO_GU1 = 0, WO_DN1 = 44 * MiB, WO_WIN = 66 * MiB, WO_WOUT = 90 * MiB, WO_GU2 = 98 * MiB, WO_DN2 = 142 * MiB;
constexpr size_t WS_XN = 330 * MiB;
constexpr size_t WS_ZB = 362 * MiB, WS_ZF = 402 * MiB;
constexpr size_t WS_ACT = 362 * MiB;
constexpr size_t WS_VFT = 514 * MiB, WS_VST = 522 * MiB, WS_VWT = 524 * MiB;
constexpr size_t WS_GPRE = 526 * MiB, GPRE_UNIT = 90112;
constexpr size_t GP_W = 0, GP_QT = 16384, GP_KDT = 32768, GP_QK = 49152, GP_U = 57344;
constexpr size_t WS_OFOX = 570 * MiB, WS_OGDN = 586 * MiB, WS_LA = 602 * MiB, WS_LU = 618 * MiB, WS_ONSA = 634 * MiB;
constexpr size_t WS_SMALL = 650 * MiB;
constexpr size_t SM_CFOX = 0;
constexpr size_t SM_GG = 128 * 1024;
constexpr size_t SM_GBETA = 256 * 1024;
constexpr size_t SM_NG = 384 * 1024;
constexpr size_t SM_KC = 768 * 1024;
constexpr size_t SM_VCT = 896 * 1024;
constexpr size_t SM_EGL = 1024 * 1024;
constexpr size_t WS_LH = 652 * MiB;
constexpr size_t WS_GSN = WS_OGDN, GSN_STEP = 4 * 8192;
constexpr size_t WS_GVN = 668 * MiB, GVN_STEP = 4 * 4096;
constexpr size_t WS_W1T = 692 * MiB;
constexpr size_t WS_END = 676 * MiB;
constexpr size_t PW_FOX = 0, PW_SEL = 32 * MiB, PW_SLOT = 8 * MiB;
constexpr size_t PW_FOXML = 64 * MiB, PW_SELML = 65 * MiB, PW_MLSLOT = 256 * 1024;
constexpr int CW_BAR = 4096, CW_Q = 16384;

constexpr int LDS_BYTES = 160 * 1024;
constexpr int LDS_CTL_OFF = LDS_BYTES - 256;
constexpr int NWAVES = 8, NTHREADS = 512;

#define GAS __attribute__((address_space(1)))
#define LAS __attribute__((address_space(3)))
typedef unsigned short bf16;
typedef unsigned v4u __attribute__((ext_vector_type(4)));
typedef unsigned v2u __attribute__((ext_vector_type(2)));
typedef float f32x4 __attribute__((ext_vector_type(4)));
typedef float f32x16 __attribute__((ext_vector_type(16)));
typedef short bf16x8 __attribute__((ext_vector_type(8)));
#define LDS_WAIT() asm volatile("s_waitcnt lgkmcnt(0)" ::: "memory")
#define VM_WAIT() asm volatile("s_waitcnt vmcnt(0)" ::: "memory")
__device__ __forceinline__ unsigned f2bf(float f) { unsigned u = __builtin_bit_cast(unsigned, f); return (u + 0x7fffu + ((u >> 16) & 1u)) >> 16; }
__device__ __forceinline__ unsigned pk2(float lo, float hi) { return f2bf(lo) | (f2bf(hi) << 16); }
__device__ __forceinline__ float bf2f(unsigned short b) { return __builtin_bit_cast(float, (unsigned)b << 16); }
__device__ __forceinline__ float wave_sum(float v) {
#pragma unroll
    for (int o = 1; o < 64; o <<= 1) v += __shfl_xor(v, o);
    return v;
}
__device__ __forceinline__ float fast_exp(float x) { return __builtin_amdgcn_exp2f(x * LOG2E); }
__device__ __forceinline__ float sigmoid_f(float x) { return __builtin_amdgcn_rcpf(1.0f + fast_exp(-x)); }
__device__ __forceinline__ float silu_ff(float x) { return x * sigmoid_f(x); }
__device__ __forceinline__ float softplus_f(float x) { return x > 20.f ? x : log1pf(expf(x)); }
__device__ __forceinline__ float gelu_tanh_f(float x) { const float u = 0.7978845608028654f * (x + 0.044715f * x * x * x); return 0.5f * x * (1.0f + tanhf(u)); }

#define XB_TMO      128
#define XB_XCNT(j)  (256  + 64 * (j))
#define XB_XSUB(j)  (1280 + 64 * (j))
#define XB_XGEN(j)  (2304 + 64 * (j))
#define XB_TOP      3328
#define XB_TOPGEN   3392
#define XCD_BAR_WORDS 3456
#define XB_SPIN_CAP (1u << 18)

__device__ __forceinline__ unsigned xb_ld(unsigned* p)              { return __hip_atomic_load(p, __ATOMIC_RELAXED, __HIP_MEMORY_SCOPE_AGENT); }
__device__ __forceinline__ unsigned xb_add(unsigned* p, unsigned v) { return __hip_atomic_fetch_add(p, v, __ATOMIC_RELAXED, __HIP_MEMORY_SCOPE_AGENT); }
__device__ __forceinline__ unsigned xb_xcc_id() { return (unsigned)__builtin_amdgcn_s_getreg((3 << 11) | 20) & 0xFu; }
#define XB_SPIN(cond, bar) do { unsigned _sp = 0; while (cond) { __builtin_amdgcn_s_sleep(1); \
    if ((++_sp & 255u) == 0u) { if (xb_ld(&(bar)[XB_TMO])) break; if (_sp > XB_SPIN_CAP) { atomicAdd(&(bar)[XB_TMO], 1u); break; } } } } while (0)

struct XcdBarrier {
    unsigned* bar; unsigned x;
    volatile LAS unsigned* st;
};

__device__ __forceinline__ XcdBarrier xcd_barrier_post(unsigned* bar, volatile LAS unsigned* st) {
    XcdBarrier b; b.bar = bar; b.x = xb_xcc_id(); b.st = st;
    if (threadIdx.x == 0) (void)xb_add(&bar[XB_XCNT(b.x)], 1u);
    return b;
}
__device__ __forceinline__ void xcd_barrier_complete(unsigned* bar, unsigned x, unsigned& nloc, unsigned& nx) {
    const unsigned G = gridDim.x * gridDim.y * gridDim.z;
    unsigned sum, cnt, mine, sp = 0u;
    for (;;) {
        sum = 0u; cnt = 0u; mine = 0u;
#pragma unroll
        for (unsigned j = 0; j < 16; ++j) { const unsigned c = xb_ld(&bar[XB_XCNT(j)]); sum += c; cnt += (c > 0u) ? 1u : 0u; mine = (j == x) ? c : mine; }
        if (sum == G) break;
        __builtin_amdgcn_s_sleep(1);
        if ((++sp & 255u) == 0u) { if (xb_ld(&bar[XB_TMO])) break; if (sp > XB_SPIN_CAP) { atomicAdd(&bar[XB_TMO], 1u); break; } }
    }
    nloc = mine > 0u ? mine : 1u; nx = cnt > 0u ? cnt : 1u;
}

__device__ __forceinline__ void xcd_barrier(const XcdBarrier& b) {
    asm volatile("s_waitcnt vmcnt(0)" ::: "memory");
    __syncthreads();
    if (threadIdx.x == 0) {
        unsigned* bar = b.bar;
        __builtin_amdgcn_s_waitcnt(0);
        unsigned nloc = b.st[0], nx = b.st[1];
        if (nloc == 0u) { xcd_barrier_complete(bar, b.x, nloc, nx); b.st[0] = nloc; b.st[1] = nx; }
        const unsigned old = xb_add(&bar[XB_XSUB(b.x)], 1u);
        const unsigned gen = old / nloc;
        if (old + 1u == (gen + 1u) * nloc) {
            __builtin_amdgcn_fence(__ATOMIC_RELEASE, "agent");
            asm volatile("s_waitcnt vmcnt(0)" ::: "memory");
            const unsigned og = xb_add(&bar[XB_TOP], 1u);
            const unsigned tg = og / nx;
            if (og + 1u == (tg + 1u) * nx) xb_add(&bar[XB_TOPGEN], 1u);
            else XB_SPIN(xb_ld(&bar[XB_TOPGEN]) == tg, bar);
            __builtin_amdgcn_fence(__ATOMIC_ACQUIRE, "agent");
            xb_add(&bar[XB_XGEN(b.x)], 1u);
            asm volatile("s_waitcnt vmcnt(0)" ::: "memory");
        } else {
            XB_SPIN(xb_ld(&bar[XB_XGEN(b.x)]) == gen, bar);
            __builtin_amdgcn_fence(__ATOMIC_ACQUIRE, "agent");
            asm volatile("s_waitcnt vmcnt(0)" ::: "memory");
        }
    }
    __syncthreads();
}
struct Ctx {
    LAS unsigned char* lds;
    unsigned char* ws;
    int tid, lane, wave, G, bid;
};
enum { I_X = 0, I_F1G, I_F1WG, I_F1WU, I_F1WD, I_MIXG, I_WIN, I_BIN, I_GCONV, I_GALOG, I_GDT, I_GNORM, I_LCONVW, I_LCONVB, I_LWA, I_LBA, I_LWX, I_LBX, I_LLAM,
       I_PEK, I_W1K, I_W2K, I_PEV, I_W1V, I_W2V, I_RELB, I_ONG, I_WOUT, I_F2G, I_F2WG, I_F2WU, I_F2WD, I_FING, N_IN };
__device__ __forceinline__ float* hptr() {
    float* p; asm volatile("s_load_dwordx2 %0, %1, %2\n\ts_waitcnt lgkmcnt(0)" : "=s"(p) : "s"(__builtin_amdgcn_kernarg_segment_ptr()), "n"(N_IN * 8));
    return p;
}
template <int I> __device__ __forceinline__ const float* inp() {
    const float* p; asm volatile("s_load_dwordx2 %0, %1, %2\n\ts_waitcnt lgkmcnt(0)" : "=s"(p) : "s"(__builtin_amdgcn_kernarg_segment_ptr()), "n"(I * 8));
    return p;
}

__device__ __forceinline__ void refresh_ids(Ctx& C) {
    int l; asm volatile("v_mbcnt_lo_u32_b32 %0, -1, 0\n\tv_mbcnt_hi_u32_b32 %0, -1, %0" : "=v"(l));
    C.lane = l; C.tid = C.wave * 64 + l;
}
__device__ __forceinline__ int queue_pull(Ctx& C, int qi) {
    refresh_ids(C);
    volatile LAS int* slot = (volatile LAS int*)(C.lds + LDS_CTL_OFF + 16);
    __syncthreads();
    if (C.tid == 0) *slot = (int)__hip_atomic_fetch_add((unsigned*)C.ws + CW_Q + 64 * qi, 1u, __ATOMIC_RELAXED, __HIP_MEMORY_SCOPE_AGENT);
    __syncthreads();
    return *slot;
}

struct TItem { const float* colp; int ldn; bf16* WT; int K, n0, k0; };
__device__ __forceinline__ void titem_load(const TItem& t, const int lane, f32x4 (&v)[8]) {
    const int kr = lane >> 3;
#pragma unroll
    for (int i = 0; i < 8; ++i) v[i] = t.colp ? *(const GAS f32x4*)(t.colp + (size_t)(t.k0 + 8 * i + kr) * t.ldn) : (f32x4){0.f, 0.f, 0.f, 0.f};
}
__device__ __forceinline__ void titem_store(const TItem& t, const int lane, const f32x4 (&v)[8], LAS float* scr) {
    const int n4 = lane & 7, kr = lane >> 3;
#pragma unroll
    for (int i = 0; i < 8; ++i) { LAS float* d = scr + (8 * i + kr) * 33 + 4 * n4; d[0] = v[i].x; d[1] = v[i].y; d[2] = v[i].z; d[3] = v[i].w; }
    LDS_WAIT(); asm volatile("" ::: "memory");
    const int c = lane & 7;
#pragma unroll
    for (int j = 0; j < 4; ++j) { const int n = (lane >> 3) + 8 * j; const LAS float* s = scr + (8 * c) * 33 + n;
        v4u o; o.x = pk2(s[0 * 33], s[1 * 33]); o.y = pk2(s[2 * 33], s[3 * 33]); o.z = pk2(s[4 * 33], s[5 * 33]); o.w = pk2(s[6 * 33], s[7 * 33]);
        *(GAS v4u*)(t.WT + (size_t)(t.n0 + n) * t.K + t.k0 + 8 * c) = o; }
    LDS_WAIT(); asm volatile("" ::: "memory");
}
__device__ __forceinline__ void rms_row_bf16(const float* xrow, const float* g, bf16* orow, float* hcopy, int lane) {
    const GAS f32x4* xr = (const GAS f32x4*)xrow + lane;
    f32x4 v[8]; float s = 0.f;
#pragma unroll
    for (int j = 0; j < 8; ++j) { v[j] = xr[64 * j]; s += (v[j].x * v[j].x + v[j].y * v[j].y) + (v[j].z * v[j].z + v[j].w * v[j].w); }
    const float rstd = 1.0f / sqrtf(wave_sum(s) * (1.f / D) + EPS);
    if (hcopy) { GAS f32x4* hc = (GAS f32x4*)hcopy + lane;
#pragma unroll
        for (int j = 0; j < 8; ++j) hc[64 * j] = v[j]; }
    GAS v2u* o8 = (GAS v2u*)orow + lane;
#pragma unroll
    for (int j = 0; j < 8; ++j) { const f32x4 gg = ((const GAS f32x4*)g)[lane + 64 * j]; v2u w; w.x = pk2(v[j].x * rstd * gg.x, v[j].y * rstd * gg.y); w.y = pk2(v[j].z * rstd * gg.z, v[j].w * rstd * gg.w); o8[64 * j] = w; }
}
__device__ __forceinline__ void rms_row_f32(const float* xrow, const float* g, float* orow, int lane) {
    const GAS f32x4* xr = (const GAS f32x4*)xrow + lane;
    f32x4 v[8]; float s = 0.f;
#pragma unroll
    for (int j = 0; j < 8; ++j) { v[j] = xr[64 * j]; s += (v[j].x * v[j].x + v[j].y * v[j].y) + (v[j].z * v[j].z + v[j].w * v[j].w); }
    const float rstd = 1.0f / sqrtf(wave_sum(s) * (1.f / D) + EPS);
    GAS f32x4* o = (GAS f32x4*)orow + lane;
#pragma unroll
    for (int j = 0; j < 8; ++j) { const f32x4 gg = ((const GAS f32x4*)g)[lane + 64 * j]; o[64 * j] = v[j] * rstd * gg; }
}
__device__ __forceinline__ void norm_phase_bf16(Ctx& C, const float* g) {
    refresh_ids(C);
    bf16* XN = (bf16*)(C.ws + WS_XN);
    float* const hp = hptr();
    for (int m = C.bid * NWAVES + C.wave; m < M; m += C.G * NWAVES) rms_row_bf16(hp + (size_t)m * D, g, XN + (size_t)m * D, nullptr, C.lane);
}

__device__ __forceinline__ int t5_bucket(int n) {
    if (n < 16) return n;
    int b = 16;
    b += (n >= 21); b += (n >= 27); b += (n >= 35); b += (n >= 46); b += (n >= 59); b += (n >= 77); b += (n >= 99); b += (n >= 128);
    b += (n >= 166); b += (n >= 216); b += (n >= 280); b += (n >= 363); b += (n >= 470); b += (n >= 609); b += (n >= 790);
    return b;
}

template <bool WITH_X = true>
__device__ __forceinline__ void prologue_phase(Ctx& C) {
    refresh_ids(C);
    LAS float* scr = (LAS float*)(C.lds + C.wave * 16384);
    const int gw = C.bid * NWAVES + C.wave, NGW = C.G * NWAVES;
    constexpr int I_GU = 32 * 352, I_DN = 88 * 64, I_WI = 32 * 192, I_WO = 32 * 64;
    constexpr int PER_LAYER = 2 * I_GU + 2 * I_DN + I_WI + I_WO, N_MAIN = DEPTH * PER_LAYER, N_ALL = N_MAIN + DEPTH * 2 * 256;
    const int c4 = 4 * (C.lane & 7);
    auto decode = [&](const int it, TItem& t) {
        if (it >= N_MAIN) { const int q = it - N_MAIN, lk = q >> 8, r = q & 255, nb = r & 3, kb = r >> 2, l = lk >> 1;
            const float* w = ((lk & 1) ? inp<I_W1V>() : inp<I_W1K>()) + (size_t)l * 4096 * 128;
            t = TItem{w + nb * 32 + c4, 128, (bf16*)(C.ws + WS_W1T) + (size_t)lk * 128 * 4096, 4096, nb * 32, kb * 64}; return; }
        const int l = it / PER_LAYER; int r = it % PER_LAYER;
        unsigned char* wl = C.ws + WS_W + (size_t)l * W_LAYER;
        int ffn = -1;
        if (r < I_GU) ffn = 0; else { r -= I_GU;
        if (r < I_DN) ffn = 2; else { r -= I_DN;
        if (r < I_WI) ffn = 4; else { r -= I_WI;
        if (r < I_WO) ffn = 5; else { r -= I_WO;
        if (r < I_GU) ffn = 1; else { r -= I_GU; ffn = 3; } } } } }
        if (ffn <= 1) {
            const int nb = r % 352, kb = r / 352, n0 = nb * 32, j = n0 / 256, rr = n0 % 256;
            const float* wg = (ffn == 0 ? inp<I_F1WG>() : inp<I_F2WG>()) + (size_t)l * D * FF; const float* wu = (ffn == 0 ? inp<I_F1WU>() : inp<I_F2WU>()) + (size_t)l * D * FF;
            t = TItem{(rr < 128 ? wg + 128 * j + rr : wu + 128 * j + rr - 128) + c4, FF, (bf16*)(wl + (ffn == 0 ? WO_GU1 : WO_GU2)), D, n0, kb * 64};
        } else if (ffn <= 3) {
            const int nb = r % 64, kb = r / 64;
            const float* w = (ffn == 2 ? inp<I_F1WD>() : inp<I_F2WD>()) + (size_t)l * FF * D;
            t = TItem{w + nb * 32 + c4, D, (bf16*)(wl + (ffn == 2 ? WO_DN1 : WO_DN2)), FF, nb * 32, kb * 64};
        } else if (ffn == 4) {
            const int nb = r % 192, kb = r / 192;
            const int sc = zsrc(nb * 32 + c4);
            const float* w = inp<I_WIN>() + (size_t)l * D * DIN;
            t = TItem{sc >= 0 ? w + sc : nullptr, DIN, (bf16*)(wl + WO_WIN), D, nb * 32, kb * 64};
        } else {
            const int nb = r % 64, kb = r / 64;
            const float* w = inp<I_WOUT>() + (size_t)l * D * D;
            t = TItem{w + nb * 32 + c4, D, (bf16*)(wl + WO_WOUT), D, nb * 32, kb * 64};
        }
    };
    if (gw < N_ALL) {
        TItem cur, nxt; f32x4 va[8], vb[8];
        decode(gw, cur); titem_load(cur, C.lane, va);
        for (int it = gw; it < N_ALL; it += NGW) {
            const bool has = it + NGW < N_ALL;
            if (has) { decode(it + NGW, nxt); titem_load(nxt, C.lane, vb); }
            titem_store(cur, C.lane, va, scr);
            if (has) { cur = nxt;
#pragma unroll
                for (int i = 0; i < 8; ++i) va[i] = vb[i]; }
        }
    }
    float* bz = (float*)(C.ws + WS_MISC);
    for (int i = C.bid * NTHREADS + C.tid; i < DEPTH * ZC; i += C.G * NTHREADS) { const int l = i / ZC, zc = i % ZC, sc = zsrc(zc); bz[i] = sc >= 0 ? inp<I_BIN>()[l * DIN + sc] : 0.f; }
    float* tb = (float*)(C.ws + WS_MISC + 65536);
    for (int i = C.bid * NTHREADS + C.tid; i < NH * NBT; i += C.G * NTHREADS) { const int hh = i / NBT, d = i % NBT; tb[i] = inp<I_RELB>()[t5_bucket(d) * NH + hh] * LOG2E; }
    if (!WITH_X) return;
    bf16* XN = (bf16*)(C.ws + WS_XN);
    float* const hp = hptr();
    for (int m = gw; m < M; m += NGW) rms_row_bf16(inp<I_X>() + (size_t)m * D, inp<I_F1G>(), XN + (size_t)m * D, hp + (size_t)m * D, C.lane);
}
typedef float f32x4v __attribute__((ext_vector_type(4)));
__device__ __forceinline__ f32x4 mfma16(bf16x8 a, bf16x8 b, f32x4 c) { return __builtin_amdgcn_mfma_f32_16x16x32_bf16(a, b, c, 0, 0, 0); }

__device__ __forceinline__ void gdn_pre_job(Ctx& C, const int l, const int job) {
    const int ch = job & 63, h = (job >> 6) & 3, b = job >> 8, t0 = ch * 64;
    const size_t row0 = (size_t)b * T + t0;
    const float* zf = (const float*)(C.ws + WS_ZF);
    unsigned char* gp = C.ws + WS_GPRE + (size_t)job * GPRE_UNIT;
    LAS float* XQ = (LAS float*)C.lds;
    LAS float* XK = XQ + 64 * 132;
    LAS float* XV = XK + 64 * 132;
    LAS bf16* KN = (LAS bf16*)(XV + 64 * 132);
    LAS bf16* KBt = KN + 64 * 136;
    LAS bf16* QN = KBt + 64 * 136;
    LAS float* SMg = (LAS float*)(QN + 64 * 136);
    LAS float* AM = XQ;
    const int tid = C.tid, lane = C.lane, wave = C.wave;
    const float* cw = inp<I_GCONV>() + (size_t)l * 4 * 1536;
    if (tid < 480) {
        const int c4 = tid % 96, chk = tid / 96, r0 = 13 * chk, col = c4 * 4, which = col >> 7, d = col & 127, cc = which * 512 + h * 128 + d;
        f32x4 wv[4], zr[16];
#pragma unroll
        for (int j = 0; j < 4; ++j) wv[j] = *(const GAS f32x4*)(cw + j * 1536 + cc);
#pragma unroll
        for (int i = 0; i < 16; ++i) { const int tq = t0 + r0 - 3 + i;
            zr[i] = (tq >= 0 && r0 - 3 + i < 64) ? *(const GAS f32x4*)(zf + ((size_t)b * T + tq) * ZFC + cc) : (f32x4){0.f, 0.f, 0.f, 0.f}; }
        LAS float* dstb = (which == 0 ? XQ : which == 1 ? XK : XV) + d;
#pragma unroll
        for (int i = 0; i < 13; ++i) { const int tt = r0 + i;
            if (tt < 64) { const f32x4 acc = zr[i] * wv[0] + zr[i + 1] * wv[1] + zr[i + 2] * wv[2] + zr[i + 3] * wv[3];
                f32x4 o; o.x = silu_ff(acc.x); o.y = silu_ff(acc.y); o.z = silu_ff(acc.z); o.w = silu_ff(acc.w);
                *(LAS f32x4*)(dstb + tt * 132) = o; } }
    }
    if (wave == 0) {
        const float ga = zf[(row0 + lane) * ZFC + ZF_GA + h], gb = zf[(row0 + lane) * ZFC + ZF_GB + h];
        const float g = -expf(inp<I_GALOG>()[l * 4 + h]) * softplus_f(ga + inp<I_GDT>()[l * 4 + h]);
        float gc = g;
#pragma unroll
        for (int o = 1; o < 64; o <<= 1) { const float v = __shfl_up(gc, o); if (lane >= o) gc += v; }
        const float gl = __shfl(gc, 63);
        SMg[lane] = gc; SMg[64 + lane] = sigmoid_f(gb); SMg[128 + lane] = expf(gc); SMg[192 + lane] = expf(gl - gc);
        if (lane == 0) ((float*)(C.ws + WS_SMALL + SM_EGL))[job] = expf(gl);
    }
    __syncthreads();
    for (int r = wave * 8; r < wave * 8 + 8; ++r) {
        const float q0 = XQ[r * 132 + lane], q1 = XQ[r * 132 + 64 + lane], k0 = XK[r * 132 + lane], k1 = XK[r * 132 + 64 + lane];
        const float sq = wave_sum(q0 * q0 + q1 * q1), sk = wave_sum(k0 * k0 + k1 * k1);
        if (lane == 0) { SMg[256 + r] = 1.0f / sqrtf(sq + EPS); SMg[320 + r] = 1.0f / sqrtf(sk + EPS); }
    }
    __syncthreads();
    const float qscale = 0.08838834764831845f;
    for (int idx = tid; idx < 1024; idx += NTHREADS) {
        const int tt = idx >> 4, d0 = (idx & 15) * 8;
        const float rq = SMg[256 + tt] * qscale, rk = SMg[320 + tt], be = SMg[64 + tt], eg = SMg[128 + tt];
        const f32x4 qa = *(LAS f32x4*)(XQ + tt * 132 + d0), qb = *(LAS f32x4*)(XQ + tt * 132 + d0 + 4), ka = *(LAS f32x4*)(XK + tt * 132 + d0), kb = *(LAS f32x4*)(XK + tt * 132 + d0 + 4);
        v4u w;
        w.x = pk2(ka.x * rk, ka.y * rk); w.y = pk2(ka.z * rk, ka.w * rk); w.z = pk2(kb.x * rk, kb.y * rk); w.w = pk2(kb.z * rk, kb.w * rk);
        *(LAS v4u*)(KN + tt * 136 + d0) = w;
        const float rkb = rk * be;
        w.x = pk2(ka.x * rkb, ka.y * rkb); w.y = pk2(ka.z * rkb, ka.w * rkb); w.z = pk2(kb.x * rkb, kb.y * rkb); w.w = pk2(kb.z * rkb, kb.w * rkb);
        *(LAS v4u*)(KBt + tt * 136 + d0) = w;
        w.x = pk2(qa.x * rq, qa.y * rq); w.y = pk2(qa.z * rq, qa.w * rq); w.z = pk2(qb.x * rq, qb.y * rq); w.w = pk2(qb.z * rq, qb.w * rq);
        *(LAS v4u*)(QN + tt * 136 + d0) = w;
        const float rqe = rq * eg;
        w.x = pk2(qa.x * rqe, qa.y * rqe); w.y = pk2(qa.z * rqe, qa.w * rqe); w.z = pk2(qb.x * rqe, qb.y * rqe); w.w = pk2(qb.z * rqe, qb.w * rqe);
        *(GAS v4u*)(gp + GP_QT + (size_t)(tt * 128 + d0) * 2) = w;
    }
    for (int idx = tid; idx < 1024; idx += NTHREADS) {
        const int d = idx & 127, tg = (idx >> 7) * 8;
        float v[8];
#pragma unroll
        for (int i = 0; i < 8; ++i) v[i] = XK[(tg + i) * 132 + d] * SMg[320 + tg + i] * SMg[192 + tg + i];
        v4u w; w.x = pk2(v[0], v[1]); w.y = pk2(v[2], v[3]); w.z = pk2(v[4], v[5]); w.w = pk2(v[6], v[7]);
        *(GAS v4u*)(gp + GP_KDT + (size_t)(d * 64 + tg) * 2) = w;
    }
    __syncthreads();
    for (int jj = wave; jj < 26; jj += NWAVES) {
        bf16* qkout = (bf16*)(gp + GP_QK);
        const int fr = lane & 15, fq = lane >> 4;
        if (jj >= 20) {
            const int z = jj - 20, ti = z < 3 ? 0 : (z < 5 ? 1 : 2), tj = z < 3 ? z + 1 : (z < 5 ? z - 1 : 3);
#pragma unroll
            for (int r = 0; r < 4; ++r) qkout[(16 * ti + 4 * fq + r) * 64 + 16 * tj + fr] = 0;
            continue;
        }
        const int which = jj / 10, tix = jj % 10;
        const int ti = tix < 1 ? 0 : (tix < 3 ? 1 : (tix < 6 ? 2 : 3)), tj = tix - (ti * (ti + 1)) / 2;
        const LAS bf16* Ap = (which == 0 ? KBt : QN) + (16 * ti + fr) * 136 + 8 * fq;
        const LAS bf16* Bp = KN + (16 * tj + fr) * 136 + 8 * fq;
        f32x4 acc = {0.f, 0.f, 0.f, 0.f};
#pragma unroll
        for (int kk = 0; kk < 4; ++kk) acc = mfma16(*(const LAS bf16x8*)(Ap + 32 * kk), *(const LAS bf16x8*)(Bp + 32 * kk), acc);
        const int j = 16 * tj + fr; const float gcj = SMg[j];
#pragma unroll
        for (int r = 0; r < 4; ++r) { const int i = 16 * ti + 4 * fq + r; const float dec = expf(SMg[i] - gcj);
            if (which == 0) AM[i * 68 + j] = (i > j) ? acc[r] * dec : 0.f;
            else qkout[i * 64 + j] = (bf16)f2bf((i >= j) ? acc[r] * dec : 0.f); }
    }
    __syncthreads();
    if (wave < 4) {
        const int c = wave * 64 + lane, d = c & 127; const bool isW = c >= 128;
        int vzero; asm volatile("v_mov_b32 %0, 0" : "=v"(vzero));
        const LAS float* AMv = AM + vzero; const LAS float* SMv = SMg + vzero;
        float X[64];
#pragma unroll
        for (int i = 0; i < 64; ++i) X[i] = isW ? XK[i * 132 + d] * SMv[320 + i] * SMv[64 + i] * SMv[128 + i] : XV[i * 132 + d] * SMv[64 + i];
#pragma unroll
        for (int i = 1; i < 64; ++i) {
            float s = X[i];
#pragma unroll
            for (int j4 = 0; j4 < (i + 3) / 4; ++j4) { const f32x4 a = *(const LAS f32x4*)(AMv + i * 68 + 4 * j4);
                if (4 * j4 + 0 < i) s -= a.x * X[4 * j4 + 0];
                if (4 * j4 + 1 < i) s -= a.y * X[4 * j4 + 1];
                if (4 * j4 + 2 < i) s -= a.z * X[4 * j4 + 2];
                if (4 * j4 + 3 < i) s -= a.w * X[4 * j4 + 3]; }
            X[i] = s;
        }
        if (isW) { bf16* Wo = (bf16*)(gp + GP_W);
#pragma unroll
            for (int i = 0; i < 64; ++i) Wo[i * 128 + d] = (bf16)f2bf(X[i]); }
        else { float* Uo = (float*)(gp + GP_U);
#pragma unroll
            for (int i = 0; i < 64; ++i) Uo[i * 128 + d] = X[i]; }
    }
}

__device__ __forceinline__ void nsa_compress_job(Ctx& C, const int l, const int job) {
    const int rg = job & 15, b = (job >> 4) & 1, kv = job >> 5, n0 = rg * 16, lk = l * 2 + kv;
    const float* zf = (const float*)(C.ws + WS_ZF) + (kv ? ZF_NVC : ZF_NKC);
    const bf16* w1t = (const bf16*)(C.ws + WS_W1T) + (size_t)lk * 128 * 4096;
    const float* w2 = (kv ? inp<I_W2V>() : inp<I_W2K>()) + (size_t)l * 128 * 128;
    const float* pe = (kv ? inp<I_PEV>() : inp<I_PEK>()) + (size_t)l * 4096;
    LAS bf16* XS = (LAS bf16*)C.lds;
    LAS float* RED = (LAS float*)(C.lds + 75776);
    LAS float* HID = (LAS float*)(C.lds + 75776 + 65536);
    LAS bf16* PEs = (LAS bf16*)(C.lds + 75776 + 65536 + 8192);
    const int tid = C.tid, lane = C.lane, wave = C.wave, fr = lane & 15, fq = lane >> 4;
    {
        f32x4 v[17];
#pragma unroll
        for (int i = 0; i < 17; ++i) { const int idx = tid + NTHREADS * i, tk = idx >> 5, d4 = (idx & 31) * 4, t = 16 * n0 + tk;
            v[i] = (t < T) ? *(const GAS f32x4*)(zf + ((size_t)b * T + t) * ZFC + d4) : (f32x4){0.f, 0.f, 0.f, 0.f}; }
#pragma unroll
        for (int i = 0; i < 17; ++i) { const int idx = tid + NTHREADS * i, tk = idx >> 5, d4 = (idx & 31) * 4;
            v2u w; w.x = pk2(v[i].x, v[i].y); w.y = pk2(v[i].z, v[i].w); *(LAS v2u*)(XS + tk * 136 + d4) = w; }
#pragma unroll
        for (int i = 0; i < 2; ++i) { const int idx = tid + NTHREADS * i; const f32x4 q = *(const GAS f32x4*)(pe + idx * 4);
            v2u w; w.x = pk2(q.x, q.y); w.y = pk2(q.z, q.w); *(LAS v2u*)(PEs + idx * 4) = w; }
    }
    __syncthreads();
    f32x4 acc[8];
#pragma unroll
    for (int nt = 0; nt < 8; ++nt) acc[nt] = (f32x4){0.f, 0.f, 0.f, 0.f};
#pragma unroll 2
    for (int s = 0; s < 16; ++s) { const int ks = 16 * wave + s, i = ks >> 2, d0 = (ks & 3) * 32;
        const bf16x8 a = *(const LAS bf16x8*)(XS + (16 * fr + i) * 136 + d0 + 8 * fq);
        const bf16x8 ap = *(const LAS bf16x8*)(PEs + i * 128 + d0 + 8 * fq);
        bf16x8 bfr[8];
#pragma unroll
        for (int nt = 0; nt < 8; ++nt) bfr[nt] = *(const GAS bf16x8*)(w1t + (size_t)(16 * nt + fr) * 4096 + 32 * ks + 8 * fq);
#pragma unroll
        for (int nt = 0; nt < 8; ++nt) { acc[nt] = mfma16(a, bfr[nt], acc[nt]); acc[nt] = mfma16(ap, bfr[nt], acc[nt]); } }
#pragma unroll
    for (int nt = 0; nt < 8; ++nt)
#pragma unroll
        for (int r = 0; r < 4; ++r) RED[(wave * 16 + 4 * fq + r) * 128 + 16 * nt + fr] = acc[nt][r];
    __syncthreads();
    for (int idx = tid; idx < 16 * 128; idx += NTHREADS) { float s = 0.f;
#pragma unroll
        for (int w = 0; w < 8; ++w) s += RED[w * 2048 + idx];
        HID[idx] = gelu_tanh_f(s); }
    __syncthreads();
    {
        const int c = tid & 127, r0 = (tid >> 7) * 4; float o[4] = {0.f, 0.f, 0.f, 0.f};
#pragma unroll 4
        for (int cc = 0; cc < 128; ++cc) { const float w = w2[cc * 128 + c];
#pragma unroll
            for (int r = 0; r < 4; ++r) o[r] += HID[(r0 + r) * 128 + cc] * w; }
#pragma unroll
        for (int r = 0; r < 4; ++r) { const int n = n0 + r0 + r; const float v = n < NCMP ? o[r] : 0.f;
            if (kv == 0) ((bf16*)(C.ws + WS_SMALL + SM_KC) + (size_t)b * NCMPP * 128)[n * 128 + c] = (bf16)f2bf(v);
            else ((bf16*)(C.ws + WS_SMALL + SM_VCT) + (size_t)b * 128 * NCMPP)[c * NCMPP + n] = (bf16)f2bf(v); }
    }
}

__device__ __forceinline__ void lru_gate_job(Ctx& C, const int l, const int job) {
    const int wave = C.wave, lane = C.lane, cbase = wave * 64, ch = cbase + lane;
    const size_t rowb = (size_t)job * 32; const int tpos = (int)(rowb % T);
    const float* zf = (const float*)(C.ws + WS_ZF) + ZF_LX + ch;
    LAS float* XS = (LAS float*)C.lds + wave * 2048;
    const float* cw = inp<I_LCONVW>() + (size_t)l * 4 * 512 + ch; const float cb = inp<I_LCONVB>()[l * 512 + ch];
    const float w0 = cw[0], w1 = cw[512], w2 = cw[1024], w3 = cw[1536];
    float xc[32];
    float zm3 = tpos >= 3 ? zf[(rowb - 3) * ZFC] : 0.f, zm2 = tpos >= 2 ? zf[(rowb - 2) * ZFC] : 0.f, zm1 = tpos >= 1 ? zf[(rowb - 1) * ZFC] : 0.f;
#pragma unroll
    for (int tt = 0; tt < 32; ++tt) { const float z0 = zf[(rowb + tt) * ZFC]; xc[tt] = w0 * zm3 + w1 * zm2 + w2 * zm1 + w3 * z0 + cb; zm3 = zm2; zm2 = zm1; zm1 = z0; }
#pragma unroll
    for (int t4 = 0; t4 < 8; ++t4) *(LAS f32x4*)(XS + lane * 32 + 4 * t4) = (f32x4){xc[4 * t4], xc[4 * t4 + 1], xc[4 * t4 + 2], xc[4 * t4 + 3]};
    LDS_WAIT(); asm volatile("" ::: "memory");
    float aA[32], aX[32];
#pragma unroll
    for (int tt = 0; tt < 32; ++tt) { aA[tt] = 0.f; aX[tt] = 0.f; }
    const float* wa = inp<I_LWA>() + ((size_t)l * 8 + wave) * 4096 + lane; const float* wx = inp<I_LWX>() + ((size_t)l * 8 + wave) * 4096 + lane;
#pragma unroll 8
    for (int d = 0; d < 64; ++d) { const float va = wa[d * 64], vx = wx[d * 64];
#pragma unroll
        for (int t4 = 0; t4 < 8; ++t4) { const f32x4 x = *(const LAS f32x4*)(XS + d * 32 + 4 * t4);
            aA[4 * t4] += x.x * va; aA[4 * t4 + 1] += x.y * va; aA[4 * t4 + 2] += x.z * va; aA[4 * t4 + 3] += x.w * va;
            aX[4 * t4] += x.x * vx; aX[4 * t4 + 1] += x.y * vx; aX[4 * t4 + 2] += x.z * vx; aX[4 * t4 + 3] += x.w * vx; } }
    const float ba = inp<I_LBA>()[l * 512 + ch], bx = inp<I_LBX>()[l * 512 + ch], spl = softplus_f(-inp<I_LLAM>()[l * 512 + ch]);
    float* LA = (float*)(C.ws + WS_LA) + ch; float* LU = (float*)(C.ws + WS_LU) + ch;
#pragma unroll
    for (int tt = 0; tt < 32; ++tt) { const float r = sigmoid_f(aA[tt] + ba), ig = sigmoid_f(aX[tt] + bx), la = -8.0f * r * spl;
        LA[(rowb + tt) * 512] = expf(la); LU[(rowb + tt) * 512] = sqrtf(-expm1f(2.0f * la)) * (ig * xc[tt]); }
    LDS_WAIT();
}

__device__ __forceinline__ void vtrans_job(Ctx& C, const int job) {
    const size_t rowb = (size_t)job * 64; const int b = (int)(rowb / T), t0 = (int)(rowb % T);
    const bf16* zb = (const bf16*)(C.ws + WS_ZB);
    LAS bf16* TL = (LAS bf16*)C.lds;
    {   v4u tmp[12];
#pragma unroll
        for (int i = 0; i < 12; ++i) { const int idx = C.tid + NTHREADS * i, tt = idx / 96, c8 = (idx % 96) * 8;
            const int sc = c8 < 512 ? ZB_FV + c8 : (c8 < 640 ? ZB_NVS + (c8 - 512) : ZB_NVW + (c8 - 640));
            tmp[i] = *(const GAS v4u*)(zb + (rowb + tt) * ZBC + sc); }
#pragma unroll
        for (int i = 0; i < 12; ++i) { const int idx = C.tid + NTHREADS * i, tt = idx / 96, c8 = (idx % 96) * 8; *(LAS v4u*)(TL + tt * 776 + c8) = tmp[i]; }
    }
    __syncthreads();
    for (int idx = C.tid; idx < 768 * 8; idx += NTHREADS) { const int c = idx % 768, tg = (idx / 768) * 8;
        unsigned short v[8];
#pragma unroll
        for (int i = 0; i < 8; ++i) v[i] = TL[(tg + i) * 776 + c];
        v4u w; w.x = v[0] | ((unsigned)v[1] << 16); w.y = v[2] | ((unsigned)v[3] << 16); w.z = v[4] | ((unsigned)v[5] << 16); w.w = v[6] | ((unsigned)v[7] << 16);
        bf16* dst = c < 512 ? (bf16*)(C.ws + WS_VFT) + ((size_t)(b * 4 + (c >> 7)) * 128 + (c & 127)) * T
                  : (c < 640 ? (bf16*)(C.ws + WS_VST) + ((size_t)b * 128 + (c - 512)) * T : (bf16*)(C.ws + WS_VWT) + ((size_t)b * 128 + (c - 640)) * T);
        *(GAS v4u*)(dst + t0 + tg) = w; }
}

__device__ __forceinline__ void fox_cumsum_job(Ctx& C, const int job) {
    const int b = job >> 2, h = job & 3;
    const float* zf = (const float*)(C.ws + WS_ZF) + ZF_FF + h;
    float* cf = (float*)(C.ws + WS_SMALL + SM_CFOX) + (size_t)job * T;
    LAS double* WS8 = (LAS double*)C.lds;
    double v[8], run = 0.0;
#pragma unroll
    for (int i = 0; i < 8; ++i) { const float x = zf[((size_t)b * T + C.tid * 8 + i) * ZFC]; const float ls = fminf(x, 0.f) - log1pf(expf(-fabsf(x))); run += (double)ls; v[i] = run; }
    double sc = run;
#pragma unroll
    for (int o = 1; o < 64; o <<= 1) { const double u = __shfl_up(sc, o); if (C.lane >= o) sc += u; }
    if (C.lane == 63) WS8[C.wave] = sc;
    __syncthreads();
    double off = sc - run;
    for (int w = 0; w < C.wave; ++w) off += WS8[w];
#pragma unroll
    for (int i = 0; i < 8; ++i) cf[C.tid * 8 + i] = (float)((off + v[i]) * 1.4426950408889634);
}

#define QUEUE_LOOP(qi, njobs, call) for (;;) { const int j = queue_pull(C, (qi)); if (j >= (njobs)) break; call; }
__device__ __forceinline__ void pre_phase(Ctx& C, const int l, const int qoff) {
    const int q0 = 16 * l + qoff;
    QUEUE_LOOP(q0 + 0, 64, nsa_compress_job(C, l, j));
    QUEUE_LOOP(q0 + 1, 512, gdn_pre_job(C, l, j));
    QUEUE_LOOP(q0 + 2, 256, lru_gate_job(C, l, j));
    QUEUE_LOOP(q0 + 3, 128, vtrans_job(C, j));
    QUEUE_LOOP(q0 + 4, 8, fox_cumsum_job(C, j));
}
__device__ __forceinline__ f32x16 mfma32(bf16x8 a, bf16x8 b, f32x16 c) { return __builtin_amdgcn_mfma_f32_32x32x16_bf16(a, b, c, 0, 0, 0); }
__device__ __forceinline__ bf16x8 pack8(float a0, float a1, float a2, float a3, float a4, float a5, float a6, float a7) {
    v4u w; w.x = pg8::cvt_pk_bf16(a0, a1); w.y = pg8::cvt_pk_bf16(a2, a3); w.z = pg8::cvt_pk_bf16(a4, a5); w.w = pg8::cvt_pk_bf16(a6, a7);
    return __builtin_bit_cast(bf16x8, w);
}
constexpr int AT_KT = 0, AT_VT = 32768, AT_CT = 65536, AT_BT = 66048, AT_SEL = 78720, AT_Q = 79360;
constexpr int AT_IMP = 0;
constexpr float SC_LOG2 = 0.1275174326f;
enum { MODE_FOX = 0, MODE_CMP = 1, MODE_SEL = 2, MODE_WIN = 3 };

struct TileSrc { const bf16* K; int ldk; const bf16* VT; int ldv; };
struct LaneOff { unsigned gk[2], gv[2]; unsigned krow, kc[8], vrow, vc[2][2]; };
__device__ __forceinline__ void lane_offsets(const TileSrc& s, const int wave, const int lane, LaneOff& o) {
#pragma unroll
    for (int i = 0; i < 2; ++i) { const int p = 2 * wave + i;
        { const int row = 4 * p + (lane >> 4), c = (lane & 15) ^ (row & 15); o.gk[i] = (unsigned)((row * s.ldk + c * 8) * 2); }
        { const int d = 8 * p + (lane >> 3), c = (lane & 7) ^ ((d >> 1) & 7); o.gv[i] = (unsigned)((d * s.ldv + c * 8) * 2); } }
    const int r32 = lane & 31, hi = lane >> 5, prow = (r32 & 19) | ((r32 & 4) << 1) | ((r32 & 8) >> 1);
    o.krow = (unsigned)(prow * 256);
#pragma unroll
    for (int c = 0; c < 8; ++c) o.kc[c] = (unsigned)(((2 * c + hi) ^ (prow & 15)) * 16);
    o.vrow = (unsigned)(r32 * 128);
#pragma unroll
    for (int kb = 0; kb < 2; ++kb)
#pragma unroll
        for (int cc = 0; cc < 2; ++cc) o.vc[kb][cc] = (unsigned)(((4 * kb + 2 * cc + hi) ^ ((r32 >> 1) & 7)) * 16);
}
template <int MODE>
__device__ __forceinline__ void dma_tile(LAS unsigned char* lds, const TileSrc& s, const LaneOff& o, const int k0, const int buf, const int wave, const int lane, const float* cfrow) {
    const char* kb = (const char*)s.K + (size_t)k0 * s.ldk * 2; const char* vb = (const char*)s.VT + (size_t)k0 * 2;
#pragma unroll
    for (int i = 0; i < 2; ++i) {
        __builtin_amdgcn_global_load_lds((const GAS unsigned*)(kb + o.gk[i]), (LAS unsigned*)(lds + AT_KT + buf * 16384 + (2 * wave + i) * 1024), 16, 0, 0);
        __builtin_amdgcn_global_load_lds((const GAS unsigned*)(vb + o.gv[i]), (LAS unsigned*)(lds + AT_VT + buf * 16384 + (2 * wave + i) * 1024), 16, 0, 0); }
    if (MODE == MODE_FOX && wave == 0) __builtin_amdgcn_global_load_lds((const GAS unsigned*)(cfrow + k0 + lane), (LAS unsigned*)(lds + AT_CT + buf * 256), 4, 0, 0);
}
template <bool QL>
__device__ __forceinline__ f32x16 score_block(const LAS unsigned char* KT, const LaneOff& o, const bf16x8 (&qf)[8], const LAS bf16* ql, const int kb, const int lane) {
    const int r32 = lane & 31, hi = lane >> 5;
    const LAS unsigned char* p = KT + kb * 8192 + o.krow;
    const LAS bf16* q = ql + r32 * 136 + 8 * hi;
    __builtin_amdgcn_sched_barrier(0);
    bf16x8 kf[8], qq[8];
#pragma unroll
    for (int c = 0; c < 8; ++c) { kf[c] = *(const LAS bf16x8*)(p + o.kc[c]); if (QL) qq[c] = *(const LAS bf16x8*)(q + 16 * c); }
    __builtin_amdgcn_sched_barrier(0);
    f32x16 sa, sb;
#pragma unroll
    for (int i = 0; i < 16; ++i) { sa[i] = 0.f; sb[i] = 0.f; }
#pragma unroll
    for (int c = 0; c < 8; c += 2) { sa = mfma32(kf[c], QL ? qq[c] : qf[c], sa); sb = mfma32(kf[c + 1], QL ? qq[c + 1] : qf[c + 1], sb); }
    __builtin_amdgcn_sched_barrier(0);
    return sa + sb;
}
__device__ __forceinline__ void pv_block(const LAS unsigned char* VT, const LaneOff& o, const f32x16& p, const int kb, f32x16 (&O)[4]) {
    bf16x8 vf[2][4];
#pragma unroll
    for (int cc = 0; cc < 2; ++cc)
#pragma unroll
        for (int db = 0; db < 4; ++db) vf[cc][db] = *(const LAS bf16x8*)(VT + db * 4096 + o.vrow + o.vc[kb][cc]);
    const bf16x8 pf0 = pack8(p[0], p[1], p[2], p[3], p[4], p[5], p[6], p[7]), pf1 = pack8(p[8], p[9], p[10], p[11], p[12], p[13], p[14], p[15]);
    __builtin_amdgcn_sched_barrier(0);
#pragma unroll
    for (int db = 0; db < 4; ++db) O[db] = mfma32(vf[0][db], pf0, O[db]);
#pragma unroll
    for (int db = 0; db < 4; ++db) O[db] = mfma32(vf[1][db], pf1, O[db]);
    __builtin_amdgcn_sched_barrier(0);
}

#define SOFTMAX_RESCALE(mx) do { mx = fmaxf(mx, __shfl_xor(mx, 32)); \
        if (__builtin_amdgcn_ballot_w64(mx > m) != 0ull) { const float alpha_ = __builtin_amdgcn_exp2f(m - mx); l *= alpha_; \
            _Pragma("unroll") for (int db_ = 0; db_ < 4; ++db_) O[db_] *= alpha_; } \
        m = mx; } while (0)
template <int MODE>
__device__ __forceinline__ void compute_tile(LAS unsigned char* lds, const int buf, const LaneOff& lo, const int j, const bf16x8 (&qf)[8], const LAS bf16* ql, f32x16 (&O)[4], float& m, float& l,
                                             const int tq, const int q0w, const float ctq2  , const int head, const bool selbit, const int lane) {
    const LAS unsigned char* KT = lds + AT_KT + buf * 16384; const LAS unsigned char* VT = lds + AT_VT + buf * 16384;
    const LAS float* CT = (const LAS float*)(lds + AT_CT + buf * 256); const LAS float* BT = (const LAS float*)(lds + AT_BT) + head * 792;
    const int hi = lane >> 5, k0 = 64 * j;
    if constexpr (MODE == MODE_FOX) {
#pragma unroll
        for (int kb = 0; kb < 2; ++kb) {
            f32x16 s = score_block<false>(KT, lo, qf, ql, kb, lane);
            const LAS float* ct = CT + 32 * kb + 8 * hi;
            float mx = m, rs = 0.f;
            if (k0 + 32 * kb + 31 <= q0w) {
#pragma unroll
                for (int r = 0; r < 16; ++r) { const float v = __builtin_fmaf(s[r], SC_LOG2, ctq2 - ct[16 * (r >> 3) + (r & 7)]); s[r] = v; mx = fmaxf(mx, v); }
                SOFTMAX_RESCALE(mx);
#pragma unroll
                for (int r = 0; r < 16; ++r) { const float p = __builtin_amdgcn_exp2f(s[r] - mx); s[r] = p; rs += p; }
            } else {
                const int lim = tq - k0 - 32 * kb - 8 * hi;
#pragma unroll
                for (int r = 0; r < 16; ++r) {
                    float v = __builtin_fmaf(s[r], SC_LOG2, ctq2 - ct[16 * (r >> 3) + (r & 7)]);
                    v = (16 * (r >> 3) + (r & 7) <= lim) ? v : -1e30f; s[r] = v; mx = fmaxf(mx, v);
                }
                SOFTMAX_RESCALE(mx);
#pragma unroll
                for (int r = 0; r < 16; ++r) { const float p = s[r] > -1e29f ? __builtin_amdgcn_exp2f(s[r] - mx) : 0.f; s[r] = p; rs += p; }
            }
            l += rs;
            pv_block(VT, lo, s, kb, O);
        }
    } else {
        const bool far = (MODE == MODE_SEL) && (q0w - (k0 + 63) >= 790);
        const float bfar = BT[790];
#pragma unroll
        for (int kb = 0; kb < 2; ++kb) {
            f32x16 s = score_block<true>(KT, lo, qf, ql, kb, lane);
            float rs = 0.f;
            if (far) {
                float smax = s[0];
#pragma unroll
                for (int r = 1; r < 16; ++r) smax = fmaxf(smax, s[r]);
                float mx = fmaxf(m, selbit ? __builtin_fmaf(smax, SC_LOG2, bfar) : -1e30f);
                SOFTMAX_RESCALE(mx);
                const float c0 = selbit ? bfar - mx : -1e30f;
#pragma unroll
                for (int r = 0; r < 16; ++r) { const float p = __builtin_amdgcn_exp2f(__builtin_fmaf(s[r], SC_LOG2, c0)); s[r] = p; rs += p; }
            } else {
                float mx = m;
#pragma unroll
                for (int r = 0; r < 16; ++r) {
                    const int dist = tq - (k0 + 32 * kb + 16 * (r >> 3) + 8 * hi + (r & 7));
                    const bool valid = (MODE == MODE_SEL) ? (selbit && dist >= 0) : (dist >= 0 && dist < WINDOW);
                    const int di = dist < 0 ? 0 : (dist > 790 ? 790 : dist);
                    float v = __builtin_fmaf(s[r], SC_LOG2, BT[di]);
                    v = valid ? v : -1e30f; s[r] = v; mx = fmaxf(mx, v);
                }
                SOFTMAX_RESCALE(mx);
#pragma unroll
                for (int r = 0; r < 16; ++r) { const float p = s[r] > -1e29f ? __builtin_amdgcn_exp2f(s[r] - mx) : 0.f; s[r] = p; rs += p; }
            }
            l += rs;
            pv_block(VT, lo, s, kb, O);
        }
    }
}

template <int MODE, int VAR = 0>
__device__ __forceinline__ void run_branch(Ctx& C, const TileSrc& src, const LaneOff& lo, unsigned long long tmask, const bf16x8 (&qf)[8], const LAS bf16* ql, f32x16 (&O)[4], float& m, float& l,
                                           const int tq, const int q0w, const float* cfrow, const float ctq2, const int head, const unsigned long long selq) {
    if (tmask == 0ull) return;
    int j = __builtin_ctzll(tmask); tmask &= tmask - 1;
    __syncthreads();
    if (VAR != 2) dma_tile<MODE>(C.lds, src, lo, 64 * j, 0, C.wave, C.lane, cfrow);
    int buf = 0;
    for (;;) {
        const int jn = tmask ? __builtin_ctzll(tmask) : -1; tmask &= tmask - 1;
        asm volatile("s_waitcnt vmcnt(0)" ::: "memory");
        __syncthreads();
        if (jn >= 0 && VAR != 2) dma_tile<MODE>(C.lds, src, lo, 64 * jn, buf ^ 1, C.wave, C.lane, cfrow);
        bool active = true;
        if (MODE == MODE_FOX || MODE == MODE_SEL) active = (64 * j <= q0w + 31);
        if (MODE == MODE_WIN) active = (64 * j <= q0w + 31) && (64 * j + 63 >= q0w - (WINDOW - 1));
        if (active && VAR != 1) compute_tile<MODE>(C.lds, buf, lo, j, qf, ql, O, m, l, tq, q0w, ctq2, head, (bool)((selq >> j) & 1ull), C.lane);
        if (jn < 0) break;
        j = jn; buf ^= 1;
    }
}
__device__ __forceinline__ void store_out(float* outp  , const f32x16 (&O)[4], const float sc, const int hi, const bool accumulate) {
#pragma unroll
    for (int db = 0; db < 4; ++db)
#pragma unroll
        for (int r4 = 0; r4 < 4; ++r4) { float* p = outp + 32 * db + 8 * r4 + 4 * hi;
            f32x4 v = {O[db][4 * r4] * sc, O[db][4 * r4 + 1] * sc, O[db][4 * r4 + 2] * sc, O[db][4 * r4 + 3] * sc};
            if (accumulate) v += *(const GAS f32x4*)p;
            *(GAS f32x4*)p = v; }
}
__device__ __forceinline__ void store_partial(bf16* partp  , float* mlp  , const f32x16 (&O)[4], const float m, const float l, const int hi) {
#pragma unroll
    for (int db = 0; db < 4; ++db)
#pragma unroll
        for (int r4 = 0; r4 < 4; ++r4) { v2u w; w.x = pg8::cvt_pk_bf16(O[db][4 * r4], O[db][4 * r4 + 1]); w.y = pg8::cvt_pk_bf16(O[db][4 * r4 + 2], O[db][4 * r4 + 3]);
            *(GAS v2u*)(partp + 32 * db + 8 * r4 + 4 * hi) = w; }
    const float lt = l + __shfl_xor(l, 32);
    if (hi == 0) { typedef float f32x2 __attribute__((ext_vector_type(2))); *(GAS f32x2*)mlp = (f32x2){m, lt}; }
}
__device__ __forceinline__ void load_q(const bf16* qrow  , bf16x8 (&qf)[8], const int hi) {
#pragma unroll
    for (int c = 0; c < 8; ++c) qf[c] = *(const GAS bf16x8*)(qrow + 16 * c + 8 * hi);
}
#define ZERO_STATE(O, m, l) do { _Pragma("unroll") for (int _d = 0; _d < 4; ++_d) _Pragma("unroll") for (int _i = 0; _i < 16; ++_i) O[_d][_i] = 0.f; m = -1e30f; l = 0.f; } while (0)

__device__ __forceinline__ void fox_item(Ctx& C, const int l, const int b, const int h, const int qb, const int part) {
    const int lane = C.lane, hi = lane >> 5, q0w = 256 * qb + 32 * C.wave, tq = q0w + (lane & 31);
    const bf16* zb = (const bf16*)(C.ws + WS_ZB);
    const size_t row = (size_t)b * T + tq;
    bf16x8 qf[8]; load_q(zb + row * ZBC + ZB_FQ + h * 128, qf, hi);
    const float* cf = (const float*)(C.ws + WS_SMALL + SM_CFOX) + (size_t)(b * 4 + h) * T;
    const float ctq = cf[tq];
    TileSrc src{zb + (size_t)b * T * ZBC + ZB_FK + h * 128, ZBC, (const bf16*)(C.ws + WS_VFT) + (size_t)(b * 4 + h) * 128 * T, T};
    f32x16 O[4]; float m, lsum; ZERO_STATE(O, m, lsum);
    LaneOff lo; lane_offsets(src, C.wave, lane, lo);
    const int nt = 4 * qb + 4, t_lo = 16 * part, t_hi = (t_lo + 16 < nt) ? t_lo + 16 : nt, cnt = t_hi - t_lo;
    run_branch<MODE_FOX>(C, src, lo, ((cnt >= 64) ? ~0ull : ((1ull << cnt) - 1ull)) << t_lo, qf, (const LAS bf16*)C.lds, O, m, lsum, tq, q0w, cf, ctq, 0, 0ull);
    unsigned char* pw = C.ws + WS_W + (size_t)l * W_LAYER;
    store_partial((bf16*)(pw + PW_FOX + (size_t)part * PW_SLOT) + row * 512 + h * 128, (float*)(pw + PW_FOXML + (size_t)part * PW_MLSLOT) + (row * 4 + h) * 2, O, m, lsum, hi);
}

template <int KIND>
__device__ __forceinline__ void nsa_item(Ctx& C, const int l, const int b, const int ub, const int part) {
    constexpr int VAR = 0;
    const int lane = C.lane, r32 = lane & 31, hi = lane >> 5, wave = C.wave, h = wave & 3, qh = wave >> 2;
    const int t0 = 64 * ub, q0w = t0 + 32 * qh, tq = q0w + r32, cur = ub;
    const size_t row = (size_t)b * T + tq;
    const bf16* zb = (const bf16*)(C.ws + WS_ZB);
    const float* zf = (const float*)(C.ws + WS_ZF);
    LAS float* BT = (LAS float*)(C.lds + AT_BT); LAS float* IMP = (LAS float*)(C.lds + AT_IMP);
    LAS unsigned long long* SEL = (LAS unsigned long long*)(C.lds + AT_SEL);
    { const float* tb = (const float*)(C.ws + WS_MISC + 65536);
      for (int i = C.tid; i < NH * NBT; i += NTHREADS) BT[(i / NBT) * 792 + (i % NBT)] = tb[i]; }
    bf16x8 qf[8];
#pragma unroll
    for (int c = 0; c < 8; ++c) qf[c] = (bf16x8){0, 0, 0, 0, 0, 0, 0, 0};
    LAS bf16* QL = (LAS bf16*)(C.lds + AT_Q) + wave * (32 * 136);
#pragma unroll
    for (int i = 0; i < 8; ++i) { const int id = lane + 64 * i, rr = id >> 4, c16 = id & 15;
        *(LAS v4u*)(QL + rr * 136 + c16 * 8) = *(const GAS v4u*)(zb + ((size_t)b * T + q0w + rr) * ZBC + ZB_NQ + h * 128 + c16 * 8); }
    f32x16 O[4]; float m, lsum;
    unsigned char* pw = C.ws + WS_W + (size_t)l * W_LAYER;
    if (KIND == 0) {
        ZERO_STATE(O, m, lsum);
        float G[32];
#pragma unroll
        for (int i = 0; i < 32; ++i) G[i] = 0.f;
        float xprev = 0.f;
        const int nkeys = 4 * ub + 3, ntc = (nkeys + 63) >> 6;
        TileSrc src{(const bf16*)(C.ws + WS_SMALL + SM_KC) + (size_t)b * NCMPP * 128, 128, (const bf16*)(C.ws + WS_SMALL + SM_VCT) + (size_t)b * 128 * NCMPP, NCMPP};
        const LAS float* BTh = BT + h * 792;
        LaneOff lo; lane_offsets(src, wave, lane, lo);
        __syncthreads();
        dma_tile<MODE_CMP>(C.lds, src, lo, 0, 0, wave, lane, nullptr);
#pragma unroll
        for (int j = 0; j < 4; ++j) {
            if (j < ntc) {
                const LAS unsigned char* KT = C.lds + AT_KT + (j & 1) * 16384; const LAS unsigned char* VT = C.lds + AT_VT + (j & 1) * 16384;
                asm volatile("s_waitcnt vmcnt(0)" ::: "memory");
                __syncthreads();
                if (j + 1 < ntc) dma_tile<MODE_CMP>(C.lds, src, lo, 64 * (j + 1), (j + 1) & 1, wave, lane, nullptr);
                f32x16 s[2];
                s[0] = score_block<true>(KT, lo, qf, QL, 0, lane); s[1] = score_block<true>(KT, lo, qf, QL, 1, lane);
                float mx = m;
#pragma unroll
                for (int kb = 0; kb < 2; ++kb)
#pragma unroll
                    for (int r = 0; r < 16; ++r) {
                        const int n = 64 * j + 32 * kb + 16 * (r >> 3) + 8 * hi + (r & 7), dist = tq - 16 * n - 31;
                        const int di = dist < 0 ? 0 : (dist > 790 ? 790 : dist);
                        float v = s[kb][r] * SC_LOG2 + BTh[di];
                        v = dist >= 0 ? v : -1e30f; s[kb][r] = v; mx = fmaxf(mx, v);
                    }
                mx = fmaxf(mx, __shfl_xor(mx, 32));
                const float alpha = __builtin_amdgcn_exp2f(m - mx); m = mx;
                float rs = 0.f;
#pragma unroll
                for (int kb = 0; kb < 2; ++kb)
#pragma unroll
                    for (int r = 0; r < 16; ++r) { const float p = s[kb][r] > -1e29f ? __builtin_amdgcn_exp2f(s[kb][r] - mx) : 0.f; s[kb][r] = p; rs += p; }
                lsum = lsum * alpha + rs;
#pragma unroll
                for (int db = 0; db < 4; ++db) O[db] *= alpha;
#pragma unroll
                for (int gi = 0; gi < 8 * j; ++gi) G[gi] *= alpha;
                xprev *= alpha;
#pragma unroll
                for (int kb = 0; kb < 2; ++kb) {
                    const float x7 = __shfl_xor(s[kb][7], 32), x15 = __shfl_xor(s[kb][15], 32);
                    const float gs0 = (s[kb][0] + s[kb][1]) + (s[kb][2] + s[kb][3]), gs1 = (s[kb][4] + s[kb][5]) + (s[kb][6] + s[kb][7]);
                    const float gs2 = (s[kb][8] + s[kb][9]) + (s[kb][10] + s[kb][11]), gs3 = (s[kb][12] + s[kb][13]) + (s[kb][14] + s[kb][15]);
                    const int gb = 4 * (2 * j + kb);
                    G[gb + 0] = gs0 + (hi ? x7 : xprev);
                    G[gb + 1] = gs1 + s[kb][3];
                    G[gb + 2] = gs2 + (hi ? x15 : x7);
                    G[gb + 3] = gs3 + s[kb][11];
                    xprev = x15;
                }
                if (part == 0) { pv_block(VT, lo, s[0], 0, O); pv_block(VT, lo, s[1], 1, O); }
            }
        }
        const float lt = lsum + __shfl_xor(lsum, 32), inv = lt > 0.f ? 1.0f / lt : 0.f;
        if (part == 0) store_out((float*)(C.ws + WS_ONSA) + row * 512 + h * 128, O, inv * sigmoid_f(zf[row * ZFC + ZF_NG + h * 3 + 0]), hi, false);
        __syncthreads();
        LAS float* slab = IMP + (qh * 32 + r32) * 64 + 2 * hi;
#pragma unroll
        for (int hh = 0; hh < 4; ++hh) {
            if (h == hh) {
#pragma unroll
                for (int gi = 0; gi < 32; ++gi) { LAS float* p = slab + 8 * (gi >> 2) + 4 * ((gi & 3) >> 1) + (gi & 1); const float v = G[gi] * inv; *p = (hh == 0) ? v : (*p + v); }
            }
            __syncthreads();
        }
    }
    if (KIND == 0) for (int qq = 0; qq < 8; ++qq) {
        const int qi = 8 * wave + qq, qh2 = qi >> 5, rr = qi & 31;
        float v = IMP[(qh2 * 32 + rr) * 64 + lane];
        if (lane == 0 || lane == cur || lane == cur - 1) v = 1.0e6f;
        if (lane > cur) v = -1.0f;
        int rank = 0;
        for (int i = 0; i < 64; ++i) { const float vi = __builtin_bit_cast(float, __builtin_amdgcn_readlane(__builtin_bit_cast(int, v), i)); rank += (vi > v || (vi == v && i < lane)) ? 1 : 0; }
        const unsigned long long mask = __ballot(rank < NSEL);
        if (lane == 0) SEL[qi] = mask;
    }
    const unsigned long long upto = cur >= 63 ? ~0ull : ((2ull << cur) - 1ull);
    if (KIND == 0) {
        __syncthreads();
        unsigned long long uni = SEL[lane];
#pragma unroll
        for (int o = 1; o < 64; o <<= 1) uni |= __shfl_xor(uni, o);
        const unsigned long long selq = SEL[32 * qh + r32];
        ZERO_STATE(O, m, lsum);
        TileSrc src{zb + (size_t)b * T * ZBC + ZB_NKS, ZBC, (const bf16*)(C.ws + WS_VST) + (size_t)b * 128 * T, T};
        LaneOff lo; lane_offsets(src, wave, lane, lo);
        run_branch<MODE_SEL, VAR>(C, src, lo, uni & upto & (0xFFFFull << (16 * part)), qf, QL, O, m, lsum, tq, q0w, nullptr, 0.f, h, selq);
        store_partial((bf16*)(pw + PW_SEL + (size_t)part * PW_SLOT) + row * 512 + h * 128, (float*)(pw + PW_SELML + (size_t)part * PW_MLSLOT) + (row * 4 + h) * 2, O, m, lsum, hi);
    }
    if (KIND == 1) {
        ZERO_STATE(O, m, lsum);
        TileSrc src{zb + (size_t)b * T * ZBC + ZB_NKW, ZBC, (const bf16*)(C.ws + WS_VWT) + (size_t)b * 128 * T, T};
        const int jlo = cur >= 8 ? cur - 8 : 0;
        LaneOff lo; lane_offsets(src, wave, lane, lo);
        run_branch<MODE_WIN, VAR>(C, src, lo, upto & ~((1ull << jlo) - 1ull), qf, QL, O, m, lsum, tq, q0w, nullptr, 0.f, h, 0ull);
        const float lt = lsum + __shfl_xor(lsum, 32);
        store_out((float*)(C.ws + WS_OFOX) + row * 512 + h * 128, O, (lt > 0.f ? 1.0f / lt : 0.f) * sigmoid_f(zf[row * ZFC + ZF_NG + h * 3 + 2]), hi, false);
    }
}

struct GdnFrags { bf16x8 w[4], kd[2][2]; float u[4]; float egl; };
struct GdnOff { unsigned a, c, u; };
__device__ __forceinline__ void gdn_offsets(const int tr, const int tc, const int cb, const int lane, GdnOff& o) {
    const int fr = lane & 15, fq = lane >> 4;
    o.a = (unsigned)(((16 * tr + fr) * 128 + 8 * fq) * 2);
    o.c = (unsigned)(((32 * tr + fr) * 64 + 8 * fq) * 2);
    o.u = (unsigned)(((16 * tr + 4 * fq) * 128 + 32 * cb + 16 * tc + fr) * 4);
}
__device__ __forceinline__ void gdn_load(const __amdgpu_buffer_rsrc_t rs, const unsigned soff, const float* eglp, const GdnOff& o, GdnFrags& f) {
#pragma unroll
    for (int kk = 0; kk < 4; ++kk) f.w[kk] = __builtin_bit_cast(bf16x8, __builtin_amdgcn_raw_buffer_load_b128(rs, o.a + 64 * kk, soff + (unsigned)GP_W, 0));
#pragma unroll
    for (int kk = 0; kk < 2; ++kk)
#pragma unroll
        for (int t2 = 0; t2 < 2; ++t2) f.kd[t2][kk] = __builtin_bit_cast(bf16x8, __builtin_amdgcn_raw_buffer_load_b128(rs, o.c + 2048 * t2 + 64 * kk, soff + (unsigned)GP_KDT, 0));
#pragma unroll
    for (int r = 0; r < 4; ++r) f.u[r] = __builtin_bit_cast(float, __builtin_amdgcn_raw_buffer_load_b32(rs, o.u + 512 * r, soff + (unsigned)GP_U, 0));
    f.egl = *eglp;
}
#define LDS_BARRIER() do { asm volatile("s_waitcnt lgkmcnt(0)" ::: "memory"); __builtin_amdgcn_s_barrier(); asm volatile("" ::: "memory"); } while (0)
constexpr int GS_ST = 8704, GS_VN = 4608, GS_VN0 = 8 * GS_ST;
__device__ __forceinline__ void gdn_step(const GdnFrags& f, const int n, LAS unsigned char* lds, f32x4 (&S)[2], const int tr, const int tc, const int fr, const int fq) {
    const LAS bf16* STp = (const LAS bf16*)(lds + ((n + 7) & 7) * GS_ST);
    LAS bf16* STn = (LAS bf16*)(lds + (n & 7) * GS_ST);
    LAS bf16* VNT = (LAS bf16*)(lds + GS_VN0 + (n & 7) * GS_VN);
    f32x4 av = {0.f, 0.f, 0.f, 0.f};
#pragma unroll
    for (int kk = 0; kk < 4; ++kk) av = mfma16(f.w[kk], *(const LAS bf16x8*)(STp + (16 * tc + fr) * 136 + 32 * kk + 8 * fq), av);
    { v2u w; w.x = pk2(f.u[0] - av[0], f.u[1] - av[1]); w.y = pk2(f.u[2] - av[2], f.u[3] - av[3]); *(LAS v2u*)(VNT + (16 * tc + fr) * 72 + 16 * tr + 4 * fq) = w; }
    LDS_BARRIER();
    bf16x8 vf[2];
#pragma unroll
    for (int kk = 0; kk < 2; ++kk) vf[kk] = *(const LAS bf16x8*)(VNT + (16 * tc + fr) * 72 + 32 * kk + 8 * fq);
#pragma unroll
    for (int t2 = 0; t2 < 2; ++t2) { S[t2] *= f.egl;
#pragma unroll
        for (int kk = 0; kk < 2; ++kk) S[t2] = mfma16(f.kd[t2][kk], vf[kk], S[t2]);
        v2u w; w.x = pk2(S[t2][0], S[t2][1]); w.y = pk2(S[t2][2], S[t2][3]);
        *(LAS v2u*)(STn + (16 * tc + fr) * 136 + 16 * (2 * tr + t2) + 4 * fq) = w; }
    LDS_BARRIER();
}
__device__ __forceinline__ void gdn_flush(const LAS unsigned char* lds, unsigned char* sn  , unsigned char* vn, const int tid) {
#pragma unroll
    for (int i = 0; i < 8; ++i) { const int idx = tid + NTHREADS * i, slot = idx >> 9, rem = idx & 511, col = rem >> 4, c16 = rem & 15;
        *(GAS v4u*)(sn + (size_t)slot * GSN_STEP + (col * 128 + c16 * 8) * 2) = *(const LAS v4u*)(lds + slot * GS_ST + (col * 136 + c16 * 8) * 2); }
#pragma unroll
    for (int i = 0; i < 4; ++i) { const int idx = tid + NTHREADS * i, slot = idx >> 8, rem = idx & 255, col = rem >> 3, c8 = rem & 7;
        *(GAS v4u*)(vn + (size_t)slot * GVN_STEP + (col * 64 + c8 * 8) * 2) = *(const LAS v4u*)(lds + GS_VN0 + slot * GS_VN + (col * 72 + c8 * 8) * 2); }
    __syncthreads();
}
template <int VAR = 0>
__device__ __forceinline__ void gdn_scan_item(Ctx& C, const int item) {
    const int cb = item & 3, bh = item >> 2;
    const int lane = C.lane, wave = C.wave, tr = wave >> 1, tc = wave & 1, fr = lane & 15, fq = lane >> 4;
    for (int i = C.tid; i < GS_ST / 4; i += NTHREADS) ((LAS unsigned*)(C.lds + 7 * GS_ST))[i] = 0u;
    const unsigned char* gp0 = C.ws + WS_GPRE + (size_t)bh * 64 * GPRE_UNIT;
    const float* egl0 = (const float*)(C.ws + WS_SMALL + SM_EGL) + bh * 64;
    unsigned char* sn0 = C.ws + WS_GSN + ((size_t)bh * 64 * 4 + cb) * 8192;
    unsigned char* vn0 = C.ws + WS_GVN + ((size_t)bh * 64 * 4 + cb) * 4096;
    f32x4 S[2]; S[0] = (f32x4){0.f, 0.f, 0.f, 0.f}; S[1] = S[0];
    GdnFrags f0, f1, f2, f3; GdnOff go; gdn_offsets(tr, tc, cb, lane, go);
    const __amdgpu_buffer_rsrc_t rs = __builtin_amdgcn_make_buffer_rsrc((void*)gp0, 0, 64 * (int)GPRE_UNIT, 0x00020000);
    gdn_load(rs, 0u, egl0, go, f0); gdn_load(rs, (unsigned)GPRE_UNIT, egl0 + 1, go, f1); gdn_load(rs, 2u * (unsigned)GPRE_UNIT, egl0 + 2, go, f2);
    if (VAR == 1) gdn_load(rs, 3u * (unsigned)GPRE_UNIT, egl0 + 3, go, f3);
    __syncthreads();
    for (int n = 0; n < 64; n += 8) {
#define GDN_LD(k, f) do { if (VAR == 1) break; const int _c = (k) < 64 ? (k) : 63; gdn_load(rs, (unsigned)_c * (unsigned)GPRE_UNIT, egl0 + _c, go, f); } while (0)
        GDN_LD(n + 3, f3); gdn_step(f0, n, C.lds, S, tr, tc, fr, fq); __builtin_amdgcn_sched_barrier(0);
        GDN_LD(n + 4, f0); gdn_step(f1, n + 1, C.lds, S, tr, tc, fr, fq); __builtin_amdgcn_sched_barrier(0);
        GDN_LD(n + 5, f1); gdn_step(f2, n + 2, C.lds, S, tr, tc, fr, fq); __builtin_amdgcn_sched_barrier(0);
        GDN_LD(n + 6, f2); gdn_step(f3, n + 3, C.lds, S, tr, tc, fr, fq); __builtin_amdgcn_sched_barrier(0);
        GDN_LD(n + 7, f3); gdn_step(f0, n + 4, C.lds, S, tr, tc, fr, fq); __builtin_amdgcn_sched_barrier(0);
        GDN_LD(n + 8, f0); gdn_step(f1, n + 5, C.lds, S, tr, tc, fr, fq); __builtin_amdgcn_sched_barrier(0);
        GDN_LD(n + 9, f1); gdn_step(f2, n + 6, C.lds, S, tr, tc, fr, fq); __builtin_amdgcn_sched_barrier(0);
        GDN_LD(n + 10, f2); gdn_step(f3, n + 7, C.lds, S, tr, tc, fr, fq); __builtin_amdgcn_sched_barrier(0);
#undef GDN_LD
        gdn_flush(C.lds, sn0 + (size_t)n * GSN_STEP, vn0 + (size_t)n * GVN_STEP, C.tid);
    }
}

__device__ __forceinline__ void lru_scan_item(Ctx& C, const int item) {
    const int b = item >> 3, ch = (item & 7) * 64 + C.lane, wave = C.wave;
    const float* LA = (const float*)(C.ws + WS_LA) + ((size_t)b * T + 512 * wave) * 512 + ch;
    const float* LU = (const float*)(C.ws + WS_LU) + ((size_t)b * T + 512 * wave) * 512 + ch;
    float* LH = (float*)(C.ws + WS_LH) + ((size_t)b * T + 512 * wave) * 512 + ch;
    LAS float* HE = (LAS float*)C.lds; LAS float* PE = HE + 8 * 64;
    float hh = 0.f, pp = 1.f;
    for (int t = 0; t < 512; t += 8) {
        float a[8], u[8];
#pragma unroll
        for (int i = 0; i < 8; ++i) { a[i] = LA[(size_t)(t + i) * 512]; u[i] = LU[(size_t)(t + i) * 512]; }
#pragma unroll
        for (int i = 0; i < 8; ++i) { hh = a[i] * hh + u[i]; pp *= a[i]; }
    }
    HE[wave * 64 + C.lane] = hh; PE[wave * 64 + C.lane] = pp;
    __syncthreads();
    float H = 0.f;
    for (int s = 0; s < wave; ++s) H = PE[s * 64 + C.lane] * H + HE[s * 64 + C.lane];
    for (int t = 0; t < 512; t += 8) {
        float a[8], u[8];
#pragma unroll
        for (int i = 0; i < 8; ++i) { a[i] = LA[(size_t)(t + i) * 512]; u[i] = LU[(size_t)(t + i) * 512]; }
#pragma unroll
        for (int i = 0; i < 8; ++i) { H = a[i] * H + u[i]; LH[(size_t)(t + i) * 512] = H; }
    }
}

__device__ __forceinline__ void nsa_sel_dispatch(Ctx& C, const int l, const int j) {
    const int bb = j & 1, k = j >> 1;
    const int pp = k < 64 ? 0 : (k < 112 ? 1 : (k < 144 ? 2 : 3));
    const int ub = 63 - (k - (pp == 0 ? 0 : (pp == 1 ? 64 : (pp == 2 ? 112 : 144))));
    nsa_item<0>(C, l, bb, ub, pp);
}
__device__ __forceinline__ void fox_dispatch(Ctx& C, const int l, const int j) {
    const int bh = j & 7, k = j >> 3;
    const int pp = k < 16 ? 0 : (k < 28 ? 1 : (k < 36 ? 2 : 3));
    const int qb = 15 - (k - (pp == 0 ? 0 : (pp == 1 ? 16 : (pp == 2 ? 28 : 36))));
    fox_item(C, l, bh >> 2, bh & 3, qb, pp);
}
__device__ __forceinline__ void mix_phase(Ctx& C, const int l, const int qoff) {
    const int q0 = 16 * l + 8 + qoff;
    if (C.bid < 32) { refresh_ids(C); __syncthreads(); gdn_scan_item<0>(C, (C.bid & 7) * 4 + (C.bid >> 3)); }
    QUEUE_LOOP(q0 + 1, 16, lru_scan_item(C, j));
    QUEUE_LOOP(q0 + 2, 320, nsa_sel_dispatch(C, l, j));
    QUEUE_LOOP(q0 + 3, 320, fox_dispatch(C, l, j));
    QUEUE_LOOP(q0 + 4, 128, nsa_item<1>(C, l, j & 1, 63 - (j >> 1), 0));
}
__device__ __forceinline__ void gdn_out_job(Ctx& C, const int l, const int job) {
    const int n = job & 63, bh = job >> 6, b = bh >> 2, h = bh & 3;
    const int lane = C.lane, wave = C.wave, tr = wave >> 1, chalf = wave & 1, fr = lane & 15, fq = lane >> 4;
    const unsigned char* gp = C.ws + WS_GPRE + (size_t)job * GPRE_UNIT;
    bf16x8 qt[4], qk[2];
#pragma unroll
    for (int kk = 0; kk < 4; ++kk) qt[kk] = *(const GAS bf16x8*)(gp + GP_QT + ((16 * tr + fr) * 128 + 32 * kk + 8 * fq) * 2);
#pragma unroll
    for (int kk = 0; kk < 2; ++kk) qk[kk] = *(const GAS bf16x8*)(gp + GP_QK + ((16 * tr + fr) * 64 + 32 * kk + 8 * fq) * 2);
    f32x4 acc[4];
#pragma unroll
    for (int i = 0; i < 4; ++i) {
        acc[i] = (f32x4){0.f, 0.f, 0.f, 0.f};
        const int ct = 4 * chalf + i, cb = ct >> 1, within = (ct & 1) * 16 + fr;
        if (n > 0) { const unsigned char* sn = C.ws + WS_GSN + ((size_t)(job - 1) * 4 + cb) * 8192 + (within * 128 + 8 * fq) * 2;
#pragma unroll
            for (int kk = 0; kk < 4; ++kk) acc[i] = mfma16(qt[kk], *(const GAS bf16x8*)(sn + 64 * kk), acc[i]); }
        const unsigned char* vn = C.ws + WS_GVN + ((size_t)job * 4 + cb) * 4096 + (within * 64 + 8 * fq) * 2;
#pragma unroll
        for (int kk = 0; kk < 2; ++kk) acc[i] = mfma16(qk[kk], *(const GAS bf16x8*)(vn + 64 * kk), acc[i]);
    }
    LAS float* PS = (LAS float*)C.lds;
    float ss[4];
#pragma unroll
    for (int r = 0; r < 4; ++r) { float s = acc[0][r] * acc[0][r] + acc[1][r] * acc[1][r] + acc[2][r] * acc[2][r] + acc[3][r] * acc[3][r];
        s += __shfl_xor(s, 1); s += __shfl_xor(s, 2); s += __shfl_xor(s, 4); s += __shfl_xor(s, 8); ss[r] = s; }
    if (fr == 0) {
#pragma unroll
        for (int r = 0; r < 4; ++r) PS[(16 * tr + 4 * fq + r) * 2 + chalf] = ss[r]; }
    __syncthreads();
    const float* gng = inp<I_GNORM>() + l * 128;
    const float* zf = (const float*)(C.ws + WS_ZF);
    bf16* Y = (bf16*)(C.ws + WS_XN);
#pragma unroll
    for (int r = 0; r < 4; ++r) {
        const int row = 16 * tr + 4 * fq + r; const size_t m = (size_t)b * T + 64 * n + row;
        const float rstd = 1.0f / sqrtf((PS[row * 2] + PS[row * 2 + 1]) * (1.f / 128.f) + EPS);
#pragma unroll
        for (int i = 0; i < 4; ++i) { const int col = 16 * (4 * chalf + i) + fr;
            const float gz = zf[m * ZFC + ZF_GZ + h * 128 + col];
            Y[m * D + 512 + h * 128 + col] = (bf16)f2bf(acc[i][r] * rstd * gng[col] * silu_ff(gz)); }
    }
}
__device__ __forceinline__ void post_phase(Ctx& C, const int l) {
    QUEUE_LOOP(16 * l + 14, 512, gdn_out_job(C, l, j));
    refresh_ids(C);
    const int lane = C.lane;
    bf16* Y = (bf16*)(C.ws + WS_XN);
    const float* zf = (const float*)(C.ws + WS_ZF);
    const float* ong = inp<I_ONG>() + (size_t)l * 3 * 512;
    for (int m = C.bid * NWAVES + C.wave; m < M; m += C.G * NWAVES) {
        const size_t r512 = (size_t)m * 512 + 8 * lane;
        const unsigned char* pw = C.ws + WS_W + (size_t)l * W_LAYER;
        const int tpos = m & (T - 1), hd = lane >> 4;
        f32x4 a0, a1, s0, s1;
        {
            const int np = (tpos >> 10) + 1;
            float mp[4], lp[4], mx = -1e30f;
#pragma unroll
            for (int p = 0; p < 4; ++p) { mp[p] = -1e30f; lp[p] = 0.f;
                if (p < np) { typedef float f32x2 __attribute__((ext_vector_type(2))); const f32x2 v = *(const GAS f32x2*)((const float*)(pw + PW_FOXML + (size_t)p * PW_MLSLOT) + ((size_t)m * 4 + hd) * 2); mp[p] = v.x; lp[p] = v.y; }
                mx = fmaxf(mx, mp[p]); }
            float den = 0.f; a0 = (f32x4){0.f, 0.f, 0.f, 0.f}; a1 = a0;
#pragma unroll
            for (int p = 0; p < 4; ++p) if (p < np) { const float w = __builtin_amdgcn_exp2f(mp[p] - mx); den += w * lp[p];
                const v4u u = *(const GAS v4u*)((const bf16*)(pw + PW_FOX + (size_t)p * PW_SLOT) + r512);
                a0 += w * (f32x4){bf2f(u.x & 0xffff), bf2f(u.x >> 16), bf2f(u.y & 0xffff), bf2f(u.y >> 16)};
                a1 += w * (f32x4){bf2f(u.z & 0xffff), bf2f(u.z >> 16), bf2f(u.w & 0xffff), bf2f(u.w >> 16)}; }
            const float inv = den > 0.f ? 1.0f / den : 0.f; a0 *= inv; a1 *= inv;
        }
        {
            const int np = (tpos >> 10) + 1;
            float mp[4], lp[4], mx = -1e30f;
#pragma unroll
            for (int p = 0; p < 4; ++p) { mp[p] = -1e30f; lp[p] = 0.f;
                if (p < np) { typedef float f32x2 __attribute__((ext_vector_type(2))); const f32x2 v = *(const GAS f32x2*)((const float*)(pw + PW_SELML + (size_t)p * PW_MLSLOT) + ((size_t)m * 4 + hd) * 2); mp[p] = v.x; lp[p] = v.y; }
                mx = fmaxf(mx, mp[p]); }
            float den = 0.f; s0 = (f32x4){0.f, 0.f, 0.f, 0.f}; s1 = s0;
#pragma unroll
            for (int p = 0; p < 4; ++p) if (p < np) { const float w = __builtin_amdgcn_exp2f(mp[p] - mx); den += w * lp[p];
                const v4u u = *(const GAS v4u*)((const bf16*)(pw + PW_SEL + (size_t)p * PW_SLOT) + r512);
                s0 += w * (f32x4){bf2f(u.x & 0xffff), bf2f(u.x >> 16), bf2f(u.y & 0xffff), bf2f(u.y >> 16)};
                s1 += w * (f32x4){bf2f(u.z & 0xffff), bf2f(u.z >> 16), bf2f(u.w & 0xffff), bf2f(u.w >> 16)}; }
            const float inv = (den > 0.f ? 1.0f / den : 0.f) * sigmoid_f(zf[(size_t)m * ZFC + ZF_NG + hd * 3 + 1]); s0 *= inv; s1 *= inv;
        }
        f32x4 c0 = *(const GAS f32x4*)((const float*)(C.ws + WS_LH) + r512), c1 = *(const GAS f32x4*)((const float*)(C.ws + WS_LH) + r512 + 4);
        f32x4 d0 = *(const GAS f32x4*)((const float*)(C.ws + WS_ONSA) + r512) + *(const GAS f32x4*)((const float*)(C.ws + WS_OFOX) + r512) + s0;
        f32x4 d1 = *(const GAS f32x4*)((const float*)(C.ws + WS_ONSA) + r512 + 4) + *(const GAS f32x4*)((const float*)(C.ws + WS_OFOX) + r512 + 4) + s1;
        const f32x4 lg0 = *(const GAS f32x4*)(zf + (size_t)m * ZFC + ZF_LG + 8 * lane), lg1 = *(const GAS f32x4*)(zf + (size_t)m * ZFC + ZF_LG + 8 * lane + 4);
#pragma unroll
        for (int i = 0; i < 4; ++i) { c0[i] *= gelu_tanh_f(lg0[i]); c1[i] *= gelu_tanh_f(lg1[i]); }
#define SS8(x0, x1) ((x0.x * x0.x + x0.y * x0.y) + (x0.z * x0.z + x0.w * x0.w) + (x1.x * x1.x + x1.y * x1.y) + (x1.z * x1.z + x1.w * x1.w))
        const float ra = 1.0f / sqrtf(wave_sum(SS8(a0, a1)) * (1.f / 512.f) + EPS);
        const float rc = 1.0f / sqrtf(wave_sum(SS8(c0, c1)) * (1.f / 512.f) + EPS);
        const float rd = 1.0f / sqrtf(wave_sum(SS8(d0, d1)) * (1.f / 512.f) + EPS);
#undef SS8
        const f32x4 ga0 = *(const GAS f32x4*)(ong + 8 * lane), ga1 = *(const GAS f32x4*)(ong + 8 * lane + 4);
        const f32x4 gc0 = *(const GAS f32x4*)(ong + 512 + 8 * lane), gc1 = *(const GAS f32x4*)(ong + 512 + 8 * lane + 4);
        const f32x4 gd0 = *(const GAS f32x4*)(ong + 1024 + 8 * lane), gd1 = *(const GAS f32x4*)(ong + 1024 + 8 * lane + 4);
        bf16* yr = Y + (size_t)m * D + 8 * lane;
        v4u w;
        w.x = pk2(a0.x * ra * ga0.x, a0.y * ra * ga0.y); w.y = pk2(a0.z * ra * ga0.z, a0.w * ra * ga0.w); w.z = pk2(a1.x * ra * ga1.x, a1.y * ra * ga1.y); w.w = pk2(a1.z * ra * ga1.z, a1.w * ra * ga1.w);
        *(GAS v4u*)yr = w;
        w.x = pk2(c0.x * rc * gc0.x, c0.y * rc * gc0.y); w.y = pk2(c0.z * rc * gc0.z, c0.w * rc * gc0.w); w.z = pk2(c1.x * rc * gc1.x, c1.y * rc * gc1.y); w.w = pk2(c1.z * rc * gc1.z, c1.w * rc * gc1.w);
        *(GAS v4u*)(yr + 1024) = w;
        w.x = pk2(d0.x * rd * gd0.x, d0.y * rd * gd0.y); w.y = pk2(d0.z * rd * gd0.z, d0.w * rd * gd0.w); w.z = pk2(d1.x * rd * gd1.x, d1.y * rd * gd1.y); w.w = pk2(d1.z * rd * gd1.z, d1.w * rd * gd1.w);
        *(GAS v4u*)(yr + 1536) = w;
    }
}
#ifndef N_LAUNCHES
#define N_LAUNCHES 1
#endif
constexpr int PH_PER_LAYER = 12, NPHASES = 1 + DEPTH * PH_PER_LAYER;
struct Args { const float* in[N_IN]; float* out; unsigned char* ws; int ph_lo, ph_hi; };
static_assert(sizeof(Args) == (N_IN + 2) * 8 + 8, "Args has no padding");

#define IN_PH(k) (lo <= (k) && (k) < hi)
#define SEAM(k) do { if (IN_PH(k) && IN_PH((k) + 1)) xcd_barrier(bar); } while (0)
template <int l> __device__ __forceinline__ void layer_phases(Ctx& C, const XcdBarrier& bar, const int lo, const int hi) {
        const int pb = 1 + l * PH_PER_LAYER;
        unsigned char* wl = C.ws + WS_W + (size_t)l * W_LAYER;
        bf16* XN = (bf16*)(C.ws + WS_XN); bf16* ACT = (bf16*)(C.ws + WS_ACT);
        if (IN_PH(pb + 0)) {
            pg8::Gemm g{XN, (const bf16*)(wl + WO_GU1), M, 2 * FF, D}; pg8::StaticOrder S; S.init(M, 2 * FF, C.G, C.bid);
            pg8::EpiSwiGLU E{ACT, FF};
            pg8::gemm_phase<pg8::EpiSwiGLU, pg8::StaticOrder, true, true>(C.lds, g, S, E);
        }
        SEAM(pb + 0);
        if (IN_PH(pb + 1)) {
            pg8::Gemm g{ACT, (const bf16*)(wl + WO_DN1), M, D, FF}; pg8::StaticOrder S; S.init(M, D, C.G, C.bid);
            pg8::EpiResid E{hptr(), D, 0.5f};
            pg8::gemm_phase<pg8::EpiResid, pg8::StaticOrder, false, true>(C.lds, g, S, E);
        }
        SEAM(pb + 1);
        if (IN_PH(pb + 2)) norm_phase_bf16(C, inp<I_MIXG>() + l * D);
        SEAM(pb + 2);
        if (IN_PH(pb + 3)) {
            pg8::Gemm g{XN, (const bf16*)(wl + WO_WIN), M, ZC, D}; pg8::StaticOrder S; S.init(M, ZC, C.G, C.bid);
            pg8::EpiWin E{(bf16*)(C.ws + WS_ZB), ZBC, (float*)(C.ws + WS_ZF), ZFC, (const float*)(C.ws + WS_MISC) + l * ZC, ZBC / 256};
            pg8::gemm_phase<pg8::EpiWin, pg8::StaticOrder, true, true>(C.lds, g, S, E);
        }
        SEAM(pb + 3);
        if (IN_PH(pb + 4)) pre_phase(C, l, 0);
        SEAM(pb + 4);
        if (IN_PH(pb + 5)) mix_phase(C, l, 0);
        SEAM(pb + 5);
        if (IN_PH(pb + 6)) post_phase(C, l);
        SEAM(pb + 6);
#ifdef PROBE_ITEM
        if (IN_PH(pb + 5)) {
#if PROBE_ITEM == 0
            if (C.bid < 32) { refresh_ids(C); __syncthreads(); gdn_scan_item<PROBE_VAR>(C, (C.bid & 7) * 4 + (C.bid >> 3)); }
#elif PROBE_ITEM == 10
            QUEUE_LOOP(16 * l + 40, 64, nsa_compress_job(C, l, j));
#elif PROBE_ITEM == 11
            QUEUE_LOOP(16 * l + 40, 512, gdn_pre_job(C, l, j));
#elif PROBE_ITEM == 12
            QUEUE_LOOP(16 * l + 40, 256, lru_gate_job(C, l, j));
#elif PROBE_ITEM == 13
            QUEUE_LOOP(16 * l + 40, 128, vtrans_job(C, j));
#elif PROBE_ITEM == 20
            prologue_phase<false>(C);
#elif PROBE_ITEM == 9
            mix_phase(C, l, 32);
#elif PROBE_ITEM == 8
            pre_phase(C, l, 32);
#elif PROBE_ITEM == 3
            QUEUE_LOOP(16 * l + 40, 16, lru_scan_item(C, j));
#endif
        }
        SEAM(pb + 5);
#endif
        if (IN_PH(pb + 7)) {
            pg8::Gemm g{XN, (const bf16*)(wl + WO_WOUT), M, D, D}; pg8::StaticOrder S; S.init(M, D, C.G, C.bid);
            pg8::EpiResid E{hptr(), D, 1.0f};
            pg8::gemm_phase<pg8::EpiResid, pg8::StaticOrder, false, true>(C.lds, g, S, E);
        }
        SEAM(pb + 7);
        if (IN_PH(pb + 8)) norm_phase_bf16(C, inp<I_F2G>() + l * D);
        SEAM(pb + 8);
        if (IN_PH(pb + 9)) {
            pg8::Gemm g{XN, (const bf16*)(wl + WO_GU2), M, 2 * FF, D}; pg8::StaticOrder S; S.init(M, 2 * FF, C.G, C.bid);
            pg8::EpiSwiGLU E{ACT, FF};
            pg8::gemm_phase<pg8::EpiSwiGLU, pg8::StaticOrder, true, true>(C.lds, g, S, E);
        }
        SEAM(pb + 9);
        if (IN_PH(pb + 10)) {
            pg8::Gemm g{ACT, (const bf16*)(wl + WO_DN2), M, D, FF}; pg8::StaticOrder S; S.init(M, D, C.G, C.bid);
            pg8::EpiResid E{hptr(), D, 0.5f};
            pg8::gemm_phase<pg8::EpiResid, pg8::StaticOrder, false, true>(C.lds, g, S, E);
        }
        SEAM(pb + 10);
        if (IN_PH(pb + 11)) {
            if (l + 1 < DEPTH) norm_phase_bf16(C, inp<I_F1G>() + (l + 1) * D);
            else { refresh_ids(C); float* const hp = hptr(); for (int m = C.bid * NWAVES + C.wave; m < M; m += C.G * NWAVES) rms_row_f32(hp + (size_t)m * D, inp<I_FING>(), hp + (size_t)m * D, C.lane); }
        }
        SEAM(pb + 11);
    }
__global__ void __launch_bounds__(NTHREADS, 2) fwd_kernel(Args args) {
    extern __shared__ __attribute__((aligned(16))) unsigned char lds_raw[];
    Ctx C;
    C.lds = (LAS unsigned char*)lds_raw;
    C.tid = threadIdx.x; C.lane = C.tid & 63; C.wave = __builtin_amdgcn_readfirstlane(C.tid >> 6);
    C.G = gridDim.x; C.bid = blockIdx.x;
    C.ws = args.ws;
    if (C.tid < 64) ((LAS unsigned*)(C.lds + LDS_CTL_OFF))[C.tid] = 0u;
    __syncthreads();
    XcdBarrier bar; bar.bar = (unsigned*)C.ws + CW_BAR; bar.x = 0; bar.st = nullptr;
    const int lo = args.ph_lo, hi = args.ph_hi;
    if (hi - lo > 1) bar = xcd_barrier_post((unsigned*)C.ws + CW_BAR, (volatile LAS unsigned*)(C.lds + LDS_CTL_OFF));

    if (IN_PH(0)) { prologue_phase(C); }
    SEAM(0);
    layer_phases<0>(C, bar, lo, hi);
    layer_phases<1>(C, bar, lo, hi);
    static_assert(DEPTH == 2, "two layers");
#undef IN_PH
#undef SEAM
}

extern "C" void kernel_launch(void* const* d_in, const int* in_sizes, int n_in, void* d_out, int out_size, void* d_ws, size_t ws_size, hipStream_t stream) {
    static int grid = 0;
    if (grid == 0) {
        if (n_in != N_IN || in_sizes[0] != M * D || out_size != M * D || ws_size < WS_W1T + 4 * MiB) { fprintf(stderr, "kernel_launch: unexpected shapes (n_in %d, in0 %d, out %d, ws %zu)\n", n_in, n_in > 0 ? in_sizes[0] : -1, out_size, ws_size); grid = -1; return; }
        int dev = 0, cus = 0, per_cu = 0;
        if (hipGetDevice(&dev) != hipSuccess || hipDeviceGetAttribute(&cus, hipDeviceAttributeMultiprocessorCount, dev) != hipSuccess) { grid = -1; return; }
        if (hipFuncSetAttribute((const void*)fwd_kernel, hipFuncAttributeMaxDynamicSharedMemorySize, LDS_BYTES) != hipSuccess) { fprintf(stderr, "kernel_launch: hipFuncSetAttribute failed\n"); grid = -1; return; }
        if (hipOccupancyMaxActiveBlocksPerMultiprocessor(&per_cu, (const void*)fwd_kernel, NTHREADS, LDS_BYTES) != hipSuccess || per_cu < 1) { fprintf(stderr, "kernel_launch: occupancy query reports %d\n", per_cu); }
        (void)hipGetLastError();
        grid = cus;
    }
    if (grid < 0) return;
    if (hipMemsetAsync((char*)d_ws + WS_CTL, 0, CTL_ZERO_BYTES, stream) != hipSuccess) return;
    Args a{};
    for (int i = 0; i < N_IN; ++i) a.in[i] = (const float*)d_in[i];
    a.out = (float*)d_out; a.ws = (unsigned char*)d_ws;
#if N_LAUNCHES == 1
    a.ph_lo = 0; a.ph_hi = NPHASES;
    hipLaunchKernelGGL(fwd_kernel, dim3(grid), dim3(NTHREADS), LDS_BYTES, stream, a);
#else
    for (int p = 0; p < NPHASES; ++p) { a.ph_lo = p; a.ph_hi = p + 1; hipLaunchKernelGGL(fwd_kernel, dim3(grid), dim3(NTHREADS), LDS_BYTES, stream, a); }
#endif
}
```
